# Optimizing an MI355X kernel written in HIP

```python
import math
import jax, jax.numpy as jnp
from jax import lax
import numpy as np

D_MODEL = 1024
BATCH = 4
SEQ = 8192
DEPTH = 2

GRID_W = 64
Q_BLOCK = 128
ROPE_THETA = 10000.0
EPS = 1e-6

MLA_HEADS = 8
MLA_Q_LORA = 512
MLA_KV_LORA = 256
MLA_NOPE = 64
MLA_ROPE = 32
MLA_V = 64
GQA_Q_HEADS = 8
GQA_KV_HEADS = 2
GQA_HEAD_DIM = 64
DIFF_HEADS = 8
DIFF_QK = 64
DIFF_V = 2 * DIFF_QK
REL_BUCKETS = 32
REL_MAX_DIST = 128
MOE_GROUPS = 4
MOE_EXPERTS_PER_GROUP = 8
MOE_EXPERTS = MOE_GROUPS * MOE_EXPERTS_PER_GROUP
MOE_TOP_K = 2
MOE_HIDDEN = 512
MOE_BLOCK = 128

AB_SPLITS = [MLA_Q_LORA, MLA_KV_LORA, MLA_ROPE, GQA_Q_HEADS * GQA_HEAD_DIM, GQA_KV_HEADS * GQA_HEAD_DIM, GQA_KV_HEADS * GQA_HEAD_DIM]
AB_IN = sum(AB_SPLITS)
AB_OUT = MLA_HEADS * MLA_V + GQA_Q_HEADS * GQA_HEAD_DIM
C_IN = DIFF_HEADS * (4 * DIFF_QK + DIFF_V)
C_OUT = DIFF_HEADS * DIFF_V

kernel_name = "hybrid_mla_axialgqa_diffattn_hmoe_encoder"


def _rms(x, g):
    xf = x.astype(jnp.float32)
    y = xf * lax.rsqrt(jnp.mean(xf * xf, axis=-1, keepdims=True) + EPS)
    return (y * g.astype(jnp.float32)).astype(x.dtype)


def _rope_tables(pos, dim):
    inv = ROPE_THETA ** (-jnp.arange(0, dim, 2, dtype=jnp.float32) / dim)
    ang = pos.astype(jnp.float32)[:, None] * inv[None, :]
    ang = jnp.concatenate([ang, ang], axis=-1)
    return jnp.cos(ang), jnp.sin(ang)


def _apply_rope(x, cos, sin):
    half = x.shape[-1] // 2
    rot = jnp.concatenate([-x[..., half:], x[..., :half]], axis=-1)
    return x * cos[None, :, None, :].astype(x.dtype) + rot * sin[None, :, None, :].astype(x.dtype)


def _to_blocks(t):
    b, s = t.shape[:2]
    t = t.reshape((b, s // Q_BLOCK, Q_BLOCK) + t.shape[2:])
    return jnp.moveaxis(t, 1, 0)


def _from_blocks(t):
    t = jnp.moveaxis(t, 0, 1)
    return t.reshape((t.shape[0], t.shape[1] * t.shape[2]) + t.shape[3:])


def _block_softmax_attention(q, k, v):
    b, s, hq, d = q.shape
    hkv = k.shape[2]
    grp = hq // hkv
    dv = v.shape[-1]
    scale = 1.0 / math.sqrt(d)

    def one(qb):
        qg = qb.reshape(b, Q_BLOCK, hkv, grp, d)
        logits = jnp.einsum('bqhgd,bkhd->bhgqk', qg, k).astype(jnp.float32) * scale
        p = jax.nn.softmax(logits, axis=-1).astype(v.dtype)
        o = jnp.einsum('bhgqk,bkhe->bqhge', p, v)
        return o.reshape(b, Q_BLOCK, hq, dv)

    return _from_blocks(lax.map(one, _to_blocks(q)))


def _t5_bucket(rel):
    nb = REL_BUCKETS // 2
    max_exact = nb // 2
    ret = jnp.where(rel > 0, nb, 0)
    n = jnp.abs(rel)
    nf = jnp.maximum(n, 1).astype(jnp.float32)
    large = max_exact + (jnp.log(nf / max_exact) / math.log(REL_MAX_DIST / max_exact) * (nb - max_exact)).astype(jnp.int32)
    large = jnp.minimum(large, nb - 1)
    return ret + jnp.where(n < max_exact, n, large)


def _diff_attention(q, k, v, lam, rel_bias):
    b, s, h, _, d = q.shape
    scale = 1.0 / math.sqrt(d)
    kpos = jnp.arange(s, dtype=jnp.int32)

    def one(args):
        qb, start = args
        qpos = start + jnp.arange(Q_BLOCK, dtype=jnp.int32)
        bias = rel_bias[_t5_bucket(kpos[None, :] - qpos[:, None])]
        bias = jnp.transpose(bias, (2, 0, 1)).astype(jnp.float32)
        logits = jnp.einsum('bqhcd,bkhcd->bhcqk', qb, k).astype(jnp.float32) * scale + bias[None, :, None]
        p = jax.nn.softmax(logits, axis=-1)
        a = (p[:, :, 0] - lam * p[:, :, 1]).astype(v.dtype)
        return jnp.einsum('bhqk,bkhe->bqhe', a, v)

    starts = jnp.arange(s // Q_BLOCK, dtype=jnp.int32) * Q_BLOCK
    return _from_blocks(lax.map(one, (_to_blocks(q), starts)))


def _mixer_ab(h, w_in, q_a_norm, w_qb, kv_a_norm, w_kvb, mla_qn, mla_kn, gqa_qn, gqa_kn, w_out):
    b, s, _ = h.shape
    idx = [int(v) for v in np.cumsum(AB_SPLITS)[:-1]]
    cq, ckv, k_pe, qg, kg, vg = jnp.split(h @ w_in, idx, axis=-1)
    q = (_rms(cq, q_a_norm) @ w_qb).reshape(b, s, MLA_HEADS, MLA_NOPE + MLA_ROPE)
    kv = (_rms(ckv, kv_a_norm) @ w_kvb).reshape(b, s, MLA_HEADS, MLA_NOPE + MLA_V)
    k_nope, v_a = kv[..., :MLA_NOPE], kv[..., MLA_NOPE:]
    k_pe = jnp.broadcast_to(k_pe[:, :, None, :], (b, s, MLA_HEADS, MLA_ROPE))
    k = jnp.concatenate([k_nope, k_pe], axis=-1)
    q = _rms(q, mla_qn)
    k = _rms(k, mla_kn)
    cos, sin = _rope_tables(jnp.arange(s, dtype=jnp.int32), MLA_ROPE)
    q = jnp.concatenate([q[..., :MLA_NOPE], _apply_rope(q[..., MLA_NOPE:], cos, sin)], axis=-1)
    k = jnp.concatenate([k[..., :MLA_NOPE], _apply_rope(k[..., MLA_NOPE:], cos, sin)], axis=-1)
    o_a = _block_softmax_attention(q, k, v_a).reshape(b, s, MLA_HEADS * MLA_V)
    rows = s // GRID_W
    row = jnp.broadcast_to(jnp.arange(rows, dtype=jnp.int32)[:, None], (rows, GRID_W)).reshape(s)
    col = jnp.broadcast_to(jnp.arange(GRID_W, dtype=jnp.int32)[None, :], (rows, GRID_W)).reshape(s)
    half = GQA_HEAD_DIM // 2
    rc, rs = _rope_tables(row, half)
    cc, cs = _rope_tables(col, half)

    def axial(t):
        return jnp.concatenate([_apply_rope(t[..., :half], rc, rs), _apply_rope(t[..., half:], cc, cs)], axis=-1)

    qb = axial(_rms(qg.reshape(b, s, GQA_Q_HEADS, GQA_HEAD_DIM), gqa_qn))
    kb = axial(_rms(kg.reshape(b, s, GQA_KV_HEADS, GQA_HEAD_DIM), gqa_kn))
    vb = vg.reshape(b, s, GQA_KV_HEADS, GQA_HEAD_DIM)
    o_b = _block_softmax_attention(qb, kb, vb).reshape(b, s, GQA_Q_HEADS * GQA_HEAD_DIM)
    return jnp.concatenate([o_a, o_b], axis=-1) @ w_out


def _mixer_c(h, w_in, qn, kn, lam_q1, lam_k1, lam_q2, lam_k2, subln, w_out, rel_bias, lambda_init):
    b, s, _ = h.shape
    nq = DIFF_HEADS * 2 * DIFF_QK
    proj = h @ w_in
    q = _rms(proj[..., :nq].reshape(b, s, DIFF_HEADS, 2, DIFF_QK), qn)
    k = _rms(proj[..., nq:2 * nq].reshape(b, s, DIFF_HEADS, 2, DIFF_QK), kn)
    v = proj[..., 2 * nq:].reshape(b, s, DIFF_HEADS, DIFF_V)
    f32 = jnp.float32
    lam = (jnp.exp(jnp.sum(lam_q1.astype(f32) * lam_k1.astype(f32)))
           - jnp.exp(jnp.sum(lam_q2.astype(f32) * lam_k2.astype(f32))) + lambda_init)
    o = _diff_attention(q, k, v, lam, rel_bias)
    o = _rms(o, subln) * (1.0 - lambda_init)
    return o.reshape(b, s, C_OUT) @ w_out


def _hier_moe(h, w_group, b_group, w_expert, b_expert, w_up, w_down):
    b, s, d = h.shape
    t = b * s
    xt = h.reshape(t, d)
    pg = jax.nn.softmax((xt @ w_group).astype(jnp.float32) + b_group.astype(jnp.float32), axis=-1)
    pg_top, g_idx = lax.top_k(pg, 1)
    g = g_idx[:, 0]
    el = jnp.einsum('td,gde->tge', xt, w_expert).astype(jnp.float32) + b_expert.astype(jnp.float32)
    el = el[jnp.arange(t), g]
    pe = jax.nn.softmax(el, axis=-1)
    pe_top, e_top = lax.top_k(pe, MOE_TOP_K)
    gate = pg_top * pe_top / jnp.sum(pe_top, axis=-1, keepdims=True)
    expert = g[:, None] * MOE_EXPERTS_PER_GROUP + e_top
    n = t * MOE_TOP_K
    p_rows = n + MOE_EXPERTS * MOE_BLOCK
    n_blocks = p_rows // MOE_BLOCK
    flat_e = expert.reshape(n).astype(jnp.int32)
    flat_w = gate.reshape(n)
    flat_t = jnp.arange(n, dtype=jnp.int32) // MOE_TOP_K
    order = jnp.argsort(flat_e)
    se = flat_e[order]
    counts = jnp.zeros((MOE_EXPERTS,), jnp.int32).at[flat_e].add(1)
    starts = jnp.cumsum(counts) - counts
    padded = (counts + MOE_BLOCK - 1) // MOE_BLOCK * MOE_BLOCK
    pad_end = jnp.cumsum(padded)
    pad_start = pad_end - padded
    dest = pad_start[se] + (jnp.arange(n, dtype=jnp.int32) - starts[se])
    slot_t = jnp.zeros((p_rows,), jnp.int32).at[dest].set(flat_t[order])
    slot_w = jnp.zeros((p_rows,), jnp.float32).at[dest].set(flat_w[order])
    block_e = jnp.minimum(jnp.searchsorted(pad_end, jnp.arange(n_blocks, dtype=jnp.int32) * MOE_BLOCK, side='right'), MOE_EXPERTS - 1)
    xs = xt[slot_t].reshape(n_blocks, MOE_BLOCK, d)

    def expert_block(args):
        xb, e = args
        gu = xb @ w_up[e]
        return (jax.nn.silu(gu[:, :MOE_HIDDEN]) * gu[:, MOE_HIDDEN:]) @ w_down[e]

    ys = lax.map(expert_block, (xs, block_e)).reshape(p_rows, d)
    out = jax.ops.segment_sum(ys * slot_w[:, None].astype(ys.dtype), slot_t, num_segments=t)
    return out.reshape(b, s, d)


def setup_inputs(seed: int = 0) -> dict:
    key = jax.random.key(seed)
    keys = jax.random.split(key, 40)
    counter = [0]

    def nrm(shape, scale):
        k = keys[counter[0]]
        counter[0] += 1
        return jax.random.normal(k, shape, jnp.float32) * scale

    def gain(shape):
        return 1.0 + nrm(shape, 0.02)

    D = D_MODEL
    n_even = (DEPTH + 1) // 2
    n_odd = DEPTH // 2
    return {
        "x": nrm((BATCH, SEQ, D), 1.0),
        "c": nrm((BATCH, D), 1.0),
        "ada_w": nrm((DEPTH, D, 6 * D), 0.5 * D ** -0.5),
        "ada_b": nrm((DEPTH, 6 * D), 0.02),
        "norm_mix": gain((DEPTH, D)),
        "norm_ffn": gain((DEPTH, D)),
        "rel_bias": nrm((REL_BUCKETS, DIFF_HEADS), 0.5),
        "ab_w_in": nrm((n_even, D, AB_IN), D ** -0.5),
        "ab_q_a_norm": gain((n_even, MLA_Q_LORA)),
        "ab_w_qb": nrm((n_even, MLA_Q_LORA, MLA_HEADS * (MLA_NOPE + MLA_ROPE)), MLA_Q_LORA ** -0.5),
        "ab_kv_a_norm": gain((n_even, MLA_KV_LORA)),
        "ab_w_kvb": nrm((n_even, MLA_KV_LORA, MLA_HEADS * (MLA_NOPE + MLA_V)), MLA_KV_LORA ** -0.5),
        "ab_mla_qn": gain((n_even, MLA_NOPE + MLA_ROPE)),
        "ab_mla_kn": gain((n_even, MLA_NOPE + MLA_ROPE)),
        "ab_gqa_qn": gain((n_even, GQA_HEAD_DIM)),
        "ab_gqa_kn": gain((n_even, GQA_HEAD_DIM)),
        "ab_w_out": nrm((n_even, AB_OUT, D), AB_OUT ** -0.5),
        "c_w_in": nrm((n_odd, D, C_IN), D ** -0.5),
        "c_qn": gain((n_odd, 2, DIFF_QK)),
        "c_kn": gain((n_odd, 2, DIFF_QK)),
        "c_lam_q1": nrm((n_odd, DIFF_QK), 0.1),
        "c_lam_k1": nrm((n_odd, DIFF_QK), 0.1),
        "c_lam_q2": nrm((n_odd, DIFF_QK), 0.1),
        "c_lam_k2": nrm((n_odd, DIFF_QK), 0.1),
        "c_subln": gain((n_odd, DIFF_V)),
        "c_w_out": nrm((n_odd, C_OUT, D), C_OUT ** -0.5),
        "moe_w_group": nrm((DEPTH, D, MOE_GROUPS), D ** -0.5),
        "moe_b_group": nrm((DEPTH, MOE_GROUPS), 0.01),
        "moe_w_expert": nrm((DEPTH, MOE_GROUPS, D, MOE_EXPERTS_PER_GROUP), D ** -0.5),
        "moe_b_expert": nrm((DEPTH, MOE_GROUPS, MOE_EXPERTS_PER_GROUP), 0.01),
        "moe_w_up": nrm((DEPTH, MOE_EXPERTS, D, 2 * MOE_HIDDEN), D ** -0.5),
        "moe_w_down": nrm((DEPTH, MOE_EXPERTS, MOE_HIDDEN, D), MOE_HIDDEN ** -0.5),
    }


def reference(x, c, ada_w, ada_b, norm_mix, norm_ffn, rel_bias,
              ab_w_in, ab_q_a_norm, ab_w_qb, ab_kv_a_norm, ab_w_kvb, ab_mla_qn, ab_mla_kn,
              ab_gqa_qn, ab_gqa_kn, ab_w_out,
              c_w_in, c_qn, c_kn, c_lam_q1, c_lam_k1, c_lam_q2, c_lam_k2, c_subln, c_w_out,
              moe_w_group, moe_b_group, moe_w_expert, moe_b_expert, moe_w_up, moe_w_down):
    cond = jax.nn.silu(c)
    for l in range(DEPTH):
        mod = (cond @ ada_w[l] + ada_b[l])[:, None, :]
        shift1, scale1, gate1, shift2, scale2, gate2 = jnp.split(mod, 6, axis=-1)
        h = _rms(x, norm_mix[l]) * (1.0 + scale1) + shift1
        i = l // 2
        if l % 2 == 0:
            y = _mixer_ab(h, ab_w_in[i], ab_q_a_norm[i], ab_w_qb[i], ab_kv_a_norm[i], ab_w_kvb[i],
                          ab_mla_qn[i], ab_mla_kn[i], ab_gqa_qn[i], ab_gqa_kn[i], ab_w_out[i])
        else:
            lambda_init = 0.8 - 0.6 * math.exp(-0.3 * l)
            y = _mixer_c(h, c_w_in[i], c_qn[i], c_kn[i], c_lam_q1[i], c_lam_k1[i], c_lam_q2[i], c_lam_k2[i],
                         c_subln[i], c_w_out[i], rel_bias, lambda_init)
        x = x + gate1 * y
        h = _rms(x, norm_ffn[l]) * (1.0 + scale2) + shift2
        x = x + gate2 * _hier_moe(h, moe_w_group[l], moe_b_group[l], moe_w_expert[l], moe_b_expert[l],
                                   moe_w_up[l], moe_w_down[l])
    return x
```

```cpp
#include <hip/hip_runtime.h>
#include <cstdio>
#include <cstdint>

#ifndef MK_ONE_LAUNCH
#define MK_ONE_LAUNCH 1
#endif

namespace {
typedef unsigned short bf16_t;
typedef float f32x4 __attribute__((ext_vector_type(4)));
typedef unsigned u32x2 __attribute__((ext_vector_type(2)));
typedef unsigned u32x4 __attribute__((ext_vector_type(4)));

constexpr int T_ = 32768, S_ = 8192, NB_ = 4, D_ = 1024;
constexpr int NTHR = 512;
constexpr int LDS_BYTES = 147456;
constexpr int LDS_CTL = 131072;
constexpr float EPS_ = 1e-6f;

constexpr size_t al256(size_t x) { return (x + 255) / 256 * 256; }
constexpr size_t WS_CTL   = 0;
constexpr size_t CTL_BYTES = 65536;
constexpr size_t CW_CNT   = 16384;
constexpr size_t WS_MODP  = WS_CTL + CTL_BYTES;
constexpr size_t WS_MOD   = WS_MODP + al256((size_t)8 * 2 * 4 * 6144 * 4);
constexpr size_t WS_COS   = WS_MOD + al256((size_t)2 * 4 * 6144 * 4);
constexpr size_t WS_SIN   = WS_COS + (size_t)8192 * 16 * 4;
constexpr int P0LD = 1792;
constexpr size_t WS_WR    = WS_SIN + (size_t)8192 * 16 * 4;
constexpr size_t WS_WIN0  = WS_WR + (size_t)2 * 2 * 48 * 1024 * 2;
constexpr size_t WS_WQB   = WS_WIN0 + (size_t)P0LD * 1024 * 2;
constexpr size_t WS_WKVB  = WS_WQB + (size_t)768 * 512 * 2;
constexpr size_t WS_WOUT0 = WS_WKVB + (size_t)1024 * 256 * 2;
constexpr size_t WS_WIN1  = WS_WOUT0 + (size_t)1024 * 1024 * 2;
constexpr size_t WS_WOUT1 = WS_WIN1 + (size_t)3072 * 1024 * 2;
constexpr size_t WS_WUP   = WS_WOUT1 + (size_t)1024 * 1024 * 2;
constexpr size_t WS_WDN   = WS_WUP + (size_t)64 * 1024 * 1024 * 2;
constexpr size_t WS_HB    = WS_WDN + (size_t)64 * 1024 * 512 * 2;
constexpr size_t WS_GATEW = WS_HB + (size_t)T_ * 1024 * 2;
constexpr size_t WS_ROWSS = WS_GATEW + (size_t)T_ * 2 * 4;
constexpr size_t WS_LIST  = WS_ROWSS + (size_t)T_ * 16 * 4;
constexpr size_t WS_ARENA = WS_LIST + (size_t)32 * 65536 * 4;
constexpr size_t A_PROJ0 = WS_ARENA;
constexpr size_t A_CQN   = A_PROJ0 + (size_t)T_ * P0LD * 2;
constexpr size_t A_CKVN  = A_CQN + (size_t)T_ * 512 * 2;
constexpr size_t A_QG    = A_CKVN + (size_t)T_ * 256 * 2;
constexpr size_t A_KG    = A_QG + (size_t)T_ * 512 * 2;
constexpr size_t A_VG    = A_KG + (size_t)T_ * 128 * 2;
constexpr size_t A_QRAW  = A_VG + (size_t)T_ * 128 * 2;
constexpr size_t A_KVRAW = A_QRAW + (size_t)T_ * 768 * 2;
constexpr size_t A_QA    = A_KVRAW + (size_t)T_ * 1024 * 2;
constexpr size_t A_KA    = A_QA + (size_t)T_ * 1024 * 2;
constexpr size_t A_VA    = A_KA + (size_t)T_ * 1024 * 2;
constexpr size_t A_OB    = A_VA + (size_t)T_ * 512 * 2;
constexpr size_t A_END0  = A_OB + (size_t)T_ * 1024 * 2;
constexpr size_t A_ACT   = WS_ARENA;
constexpr size_t A_YB    = A_ACT + (size_t)(65536 + 256) * 512 * 2;
constexpr size_t A_ENDM  = A_YB + (size_t)T_ * 2 * 1024 * 2;
constexpr size_t A_QD    = WS_ARENA;
constexpr size_t A_KD    = A_QD + (size_t)T_ * 1024 * 2;
constexpr size_t A_VD    = A_KD + (size_t)T_ * 1024 * 2;
constexpr size_t A_PROJ1 = A_VD + (size_t)T_ * 1024 * 2;
constexpr size_t A_OD    = A_PROJ1;
constexpr size_t A_Q8D   = A_OD + (size_t)T_ * 1024 * 4;
constexpr size_t A_K8D   = A_Q8D + (size_t)T_ * 1024;
constexpr size_t A_VT8D  = A_K8D + (size_t)T_ * 1024;
constexpr size_t A_OB1   = A_OD + (size_t)T_ * 2048 * 4;
constexpr size_t A_END1  = A_OB1 + (size_t)T_ * 1024 * 2;
constexpr size_t WS_END  = (A_END0 > A_END1 ? (A_END0 > A_ENDM ? A_END0 : A_ENDM) : (A_END1 > A_ENDM ? A_END1 : A_ENDM));

enum { I_X = 0, I_C, I_ADAW, I_ADAB, I_NMIX, I_NFFN, I_RELB, I_ABWIN, I_ABQAN, I_ABWQB, I_ABKVAN, I_ABWKVB, I_MLAQN, I_MLAKN, I_GQAQN, I_GQAKN,
       I_ABWOUT, I_CWIN, I_CQN, I_CKN, I_LQ1, I_LK1, I_LQ2, I_LK2, I_SUBLN, I_CWOUT, I_WG, I_BG, I_WE, I_BE, I_WUP, I_WDN, N_IN };

struct Args { const float* in[N_IN]; float* out; unsigned char* ws; int ph_lo, ph_hi; };

__device__ __forceinline__ float bf2f(unsigned short h) { return __uint_as_float((unsigned)h << 16); }
__device__ __forceinline__ unsigned short f2bf(float f) { unsigned u = __float_as_uint(f); u += 0x7fffu + ((u >> 16) & 1u); return (unsigned short)(u >> 16); }
__device__ __forceinline__ unsigned pack2(float lo, float hi) { return (unsigned)f2bf(lo) | ((unsigned)f2bf(hi) << 16); }
__device__ __forceinline__ float bflo(unsigned w) { return __uint_as_float(w << 16); }
__device__ __forceinline__ float bfhi(unsigned w) { return __uint_as_float(w & 0xffff0000u); }
__device__ __forceinline__ float wave_sum(float v) {
#pragma unroll
  for (int o = 32; o >= 1; o >>= 1) v += __shfl_xor(v, o);
  return v;
}
__device__ __forceinline__ float siluf(float x) { return x / (1.f + __expf(-x)); }

#define XB_TMO      128
#define XB_XCNT(j)  (256  + 64 * (j))
#define XB_XSUB(j)  (1280 + 64 * (j))
#define XB_XGEN(j)  (2304 + 64 * (j))
#define XB_TOP      3328
#define XB_TOPGEN   3392
#define XCD_BAR_WORDS 3456
#define XB_SPIN_CAP (1u << 24)
#define LAS __attribute__((address_space(3)))

__device__ __forceinline__ unsigned xb_ld(unsigned* p)              { return __hip_atomic_load(p, __ATOMIC_RELAXED, __HIP_MEMORY_SCOPE_AGENT); }
__device__ __forceinline__ unsigned xb_add(unsigned* p, unsigned v) { return __hip_atomic_fetch_add(p, v, __ATOMIC_RELAXED, __HIP_MEMORY_SCOPE_AGENT); }
__device__ __forceinline__ unsigned xb_xcc_id() { return (unsigned)__builtin_amdgcn_s_getreg((3 << 11) | 20) & 0xFu; }
#define XB_SPIN(cond, bar) do { unsigned _sp = 0; while (cond) { __builtin_amdgcn_s_sleep(1); \
    if ((++_sp & 255u) == 0u) { if (xb_ld(&(bar)[XB_TMO])) break; if (_sp > XB_SPIN_CAP) { atomicAdd(&(bar)[XB_TMO], 1u); break; } } } } while (0)

struct XcdBarrier { unsigned* bar; unsigned x; volatile LAS unsigned* st; };

__device__ __forceinline__ XcdBarrier xcd_barrier_post(unsigned* bar, volatile LAS unsigned* st) {
    XcdBarrier b; b.bar = bar; b.x = xb_xcc_id(); b.st = st;
    if (threadIdx.x == 0) (void)xb_add(&bar[XB_XCNT(b.x)], 1u);
    return b;
}
__device__ __forceinline__ void xcd_barrier_complete(unsigned* bar, unsigned x, unsigned& nloc, unsigned& nx) {
    const unsigned G = gridDim.x * gridDim.y * gridDim.z;
    unsigned sum, cnt, mine, sp = 0u;
    for (;;) {
        sum = 0u; cnt = 0u; mine = 0u;
#pragma unroll
        for (unsigned j = 0; j < 16; ++j) { const unsigned c = xb_ld(&bar[XB_XCNT(j)]); sum += c; cnt += (c > 0u) ? 1u : 0u; mine = (j == x) ? c : mine; }
        if (sum == G) break;
        __builtin_amdgcn_s_sleep(1);
        if ((++sp & 255u) == 0u) { if (xb_ld(&bar[XB_TMO])) break; if (sp > XB_SPIN_CAP) { atomicAdd(&bar[XB_TMO], 1u); break; } }
    }
    nloc = mine > 0u ? mine : 1u; nx = cnt > 0u ? cnt : 1u;
}
__device__ __forceinline__ void xcd_barrier(const XcdBarrier& b) {
    asm volatile("s_waitcnt vmcnt(0)" ::: "memory");
    __syncthreads();
    if (threadIdx.x == 0) {
        unsigned* bar = b.bar;
        __builtin_amdgcn_s_waitcnt(0);
        unsigned nloc = b.st[0], nx = b.st[1];
        if (nloc == 0u) { xcd_barrier_complete(bar, b.x, nloc, nx); b.st[0] = nloc; b.st[1] = nx; }
        const unsigned old = xb_add(&bar[XB_XSUB(b.x)], 1u);
        const unsigned gen = old / nloc;
        if (old + 1u == (gen + 1u) * nloc) {
            __builtin_amdgcn_fence(__ATOMIC_RELEASE, "agent");
            asm volatile("s_waitcnt vmcnt(0)" ::: "memory");
            const unsigned og = xb_add(&bar[XB_TOP], 1u);
            const unsigned tg = og / nx;
            if (og + 1u == (tg + 1u) * nx) xb_add(&bar[XB_TOPGEN], 1u);
            else XB_SPIN(xb_ld(&bar[XB_TOPGEN]) == tg, bar);
            __builtin_amdgcn_fence(__ATOMIC_ACQUIRE, "agent");
            xb_add(&bar[XB_XGEN(b.x)], 1u);
            asm volatile("s_waitcnt vmcnt(0)" ::: "memory");
        } else {
            XB_SPIN(xb_ld(&bar[XB_XGEN(b.x)]) == gen, bar);
            __builtin_amdgcn_fence(__ATOMIC_ACQUIRE, "agent");
            asm volatile("s_waitcnt vmcnt(0)" ::: "memory");
        }
    }
    __syncthreads();
}

struct Frame {
  const float* in[N_IN]; float* out; unsigned char* ws; unsigned char* lds;
  int tid, lane, wave, G, bid;
};
#define WSP(T, off) ((T*)(F.ws + (off)))

__device__ __forceinline__ const float* modp(const Frame& F, int l, int b) { return WSP(const float, WS_MOD) + ((size_t)l * 4 + b) * 6144; }

__device__ __forceinline__ unsigned pk4_fp8(float a, float b, float c, float d) { int r = __builtin_amdgcn_cvt_pk_fp8_f32(a, b, 0, false); r = __builtin_amdgcn_cvt_pk_fp8_f32(c, d, r, true); return (unsigned)r; }
constexpr float MOE_WUP_SC = 64.f, MOE_WDN_SC = 32.f, MOE_ACT_SC = 4.f;
constexpr float INPROJ_W_SC = 64.f;
struct CvtJob { const float* src; bf16_t* dst; int K, Nsrc, k0, n0, perm; float f8s; };
__device__ __forceinline__ void cvt_fetch(const CvtJob& J, int tid, f32x4& v0, f32x4& v1) {
  const int r = tid >> 4, c4 = (tid & 15) * 4;
  v0 = f32x4{0.f, 0.f, 0.f, 0.f}; v1 = v0;
  if (J.n0 + c4 < J.Nsrc) {
    v0 = *(const f32x4*)(J.src + (size_t)(J.k0 + r) * J.Nsrc + J.n0 + c4);
    v1 = *(const f32x4*)(J.src + (size_t)(J.k0 + r + 32) * J.Nsrc + J.n0 + c4);
  }
}
__device__ __forceinline__ void cvt_put(const Frame& F, const f32x4& v0, const f32x4& v1) {
  float* tile = (float*)(F.lds + 1024);
  const int r = F.tid >> 4, c4 = (F.tid & 15) * 4;
  tile[r * 65 + c4 + 0] = v0[0]; tile[r * 65 + c4 + 1] = v0[1]; tile[r * 65 + c4 + 2] = v0[2]; tile[r * 65 + c4 + 3] = v0[3];
  tile[(r + 32) * 65 + c4 + 0] = v1[0]; tile[(r + 32) * 65 + c4 + 1] = v1[1]; tile[(r + 32) * 65 + c4 + 2] = v1[2]; tile[(r + 32) * 65 + c4 + 3] = v1[3];
}
__device__ __forceinline__ void cvt_emit(const Frame& F, const CvtJob& J) {
  const float* tile = (const float*)(F.lds + 1024);
  const int tid = F.tid;
  const int n = tid >> 3, kc = (tid & 7) * 8;
  int nd = J.n0 + n;
  if (J.perm) nd = (nd < 512) ? 2 * nd : 2 * (nd - 512) + 1;
  const float f8scale = J.f8s;
  if (f8scale > 0.f) {
    u32x2 w8; w8[0] = pk4_fp8(tile[(kc + 0) * 65 + n] * f8scale, tile[(kc + 1) * 65 + n] * f8scale, tile[(kc + 2) * 65 + n] * f8scale, tile[(kc + 3) * 65 + n] * f8scale);
    w8[1] = pk4_fp8(tile[(kc + 4) * 65 + n] * f8scale, tile[(kc + 5) * 65 + n] * f8scale, tile[(kc + 6) * 65 + n] * f8scale, tile[(kc + 7) * 65 + n] * f8scale);
    *(u32x2*)((unsigned char*)J.dst + (size_t)nd * J.K + J.k0 + kc) = w8;
  } else {
    u32x4 w;
    w[0] = pack2(tile[(kc + 0) * 65 + n], tile[(kc + 1) * 65 + n]);
    w[1] = pack2(tile[(kc + 2) * 65 + n], tile[(kc + 3) * 65 + n]);
    w[2] = pack2(tile[(kc + 4) * 65 + n], tile[(kc + 5) * 65 + n]);
    w[3] = pack2(tile[(kc + 6) * 65 + n], tile[(kc + 7) * 65 + n]);
    *(u32x4*)(J.dst + (size_t)nd * J.K + J.k0 + kc) = w;
  }
}

__device__ __forceinline__ void phase0(const Frame& F) {
  constexpr int J0 = 16 * 28, J1 = 8 * 12, J2 = 4 * 16, J3 = 16 * 16, J4 = 16 * 48, J5 = 16 * 16, J6 = 64 * 256, J7 = 64 * 128;
  constexpr int E0 = J0, E1 = E0 + J1, E2 = E1 + J2, E3 = E2 + J3, E4 = E3 + J4, E5 = E4 + J5, E6 = E5 + J6, E7 = E6 + J7;
  auto decode = [&](int u) -> CvtJob {
    const float* src; bf16_t* dst; int K, Nsrc, ntn, perm = 0, v; float f8s = 0.f;
    if (u < E0)      { v = u;      src = F.in[I_ABWIN];  dst = WSP(bf16_t, WS_WIN0);  K = 1024; Nsrc = 1568; ntn = 28; f8s = INPROJ_W_SC; }
    else if (u < E1) { v = u - E0; src = F.in[I_ABWQB];  dst = WSP(bf16_t, WS_WQB);   K = 512;  Nsrc = 768;  ntn = 12; }
    else if (u < E2) { v = u - E1; src = F.in[I_ABWKVB]; dst = WSP(bf16_t, WS_WKVB);  K = 256;  Nsrc = 1024; ntn = 16; }
    else if (u < E3) { v = u - E2; src = F.in[I_ABWOUT]; dst = WSP(bf16_t, WS_WOUT0); K = 1024; Nsrc = 1024; ntn = 16; }
    else if (u < E4) { v = u - E3; src = F.in[I_CWIN];   dst = WSP(bf16_t, WS_WIN1);  K = 1024; Nsrc = 3072; ntn = 48; f8s = INPROJ_W_SC; }
    else if (u < E5) { v = u - E4; src = F.in[I_CWOUT];  dst = WSP(bf16_t, WS_WOUT1); K = 1024; Nsrc = 1024; ntn = 16; }
    else if (u < E6) { v = u - E5; const int m = v >> 8; v &= 255; src = F.in[I_WUP] + (size_t)m * 1024 * 1024; dst = (bf16_t*)(WSP(unsigned char, WS_WUP) + (size_t)m * 1024 * 1024); K = 1024; Nsrc = 1024; ntn = 16; perm = 1; f8s = MOE_WUP_SC; }
    else             { v = u - E6; const int m = v >> 7; v &= 127; src = F.in[I_WDN] + (size_t)m * 512 * 1024;  dst = (bf16_t*)(WSP(unsigned char, WS_WDN) + (size_t)m * 1024 * 512);  K = 512;  Nsrc = 1024; ntn = 16; f8s = MOE_WDN_SC; }
    const int kt = v / ntn, nt = v % ntn;
    return CvtJob{src, dst, K, Nsrc, kt * 64, nt * 64, perm, f8s};
  };
  {
    int u = F.bid;
    CvtJob J = decode(u < E7 ? u : 0);
    f32x4 a0, a1;
    if (u < E7) cvt_fetch(J, F.tid, a0, a1);
    while (u < E7) {
      cvt_put(F, a0, a1);
      asm volatile("s_waitcnt lgkmcnt(0)\n\ts_barrier" ::: "memory");
      const CvtJob Jc = J;
      const int un = u + F.G;
      if (un < E7) { J = decode(un); cvt_fetch(J, F.tid, a0, a1); }
      cvt_emit(F, Jc);
      asm volatile("s_waitcnt lgkmcnt(0)\n\ts_barrier" ::: "memory");
      u = un;
    }
  }
  for (int i = F.bid * NTHR + F.tid; i < 2 * 48 * 1024; i += F.G * NTHR) {
    const int l = i / (48 * 1024), j = (i >> 10) % 48, k = i & 1023;
    float v = 0.f;
    if (j < 4) v = F.in[I_WG][((size_t)l * 1024 + k) * 4 + j];
    else if (j < 36) v = F.in[I_WE][(((size_t)l * 4 + ((j - 4) >> 3)) * 1024 + k) * 8 + ((j - 4) & 7)];
    const unsigned short hi = f2bf(v);
    WSP(unsigned short, WS_WR)[(size_t)(l * 2 + 0) * 48 * 1024 + j * 1024 + k] = hi;
    WSP(unsigned short, WS_WR)[(size_t)(l * 2 + 1) * 48 * 1024 + j * 1024 + k] = f2bf(v - bf2f(hi));
  }
  {
    float* sc = (float*)(F.lds + 1024);
    for (int u = F.bid; u < 192; u += F.G) {
      const int kc = u & 7, cb = (u >> 3) % 12, l = u / 96;
      __syncthreads();
      { const int b = F.tid >> 7, k = F.tid & 127; sc[F.tid] = siluf(F.in[I_C][b * 1024 + kc * 128 + k]); }
      __syncthreads();
      const int j = cb * 512 + F.tid;
      const float* w = F.in[I_ADAW] + ((size_t)l * 1024 + kc * 128) * 6144 + j;
      float a0 = 0.f, a1 = 0.f, a2 = 0.f, a3 = 0.f;
#pragma unroll 8
      for (int k = 0; k < 128; ++k) { const float wv = w[(size_t)k * 6144]; a0 += sc[k] * wv; a1 += sc[128 + k] * wv; a2 += sc[256 + k] * wv; a3 += sc[384 + k] * wv; }
      float* mp = WSP(float, WS_MODP) + ((size_t)kc * 2 + l) * 4 * 6144 + j;
      mp[0] = a0; mp[6144] = a1; mp[2 * 6144] = a2; mp[3 * 6144] = a3;
    }
  }
  for (int i = F.bid * NTHR + F.tid; i < 8192 * 16; i += F.G * NTHR) {
    const int pos = i >> 4, j = i & 15;
    const float inv = (float)pow(10000.0, -(double)j / 16.0);
    const float ang = (float)pos * inv;
    const double rev = (double)ang * 0.15915494309189533577;
    const float fr = (float)(rev - rint(rev));
    WSP(float, WS_COS)[i] = __builtin_amdgcn_cosf(fr);
    WSP(float, WS_SIN)[i] = __builtin_amdgcn_sinf(fr);
  }
}

__device__ __forceinline__ float mod_sum(const Frame& F, int l, int b, int idx) {
  float s = F.in[I_ADAB][l * 6144 + idx];
#pragma unroll
  for (int kc = 0; kc < 8; ++kc) s += WSP(const float, WS_MODP)[(((size_t)kc * 2 + l) * 4 + b) * 6144 + idx];
  return s;
}

template <int MODE>
__device__ __forceinline__ void phase_xnorm(const Frame& F, int l) {
  float* gs = (float*)(F.lds + 1024);
  float* sh = gs + 1024;
  float* g2 = sh + 1024;
  if (MODE == 0) {
    for (int i = F.bid * NTHR + F.tid; i < 2 * 4 * 6144; i += F.G * NTHR) {
      const int idx = i % 6144, b = (i / 6144) & 3, ll = i / (4 * 6144);
      WSP(float, WS_MOD)[i] = mod_sum(F, ll, b, idx);
    }
  }
  const float* Xin = (MODE == 0) ? F.in[I_X] : F.out;
  const bf16_t* YB = WSP(const bf16_t, A_YB);
  bf16_t* HB = WSP(bf16_t, WS_HB);
  int curb = -1;
  for (int u = F.bid; u < T_ / 64; u += F.G) {
    const int b = u >> 7;
    if (b != curb) {
      __syncthreads();
      for (int c = F.tid; c < 1024; c += NTHR) {
        if (MODE == 0) { gs[c] = F.in[I_NMIX][l * 1024 + c] * (1.f + mod_sum(F, l, b, 1024 + c)); sh[c] = mod_sum(F, l, b, c); }
        if (MODE == 1) { gs[c] = F.in[I_NMIX][l * 1024 + c] * (1.f + modp(F, l, b)[1024 + c]); sh[c] = modp(F, l, b)[c]; }
        if (MODE >= 1) g2[c] = modp(F, l - (MODE == 1 ? 1 : 0), b)[5120 + c];
      }
      __syncthreads(); curb = b;
    }
    for (int i = 0; i < 8; ++i) {
      const size_t t = (size_t)u * 64 + F.wave * 8 + i;
      f32x4 v[4];
#pragma unroll
      for (int k = 0; k < 4; ++k) v[k] = *(const f32x4*)(Xin + t * 1024 + k * 256 + F.lane * 4);
      if (MODE >= 1) {
#pragma unroll
        for (int k = 0; k < 4; ++k) {
          const int c = k * 256 + F.lane * 4;
          const u32x2 y0 = *(const u32x2*)(YB + (t * 2) * 1024 + c), y1 = *(const u32x2*)(YB + (t * 2 + 1) * 1024 + c);
          v[k][0] += g2[c + 0] * (bflo(y0[0]) + bflo(y1[0]));
          v[k][1] += g2[c + 1] * (bfhi(y0[0]) + bfhi(y1[0]));
          v[k][2] += g2[c + 2] * (bflo(y0[1]) + bflo(y1[1]));
          v[k][3] += g2[c + 3] * (bfhi(y0[1]) + bfhi(y1[1]));
          *(f32x4*)(F.out + t * 1024 + c) = v[k];
        }
      }
      if (MODE <= 1) {
        float ss = 0.f;
#pragma unroll
        for (int k = 0; k < 4; ++k) ss += v[k][0] * v[k][0] + v[k][1] * v[k][1] + v[k][2] * v[k][2] + v[k][3] * v[k][3];
        ss = wave_sum(ss);
        const float r = rsqrtf(ss * (1.f / 1024.f) + EPS_);
#pragma unroll
        for (int k = 0; k < 4; ++k) {
          const int c = k * 256 + F.lane * 4;
          const float h0 = v[k][0] * r * gs[c] + sh[c], h1 = v[k][1] * r * gs[c + 1] + sh[c + 1], h2 = v[k][2] * r * gs[c + 2] + sh[c + 2], h3 = v[k][3] * r * gs[c + 3] + sh[c + 3];
          *(unsigned*)((unsigned char*)HB + t * 1024 + c) = pk4_fp8(h0, h1, h2, h3);
        }
      }
    }
  }
}

__device__ __forceinline__ float gain_absmax(const Frame& F, const float* g, int n) {
  float* red = (float*)(F.lds + LDS_CTL + 1024);
  float m = 0.f;
  for (int i = F.tid; i < n; i += NTHR) m = fmaxf(m, fabsf(g[i]));
#pragma unroll
  for (int o = 32; o >= 1; o >>= 1) m = fmaxf(m, __shfl_xor(m, o));
  __syncthreads();
  if (F.lane == 0) red[F.wave] = m;
  __syncthreads();
  float r = red[0];
#pragma unroll
  for (int w = 1; w < 8; ++w) r = fmaxf(r, red[w]);
  return r;
}
constexpr float LOG2E = 1.4426950408889634f;
constexpr float PP_BF8 = 20.f;
constexpr float PP_BOUND = 60.f;


__device__ __forceinline__ int vt_pos(int tau) { const int kq = tau & 31, i = kq >> 3, r = kq & 7; return (tau & 32) + ((r < 4) ? (4 * i + r) : (16 + 4 * i + (r - 4))); }
__device__ __forceinline__ int vt_pos0(int tau) { return 32 * ((tau >> 2) & 1) + 16 * (tau >> 5) + 4 * ((tau & 31) >> 3) + (tau & 3); }
__device__ __forceinline__ float pp_mla_bound(const Frame& F) { return 9.797959f * gain_absmax(F, F.in[I_MLAQN], 96) * gain_absmax(F, F.in[I_MLAKN], 96) * LOG2E * 1.04f; }
__device__ __forceinline__ bool pp_mla_ok(const Frame& F) { return pp_mla_bound(F) <= PP_BF8; }
__device__ __forceinline__ float pp_diff_bound(const Frame& F) { return (8.f * gain_absmax(F, F.in[I_CQN], 128) * gain_absmax(F, F.in[I_CKN], 128) * 1.04f + gain_absmax(F, F.in[I_RELB], 256)) * LOG2E; }
constexpr float PP_F16 = 15.9f;
__device__ __forceinline__ bool pp_diff_ok(const Frame& F) { return pp_diff_bound(F) <= PP_F16; }
__device__ __forceinline__ float pp_gqa_bound(const Frame& F) { return 8.f * gain_absmax(F, F.in[I_GQAQN], 64) * gain_absmax(F, F.in[I_GQAKN], 64) * LOG2E * 1.04f; }
__device__ __forceinline__ bool pp_gqa_ok(const Frame& F) { return pp_gqa_bound(F) <= PP_BF8; }

__device__ __forceinline__ void phase_split0(const Frame& F) {
  const bf16_t* PROJ = WSP(const bf16_t, A_PROJ0);
  bf16_t* CQN = WSP(bf16_t, A_CQN); bf16_t* CKVN = WSP(bf16_t, A_CKVN);
  bf16_t* QG = WSP(bf16_t, A_QG); bf16_t* KG = WSP(bf16_t, A_KG); bf16_t* VG = WSP(bf16_t, A_VG);
  unsigned char* QG8 = WSP(unsigned char, A_QG); unsigned char* KG8 = WSP(unsigned char, A_KG); unsigned char* VGT8 = WSP(unsigned char, A_VG);
  const float* COS = WSP(const float, WS_COS); const float* SIN = WSP(const float, WS_SIN);
  const int lane = F.lane;
  const bool pp = pp_gqa_ok(F);
  unsigned char* vt = F.lds + 1024;
  for (int u = F.bid; u < T_ / 64; u += F.G) {
   for (int tb = 0; tb < 8; tb += 4) {
    u32x4 Lcq[4], Lgq[4], Lgk[4], Lgv[4]; u32x2 Lckv[4]; float Lcs[4][8], Lsn[4][8];
#pragma unroll
    for (int k = 0; k < 4; ++k) {
      const int t = u * 64 + F.wave * 8 + tb + k, s = t & 8191;
      const bf16_t* row = PROJ + (size_t)t * P0LD;
      Lcq[k] = *(const u32x4*)(row + lane * 8);
      Lckv[k] = *(const u32x2*)(row + 512 + lane * 4);
      Lgq[k] = *(const u32x4*)(row + 800 + lane * 8);
      Lgk[k] = u32x4{0u, 0u, 0u, 0u}; Lgv[k] = u32x4{0u, 0u, 0u, 0u};
      if (lane < 16) { Lgk[k] = *(const u32x4*)(row + 1312 + lane * 8); Lgv[k] = *(const u32x4*)(row + 1440 + lane * 8); }
      const int pos = ((lane & 7) < 4) ? (s >> 6) : (s & 63), jb = (lane & 1) * 8;
#pragma unroll
      for (int i = 0; i < 8; ++i) { Lcs[k][i] = COS[pos * 16 + jb + i]; Lsn[k][i] = SIN[pos * 16 + jb + i]; }
    }
#pragma unroll
    for (int k = 0; k < 4; ++k) {
    const int ti = tb + k;
    const int tau = F.wave * 8 + ti, t = u * 64 + tau;
    const int b = t >> 13, s = t & 8191;
    {
      const u32x4 w = Lcq[k];
      float x[8] = {bflo(w[0]), bfhi(w[0]), bflo(w[1]), bfhi(w[1]), bflo(w[2]), bfhi(w[2]), bflo(w[3]), bfhi(w[3])};
      float ss = 0.f;
#pragma unroll
      for (int i = 0; i < 8; ++i) ss += x[i] * x[i];
      ss = wave_sum(ss);
      const float r = rsqrtf(ss * (1.f / 512.f) + EPS_);
      const float* g = F.in[I_ABQAN] + lane * 8;
      u32x4 o;
#pragma unroll
      for (int i = 0; i < 4; ++i) o[i] = pack2(x[2 * i] * r * g[2 * i], x[2 * i + 1] * r * g[2 * i + 1]);
      *(u32x4*)(CQN + (size_t)t * 512 + lane * 8) = o;
    }
    {
      const u32x2 w = Lckv[k];
      float x[4] = {bflo(w[0]), bfhi(w[0]), bflo(w[1]), bfhi(w[1])};
      float ss = x[0] * x[0] + x[1] * x[1] + x[2] * x[2] + x[3] * x[3];
      ss = wave_sum(ss);
      const float r = rsqrtf(ss * (1.f / 256.f) + EPS_);
      const float* g = F.in[I_ABKVAN] + lane * 4;
      u32x2 o; o[0] = pack2(x[0] * r * g[0], x[1] * r * g[1]); o[1] = pack2(x[2] * r * g[2], x[3] * r * g[3]);
      *(u32x2*)(CKVN + (size_t)t * 256 + lane * 4) = o;
    }
#pragma unroll
    for (int which = 0; which < 2; ++which) {
      const bool act = (which == 0) || (lane < 16);
      const u32x4 w = (which == 0) ? Lgq[k] : Lgk[k];
      float x[8] = {bflo(w[0]), bfhi(w[0]), bflo(w[1]), bfhi(w[1]), bflo(w[2]), bfhi(w[2]), bflo(w[3]), bfhi(w[3])};
      float ss = 0.f;
#pragma unroll
      for (int i = 0; i < 8; ++i) ss += x[i] * x[i];
      ss += __shfl_xor(ss, 1); ss += __shfl_xor(ss, 2); ss += __shfl_xor(ss, 4);
      const float r = rsqrtf(ss * (1.f / 64.f) + EPS_);
      const int ch = lane & 7;
      const float* g = F.in[which == 0 ? I_GQAQN : I_GQAKN] + ch * 8;
#pragma unroll
      for (int i = 0; i < 8; ++i) x[i] = x[i] * r * g[i];
      const bool second = (ch & 2) != 0;
      float y[8];
#pragma unroll
      for (int i = 0; i < 8; ++i) {
        const float p = __shfl_xor(x[i], 2);
        const float cs = Lcs[k][i], sn = Lsn[k][i];
        y[i] = second ? (x[i] * cs + p * sn) : (x[i] * cs - p * sn);
      }
      const float qs = (which == 0) ? (0.125f * 1.4426950408889634f * (pp ? 8.f : 1.f)) : 1.f;
      const int hd = lane >> 3;
      if (pp) {
        u32x2 o; o[0] = pk4_fp8(y[0] * qs, y[1] * qs, y[2] * qs, y[3] * qs); o[1] = pk4_fp8(y[4] * qs, y[5] * qs, y[6] * qs, y[7] * qs);
        if (act) {
          if (which == 0) *(u32x2*)(QG8 + (((size_t)b * 8 + hd) * S_ + s) * 64 + ch * 8) = o;
          else            *(u32x2*)(KG8 + (((size_t)b * 2 + hd) * S_ + s) * 64 + ch * 8) = o;
        }
      } else {
        u32x4 o;
#pragma unroll
        for (int i = 0; i < 4; ++i) o[i] = pack2(y[2 * i] * qs, y[2 * i + 1] * qs);
        if (act) {
          if (which == 0) *(u32x4*)(QG + (((size_t)b * 8 + hd) * S_ + s) * 64 + ch * 8) = o;
          else            *(u32x4*)(KG + (((size_t)b * 2 + hd) * S_ + s) * 64 + ch * 8) = o;
        }
      }
    }
    if (lane < 16) {
      const u32x4 w = Lgv[k];
      if (pp) {
        const unsigned a = pk4_fp8(bflo(w[0]), bfhi(w[0]), bflo(w[1]), bfhi(w[1])), c = pk4_fp8(bflo(w[2]), bfhi(w[2]), bflo(w[3]), bfhi(w[3]));
        unsigned char* dst = vt + ((lane >> 3) * 64 + (lane & 7) * 8) * 64 + vt_pos0(tau);
        dst[0 * 64] = (unsigned char)a; dst[1 * 64] = (unsigned char)(a >> 8); dst[2 * 64] = (unsigned char)(a >> 16); dst[3 * 64] = (unsigned char)(a >> 24);
        dst[4 * 64] = (unsigned char)c; dst[5 * 64] = (unsigned char)(c >> 8); dst[6 * 64] = (unsigned char)(c >> 16); dst[7 * 64] = (unsigned char)(c >> 24);
      } else {
        *(u32x4*)(VG + (((size_t)b * 2 + (lane >> 3)) * S_ + s) * 64 + (lane & 7) * 8) = w;
      }
    }
    }
   }
   if (pp) {
     __syncthreads();
     const int t0 = u * 64, b = t0 >> 13, s0 = t0 & 8191, rid = F.tid >> 2, chk = F.tid & 3;
     *(u32x4*)(VGT8 + ((size_t)(b * 2 * 64 + rid)) * S_ + s0 + chk * 16) = *(const u32x4*)(vt + rid * 64 + chk * 16);
     __syncthreads();
   }
  }
}

__device__ __forceinline__ void phase_mla(const Frame& F) {
  const bf16_t* PROJ = WSP(const bf16_t, A_PROJ0);
  const bf16_t* QRAW = WSP(const bf16_t, A_QRAW); const bf16_t* KVRAW = WSP(const bf16_t, A_KVRAW);
  bf16_t* QA = WSP(bf16_t, A_QA); bf16_t* KA = WSP(bf16_t, A_KA); bf16_t* VA = WSP(bf16_t, A_VA);
  unsigned char* QA8 = WSP(unsigned char, A_QA); unsigned char* KA8 = WSP(unsigned char, A_KA); unsigned char* VAT8 = WSP(unsigned char, A_VA);
  const float* COS = WSP(const float, WS_COS); const float* SIN = WSP(const float, WS_SIN);
  const int lane = F.lane, hd = lane >> 3, ch = lane & 7;
  const bool pp = pp_mla_ok(F);
  unsigned char* vt = F.lds + 1024;
  for (int u = F.bid; u < T_ / 64; u += F.G) {
   for (int tb = 0; tb < 8; tb += 4) {
    u32x4 Lq[4], Lkv[4], Lv[4]; u32x2 Lqr[4], Lkr[4]; float Lcs[4][4], Lsn[4][4];
#pragma unroll
    for (int k = 0; k < 4; ++k) {
      const int t = u * 64 + F.wave * 8 + tb + k, s = t & 8191;
      Lq[k] = *(const u32x4*)(QRAW + (size_t)t * 768 + hd * 96 + ch * 8);
      Lqr[k] = *(const u32x2*)(QRAW + (size_t)t * 768 + hd * 96 + 64 + ch * 4);
      Lkv[k] = *(const u32x4*)(KVRAW + (size_t)t * 1024 + hd * 128 + ch * 8);
      Lkr[k] = *(const u32x2*)(PROJ + (size_t)t * P0LD + 768 + ch * 4);
      Lv[k] = *(const u32x4*)(KVRAW + (size_t)t * 1024 + hd * 128 + 64 + ch * 8);
#pragma unroll
      for (int i = 0; i < 4; ++i) { Lcs[k][i] = COS[s * 16 + (ch & 3) * 4 + i]; Lsn[k][i] = SIN[s * 16 + (ch & 3) * 4 + i]; }
    }
#pragma unroll
    for (int k = 0; k < 4; ++k) {
    const int ti = tb + k;
    const int tau = F.wave * 8 + ti, t = u * 64 + tau;
    const int b = t >> 13, s = t & 8191;
#pragma unroll
    for (int which = 0; which < 2; ++which) {
      float xn[8], xr[4];
      if (which == 0) {
        const u32x4 w = Lq[k];
        const u32x2 v = Lqr[k];
        xn[0] = bflo(w[0]); xn[1] = bfhi(w[0]); xn[2] = bflo(w[1]); xn[3] = bfhi(w[1]); xn[4] = bflo(w[2]); xn[5] = bfhi(w[2]); xn[6] = bflo(w[3]); xn[7] = bfhi(w[3]);
        xr[0] = bflo(v[0]); xr[1] = bfhi(v[0]); xr[2] = bflo(v[1]); xr[3] = bfhi(v[1]);
      } else {
        const u32x4 w = Lkv[k];
        const u32x2 v = Lkr[k];
        xn[0] = bflo(w[0]); xn[1] = bfhi(w[0]); xn[2] = bflo(w[1]); xn[3] = bfhi(w[1]); xn[4] = bflo(w[2]); xn[5] = bfhi(w[2]); xn[6] = bflo(w[3]); xn[7] = bfhi(w[3]);
        xr[0] = bflo(v[0]); xr[1] = bfhi(v[0]); xr[2] = bflo(v[1]); xr[3] = bfhi(v[1]);
      }
      float ss = 0.f;
#pragma unroll
      for (int i = 0; i < 8; ++i) ss += xn[i] * xn[i];
#pragma unroll
      for (int i = 0; i < 4; ++i) ss += xr[i] * xr[i];
      ss += __shfl_xor(ss, 1); ss += __shfl_xor(ss, 2); ss += __shfl_xor(ss, 4);
      const float r = rsqrtf(ss * (1.f / 96.f) + EPS_);
      const float* g = F.in[which == 0 ? I_MLAQN : I_MLAKN];
#pragma unroll
      for (int i = 0; i < 8; ++i) xn[i] = xn[i] * r * g[ch * 8 + i];
#pragma unroll
      for (int i = 0; i < 4; ++i) xr[i] = xr[i] * r * g[64 + ch * 4 + i];
      const bool second = (ch & 4) != 0;
      float y[4];
#pragma unroll
      for (int i = 0; i < 4; ++i) {
        const float p = __shfl_xor(xr[i], 4);
        const float cs = Lcs[k][i], sn = Lsn[k][i];
        y[i] = second ? (xr[i] * cs + p * sn) : (xr[i] * cs - p * sn);
      }
      const float qs = (which == 0) ? (0.10206207261596575f * 1.4426950408889634f * (pp ? 8.f : 1.f)) : 1.f;
      if (pp) {
        unsigned char* dst = (which == 0 ? QA8 : KA8) + (((size_t)b * 8 + hd) * S_ + s) * 128;
        u32x2 o; o[0] = pk4_fp8(xn[0] * qs, xn[1] * qs, xn[2] * qs, xn[3] * qs); o[1] = pk4_fp8(xn[4] * qs, xn[5] * qs, xn[6] * qs, xn[7] * qs);
        *(u32x2*)(dst + ch * 8) = o;
        *(unsigned*)(dst + 64 + ch * 4) = pk4_fp8(y[0] * qs, y[1] * qs, y[2] * qs, y[3] * qs);
        *(unsigned*)(dst + 96 + ch * 4) = 0u;
      } else {
        bf16_t* dst = (which == 0 ? QA : KA) + (((size_t)b * 8 + hd) * S_ + s) * 128;
        u32x4 o;
#pragma unroll
        for (int i = 0; i < 4; ++i) o[i] = pack2(xn[2 * i] * qs, xn[2 * i + 1] * qs);
        *(u32x4*)(dst + ch * 8) = o;
        u32x2 o2; o2[0] = pack2(y[0] * qs, y[1] * qs); o2[1] = pack2(y[2] * qs, y[3] * qs);
        *(u32x2*)(dst + 64 + ch * 4) = o2;
        u32x2 z; z[0] = 0u; z[1] = 0u;
        *(u32x2*)(dst + 96 + ch * 4) = z;
      }
    }
    {
      const u32x4 w = Lv[k];
      if (pp) {
        const unsigned a = pk4_fp8(bflo(w[0]), bfhi(w[0]), bflo(w[1]), bfhi(w[1])), c = pk4_fp8(bflo(w[2]), bfhi(w[2]), bflo(w[3]), bfhi(w[3]));
        unsigned char* dst = vt + (hd * 64 + ch * 8) * 64 + vt_pos0(tau);
        dst[0 * 64] = (unsigned char)a; dst[1 * 64] = (unsigned char)(a >> 8); dst[2 * 64] = (unsigned char)(a >> 16); dst[3 * 64] = (unsigned char)(a >> 24);
        dst[4 * 64] = (unsigned char)c; dst[5 * 64] = (unsigned char)(c >> 8); dst[6 * 64] = (unsigned char)(c >> 16); dst[7 * 64] = (unsigned char)(c >> 24);
      } else {
        *(u32x4*)(VA + (((size_t)b * 8 + hd) * S_ + s) * 64 + ch * 8) = w;
      }
    }
    }
   }
   if (pp) {
     __syncthreads();
     const int t0 = u * 64, b = t0 >> 13, s0 = t0 & 8191;
#pragma unroll
     for (int q = 0; q < 4; ++q) { const int idx = F.tid + q * NTHR, rid = idx >> 2, chk = idx & 3;
       *(u32x4*)(VAT8 + ((size_t)(b * 8 * 64 + rid)) * S_ + s0 + chk * 16) = *(const u32x4*)(vt + rid * 64 + chk * 16); }
     __syncthreads();
   }
  }
}


__device__ __forceinline__ void phase_vt1(const Frame& F) {
  const bf16_t* VD = WSP(const bf16_t, A_VD);
  unsigned char* VT = WSP(unsigned char, A_VT8D);
  unsigned char* vt = F.lds + 1024;
  for (int u = F.bid; u < 32 * 128; u += F.G) {
    const int bh = u >> 7, s0 = (u & 127) * 64;
#pragma unroll
    for (int q = 0; q < 2; ++q) {
      const int idx = F.tid + q * NTHR, tau = idx >> 4, c8 = (idx & 15) * 8;
      const u32x4 w = *(const u32x4*)(VD + ((size_t)bh * S_ + s0 + tau) * 128 + c8);
      const unsigned a = pk4_fp8(bflo(w[0]), bfhi(w[0]), bflo(w[1]), bfhi(w[1])), c = pk4_fp8(bflo(w[2]), bfhi(w[2]), bflo(w[3]), bfhi(w[3]));
      unsigned char* dst = vt + c8 * 64 + vt_pos0(tau);
      dst[0 * 64] = (unsigned char)a; dst[1 * 64] = (unsigned char)(a >> 8); dst[2 * 64] = (unsigned char)(a >> 16); dst[3 * 64] = (unsigned char)(a >> 24);
      dst[4 * 64] = (unsigned char)c; dst[5 * 64] = (unsigned char)(c >> 8); dst[6 * 64] = (unsigned char)(c >> 16); dst[7 * 64] = (unsigned char)(c >> 24);
    }
    __syncthreads();
    { const int rid = F.tid >> 2, chk = F.tid & 3;
      *(u32x4*)(VT + ((size_t)bh * 128 + rid) * S_ + s0 + chk * 16) = *(const u32x4*)(vt + rid * 64 + chk * 16); }
    __syncthreads();
  }
}

__device__ __forceinline__ void phase_route(const Frame& F, int l) {
  typedef short bf16x8_t __attribute__((ext_vector_type(8)));
  constexpr int KC = 128, LDX = KC + 8;
  float* gs = (float*)(F.lds + 1024);
  float* sh = gs + 1024;
  float* rs = sh + 1024;
  bf16_t* XH = (bf16_t*)(rs + 64);
  bf16_t* XL = XH + 64 * LDX;
  bf16_t* WH = XL + 64 * LDX;
  bf16_t* WL = WH + 48 * LDX;
  float* lg = (float*)(WL + 48 * LDX);
  int* cnt = (int*)(lg + 64 * 49);
  int* base = cnt + 32;
  unsigned char* HB8 = WSP(unsigned char, WS_HB);
  const float* X = F.out;
  unsigned* COUNT = (unsigned*)(F.ws + WS_CTL + CW_CNT) + l * 32;
  int* LIST = WSP(int, WS_LIST); float* GATEW = WSP(float, WS_GATEW);
  const int lane = F.lane, mb = F.wave & 3, nb0 = (F.wave >> 2) ? 2 : 0, nnb = (F.wave >> 2) ? 1 : 2;
  int curb = -1;
  const bf16_t* WRg = WSP(const bf16_t, WS_WR) + (size_t)l * 2 * 48 * 1024;
  for (int u = F.bid; u < T_ / 64; u += F.G) {
    const int b = u >> 7;
    __syncthreads();
    if (b != curb) {
      for (int c = F.tid; c < 1024; c += NTHR) { gs[c] = F.in[I_NFFN][l * 1024 + c] * (1.f + modp(F, l, b)[4096 + c]); sh[c] = modp(F, l, b)[3072 + c]; }
      curb = b;
    }
    if (F.tid < 32) cnt[F.tid] = 0;
    if (F.tid < 64) {
      const float* sp = WSP(const float, WS_ROWSS) + ((size_t)u * 64 + F.tid) * 16;
      float ss = 0.f;
#pragma unroll
      for (int q = 0; q < 4; ++q) { const f32x4 v = *(const f32x4*)(sp + 4 * q); ss += v[0]; ss += v[1]; ss += v[2]; ss += v[3]; }
      rs[F.tid] = rsqrtf(ss * (1.f / 1024.f) + EPS_);
    }
    f32x4 acc[2] = {{0.f, 0.f, 0.f, 0.f}, {0.f, 0.f, 0.f, 0.f}};
    u32x4 wpre[3]; f32x4 xpre[4];
#define RT_FETCH(kc_) do { \
      _Pragma("unroll") for (int q = 0; q < 3; ++q) { const int idx = F.tid + NTHR * q, img = idx / 768, rem = idx % 768, row = rem >> 4, seg = rem & 15; \
        wpre[q] = *(const u32x4*)(WRg + ((size_t)img * 48 + row) * 1024 + (kc_) * KC + seg * 8); } \
      _Pragma("unroll") for (int i = 0; i < 4; ++i) { const int tl = F.wave * 8 + 2 * i + (lane >> 5); \
        xpre[i] = *(const f32x4*)(X + ((size_t)u * 64 + tl) * 1024 + (kc_) * KC + (lane & 31) * 4); } } while (0)
    RT_FETCH(0);
    for (int kc = 0; kc < 1024 / KC; ++kc) {
      __syncthreads();
#pragma unroll
      for (int q = 0; q < 3; ++q) { const int idx = F.tid + NTHR * q, img = idx / 768, rem = idx % 768, row = rem >> 4, seg = rem & 15;
        *(u32x4*)((img ? WL : WH) + row * LDX + seg * 8) = wpre[q]; }
#pragma unroll
      for (int i = 0; i < 4; ++i) {
        const int tl = F.wave * 8 + 2 * i + (lane >> 5); const size_t t = (size_t)u * 64 + tl;
        const int cl = (lane & 31) * 4, c = kc * KC + cl;
        const f32x4 v = xpre[i];
        const float r = rs[tl];
        const float h0 = v[0] * r * gs[c] + sh[c], h1 = v[1] * r * gs[c + 1] + sh[c + 1], h2 = v[2] * r * gs[c + 2] + sh[c + 2], h3 = v[3] * r * gs[c + 3] + sh[c + 3];
        u32x2 w; w[0] = pack2(h0, h1); w[1] = pack2(h2, h3);
        *(unsigned*)(HB8 + t * 1024 + c) = pk4_fp8(h0, h1, h2, h3);
        *(u32x2*)(XH + tl * LDX + cl) = w;
        u32x2 wl; wl[0] = pack2(h0 - bflo(w[0]), h1 - bfhi(w[0])); wl[1] = pack2(h2 - bflo(w[1]), h3 - bfhi(w[1]));
        *(u32x2*)(XL + tl * LDX + cl) = wl;
      }
      if (kc + 1 < 1024 / KC) RT_FETCH(kc + 1);
      __syncthreads();
#pragma unroll
      for (int ks = 0; ks < KC / 32; ++ks) {
        const int xo = (mb * 16 + (lane & 15)) * LDX + ks * 32 + 8 * (lane >> 4);
        const bf16x8_t ah = *(const bf16x8_t*)(XH + xo), al = *(const bf16x8_t*)(XL + xo);
#pragma unroll
        for (int q = 0; q < 2; ++q) if (q < nnb) {
          const int wo = ((nb0 + q) * 16 + (lane & 15)) * LDX + ks * 32 + 8 * (lane >> 4);
          const bf16x8_t bh = *(const bf16x8_t*)(WH + wo), bl = *(const bf16x8_t*)(WL + wo);
          acc[q] = __builtin_amdgcn_mfma_f32_16x16x32_bf16(ah, bh, acc[q], 0, 0, 0);
          acc[q] = __builtin_amdgcn_mfma_f32_16x16x32_bf16(ah, bl, acc[q], 0, 0, 0);
          acc[q] = __builtin_amdgcn_mfma_f32_16x16x32_bf16(al, bh, acc[q], 0, 0, 0);
        }
      }
    }
#undef RT_FETCH
#pragma unroll
    for (int q = 0; q < 2; ++q) if (q < nnb) {
#pragma unroll
      for (int r = 0; r < 4; ++r) lg[(mb * 16 + 4 * (lane >> 4) + r) * 49 + (nb0 + q) * 16 + (lane & 15)] = acc[q][r];
    }
    __syncthreads();
    int e0 = 0, e1 = 0, i0 = 0, i1 = 0; float w0 = 0.f, w1 = 0.f;
    if (F.tid < 64) {
      const float* L = lg + F.tid * 49;
      const float* bg = F.in[I_BG] + l * 4; const float* be = F.in[I_BE] + l * 32;
      float gl[4]; int g = 0; float gm;
#pragma unroll
      for (int j = 0; j < 4; ++j) gl[j] = L[j] + bg[j];
      gm = gl[0];
#pragma unroll
      for (int j = 1; j < 4; ++j) if (gl[j] > gm) { gm = gl[j]; g = j; }
      float gsum = 0.f;
#pragma unroll
      for (int j = 0; j < 4; ++j) gsum += __expf(gl[j] - gm);
      const float pg = 1.f / gsum;
      float el[8];
#pragma unroll
      for (int j = 0; j < 8; ++j) el[j] = L[4 + g * 8 + j] + be[g * 8 + j];
      int a0 = 0; float m0 = el[0];
#pragma unroll
      for (int j = 1; j < 8; ++j) if (el[j] > m0) { m0 = el[j]; a0 = j; }
      int a1 = -1; float m1 = -3.0e38f;
#pragma unroll
      for (int j = 0; j < 8; ++j) if (j != a0 && el[j] > m1) { m1 = el[j]; a1 = j; }
      const float ex = __expf(m1 - m0);
      w0 = pg / (1.f + ex); w1 = pg * ex / (1.f + ex);
      e0 = g * 8 + a0; e1 = g * 8 + a1;
      i0 = atomicAdd(&cnt[e0], 1); i1 = atomicAdd(&cnt[e1], 1);
    }
    __syncthreads();
    if (F.tid < 32) base[F.tid] = (int)__hip_atomic_fetch_add(COUNT + F.tid, (unsigned)cnt[F.tid], __ATOMIC_RELAXED, __HIP_MEMORY_SCOPE_AGENT);
    __syncthreads();
    if (F.tid < 64) {
      const int t = u * 64 + F.tid;
      LIST[(size_t)e0 * 65536 + base[e0] + i0] = t * 2;
      LIST[(size_t)e1 * 65536 + base[e1] + i1] = t * 2 + 1;
      GATEW[t * 2] = w0; GATEW[t * 2 + 1] = w1;
    }
  }
}


namespace pg {
typedef short bf16x8 __attribute__((ext_vector_type(8)));
typedef int i32x4_t __attribute__((ext_vector_type(4)));
typedef int i32x8_t __attribute__((ext_vector_type(8)));
constexpr int BM = 256, BK = 64, HALF = 128, HTB = HALF * BK * 2, STAGE_BYTES = 8 * HTB, NXCD = 8, WGM = 8;
__device__ __forceinline__ int lds_byte(int r, int c) { const int st = (r >> 4) * 2 + (c >> 5), rr = r & 15, cc = c & 31, ob = rr * 64 + cc * 2; return st * 1024 + (ob ^ (((ob >> 9) & 1) << 5)); }
__device__ __forceinline__ void stage_rc(int b, int& R, int& C) { const int st = b / 1024, sb = b % 1024, swz = sb ^ (((sb >> 9) & 1) << 5); R = (st >> 1) * 16 + swz / 64; C = (st & 1) * 32 + (swz % 64) / 2; }
__device__ __forceinline__ int perm32(int rho) { const int n = rho >> 4, i = rho & 15; return 8 * (i >> 2) + 4 * n + (i & 3); }
__device__ __forceinline__ unsigned cvt_pk_bf16(float lo, float hi) { unsigned r; asm volatile("v_cvt_pk_bf16_f32 %0, %1, %2" : "=v"(r) : "v"(lo), "v"(hi)); return r; }

struct GUnit { const char* A; const char* B; const int* lst; int row0, col0, nrow, e; };

struct DenseOrder {
  const char* A; const char* Bt; int K, nM, nN, nwg, G, c;
  __device__ void init(const bf16_t* A_, const bf16_t* Bt_, int M, int N, int K_, int G_, int c_) { A = (const char*)A_; Bt = (const char*)Bt_; K = K_; nM = M / BM; nN = N / BM; nwg = nM * nN; G = G_; c = c_; }
  __device__ __forceinline__ bool next(int i, GUnit& u) const {
    const long L = (long)i * G + c; if (L >= nwg) return false;
    int wgid = (int)L; { const int q = nwg / NXCD, r = nwg % NXCD, xcd = wgid % NXCD, off = wgid / NXCD; wgid = (xcd < r ? xcd * (q + 1) : r * (q + 1) + (xcd - r) * q) + off; }
    const int nig = WGM * nN, gid = wgid / nig, fm = gid * WGM, gsz = (nM - fm) < WGM ? (nM - fm) : WGM;
    const int pm = fm + ((wgid % nig) % gsz), pn = (wgid % nig) / gsz;
    u.A = A + (size_t)pm * BM * K * 2; u.B = Bt + (size_t)pn * BM * K * 2; u.lst = nullptr; u.row0 = pm * BM; u.col0 = pn * BM; u.nrow = BM; u.e = 0;
    return true;
  }
};
struct MoeOrder {
  const int* tstart; const int* sbase; const int* cntl; const char* Abase; const char* Wbase; const int* LIST; int K, G, c, up;
  __device__ __forceinline__ bool next(int i, GUnit& u) const {
    const int L = i * G + c; if (L >= tstart[32] * 4) return false;
    const int rtg = L >> 2, pn = L & 3;
    int e = 0; while (tstart[e + 1] <= rtg) ++e;
    const int rt = rtg - tstart[e];
    u.e = e; u.nrow = cntl[e] - rt * BM; if (u.nrow > BM) u.nrow = BM;
    u.lst = LIST + (size_t)e * 65536 + rt * BM; u.row0 = sbase[e] + rt * BM; u.col0 = pn * BM;
    u.A = up ? Abase : Abase + (size_t)u.row0 * K * 2;
    u.B = Wbase + ((size_t)e * 1024 + pn * BM) * K * 2;
    return true;
  }
};

struct EpiStoreBf16 {
  static constexpr bool PERM = true;
  bf16_t* O; int ldc;
  __device__ __forceinline__ void operator()(const f32x4 (&acc)[2][2][4][2], const GUnit& u, int wr, int wc, int fr, int fq) const {
#pragma unroll
    for (int ai = 0; ai < 2; ++ai)
#pragma unroll
      for (int m = 0; m < 4; ++m) { bf16_t* rowp = O + (size_t)(u.row0 + ai * HALF + wr * 64 + m * 16 + fr) * ldc + u.col0 + wc * 32 + 8 * fq;
#pragma unroll
        for (int bj = 0; bj < 2; ++bj) { const f32x4 v0 = acc[ai][bj][m][0], v1 = acc[ai][bj][m][1];
          u32x4 w; w[0] = cvt_pk_bf16(v0[0], v0[1]); w[1] = cvt_pk_bf16(v0[2], v0[3]); w[2] = cvt_pk_bf16(v1[0], v1[1]); w[3] = cvt_pk_bf16(v1[2], v1[3]);
          *(u32x4*)(rowp + bj * HALF) = w; } }
  }
};
struct EpiResid {
  static constexpr bool PERM = false;
  const float* R; float* O; const float* gate; float* SS;
  __device__ __forceinline__ void operator()(const f32x4 (&acc)[2][2][4][2], const GUnit& u, int wr, int wc, int fr, int fq) const {
    const int b = u.row0 >> 13; const float* gp = gate + (size_t)b * 6144 + u.col0 + wc * 32 + 4 * fq;
    f32x4 gv[2][2];
#pragma unroll
    for (int bj = 0; bj < 2; ++bj)
#pragma unroll
      for (int n = 0; n < 2; ++n) gv[bj][n] = *(const f32x4*)(gp + bj * HALF + n * 16);
#pragma unroll
    for (int ai = 0; ai < 2; ++ai)
#pragma unroll
      for (int m = 0; m < 4; ++m) { const int row = u.row0 + ai * HALF + wr * 64 + m * 16 + fr; const size_t off = (size_t)row * 1024 + u.col0 + wc * 32 + 4 * fq;
        float ss = 0.f;
#pragma unroll
        for (int bj = 0; bj < 2; ++bj)
#pragma unroll
          for (int n = 0; n < 2; ++n) { const f32x4 r = *(const f32x4*)(R + off + bj * HALF + n * 16); const f32x4 x = r + gv[bj][n] * acc[ai][bj][m][n]; *(f32x4*)(O + off + bj * HALF + n * 16) = x;
            ss += x[0] * x[0] + x[1] * x[1] + x[2] * x[2] + x[3] * x[3]; }
        ss += __shfl_xor(ss, 16); ss += __shfl_xor(ss, 32);
        if (fq == 0) SS[(size_t)row * 16 + (u.col0 >> 8) * 4 + wc] = ss; }
  }
};
struct EpiSplit1 {
  static constexpr bool PERM = true;
  bf16_t* QD; bf16_t* KD; bf16_t* VD; const float* qn; const float* kn; unsigned char* Q8; unsigned char* K8; int wbf;
  __device__ __forceinline__ void operator()(const f32x4 (&acc)[2][2][4][2], const GUnit& u, int wr, int wc, int fr, int fq) const {
    const int pn = u.col0 >> 8;
    if (pn < 8) {
      const int which = pn >> 2, head16 = (pn & 3) * 4 + wc, comp = head16 & 1;
      const float* gp = (which ? kn : qn) + comp * 64 + 8 * fq;
      const float qs = which ? 1.f : (0.125f * 1.4426950408889634f);
      f32x4 g[2][2];
#pragma unroll
      for (int bj = 0; bj < 2; ++bj)
#pragma unroll
        for (int n = 0; n < 2; ++n) g[bj][n] = *(const f32x4*)(gp + 32 * bj + 4 * n) * qs;
      bf16_t* base = (which ? KD : QD);
#pragma unroll
      for (int ai = 0; ai < 2; ++ai)
#pragma unroll
        for (int m = 0; m < 4; ++m) {
          const int t = u.row0 + ai * HALF + wr * 64 + m * 16 + fr, b = t >> 13, s = t & 8191;
          float ss = 0.f;
#pragma unroll
          for (int bj = 0; bj < 2; ++bj)
#pragma unroll
            for (int n = 0; n < 2; ++n) { const f32x4 v = acc[ai][bj][m][n]; ss += v[0] * v[0] + v[1] * v[1] + v[2] * v[2] + v[3] * v[3]; }
          ss += __shfl_xor(ss, 16); ss += __shfl_xor(ss, 32);
          const float r = rsqrtf(ss * (1.f / 64.f) + EPS_);
          bf16_t* dst = base + (((size_t)b * 16 + head16) * S_ + s) * 64 + 8 * fq;
          unsigned char* dst8 = (which ? K8 : Q8) + (((size_t)b * 16 + head16) * S_ + s) * 64 + 8 * fq;
          const float f8 = which ? 1.f : 8.f;
#pragma unroll
          for (int bj = 0; bj < 2; ++bj) { const f32x4 v0 = acc[ai][bj][m][0] * r * g[bj][0], v1 = acc[ai][bj][m][1] * r * g[bj][1];
            u32x4 w; w[0] = cvt_pk_bf16(v0[0], v0[1]); w[1] = cvt_pk_bf16(v0[2], v0[3]); w[2] = cvt_pk_bf16(v1[0], v1[1]); w[3] = cvt_pk_bf16(v1[2], v1[3]);
            if (wbf) *(u32x4*)(dst + 32 * bj) = w;
            { u32x2 w8; w8[0] = pk4_fp8(v0[0] * f8, v0[1] * f8, v0[2] * f8, v0[3] * f8); w8[1] = pk4_fp8(v1[0] * f8, v1[1] * f8, v1[2] * f8, v1[3] * f8); *(u32x2*)(dst8 + 32 * bj) = w8; } }
        }
    } else {
      const int h = (pn - 8) * 2 + (wc >> 1), e0 = (wc & 1) * 64 + 8 * fq;
#pragma unroll
      for (int ai = 0; ai < 2; ++ai)
#pragma unroll
        for (int m = 0; m < 4; ++m) {
          const int t = u.row0 + ai * HALF + wr * 64 + m * 16 + fr, b = t >> 13, s = t & 8191;
          bf16_t* dst = VD + (((size_t)b * 8 + h) * S_ + s) * 128 + e0;
#pragma unroll
          for (int bj = 0; bj < 2; ++bj) { const f32x4 v0 = acc[ai][bj][m][0], v1 = acc[ai][bj][m][1];
            u32x4 w; w[0] = cvt_pk_bf16(v0[0], v0[1]); w[1] = cvt_pk_bf16(v0[2], v0[3]); w[2] = cvt_pk_bf16(v1[0], v1[1]); w[3] = cvt_pk_bf16(v1[2], v1[3]);
            *(u32x4*)(dst + 32 * bj) = w; }
        }
    }
  }
};
struct EpiSwiglu {
  static constexpr bool PERM = true;
  unsigned char* ACT;
  __device__ __forceinline__ void operator()(const f32x4 (&acc)[2][2][4][2], const GUnit& u, int wr, int wc, int fr, int fq) const {
#pragma unroll
    for (int ai = 0; ai < 2; ++ai)
#pragma unroll
      for (int m = 0; m < 4; ++m) { const int r = ai * HALF + wr * 64 + m * 16 + fr;
        if (r < u.nrow) { unsigned char* rowp = ACT + (size_t)(u.row0 + r) * 512 + ((u.col0 + wc * 32 + 8 * fq) >> 1);
#pragma unroll
          for (int bj = 0; bj < 2; ++bj) { const f32x4 v0 = acc[ai][bj][m][0], v1 = acc[ai][bj][m][1];
            *(unsigned*)(rowp + bj * (HALF / 2)) = pk4_fp8(MOE_ACT_SC * siluf(v0[0]) * v0[1], MOE_ACT_SC * siluf(v0[2]) * v0[3], MOE_ACT_SC * siluf(v1[0]) * v1[1], MOE_ACT_SC * siluf(v1[2]) * v1[3]); } } }
  }
};
struct EpiDown {
  static constexpr bool PERM = true;
  bf16_t* YB; const float* GATEW;
  __device__ __forceinline__ void operator()(const f32x4 (&acc)[2][2][4][2], const GUnit& u, int wr, int wc, int fr, int fq) const {
#pragma unroll
    for (int ai = 0; ai < 2; ++ai)
#pragma unroll
      for (int m = 0; m < 4; ++m) { const int r = ai * HALF + wr * 64 + m * 16 + fr;
        if (r < u.nrow) { const int ent = u.lst[r]; const float gw = GATEW[ent];
          bf16_t* rowp = YB + (size_t)ent * 1024 + u.col0 + wc * 32 + 8 * fq;
#pragma unroll
          for (int bj = 0; bj < 2; ++bj) { const f32x4 v0 = acc[ai][bj][m][0] * gw, v1 = acc[ai][bj][m][1] * gw;
            u32x4 w; w[0] = cvt_pk_bf16(v0[0], v0[1]); w[1] = cvt_pk_bf16(v0[2], v0[3]); w[2] = cvt_pk_bf16(v1[0], v1[1]); w[3] = cvt_pk_bf16(v1[2], v1[3]);
            *(u32x4*)(rowp + bj * HALF) = w; } } }
  }
};

template <class Epi, class Sched, bool GATHER, bool FP8 = false, int BLAY = 0>
__device__ __forceinline__ void gemm_phase(LAS unsigned char* lds, const int K, const Sched& S, const Epi& E, const int sa = 127, const int sb = 127) {
  const int tid = threadIdx.x, wid = __builtin_amdgcn_readfirstlane(tid >> 6), lane = tid & 63, wr = wid >> 2, wc = wid & 3, fr = lane & 15, fq = lane >> 4;
  const int nt = K / BK;
  unsigned voffA[2], voffB[2]; int gR[2], gC[2];
#pragma unroll
  for (int i = 0; i < 2; ++i) { int R, C; stage_rc(tid * 16 + i * 8192, R, C); const int Rb = Epi::PERM ? ((R & ~31) + perm32(R & 31)) : R;
    const int Rg = BLAY ? (64 * (R >> 5) + (Epi::PERM ? perm32(R & 31) : (R & 31))) : Rb;
    voffA[i] = (unsigned)(R * K + C) * 2u; voffB[i] = (unsigned)(Rg * K + C) * 2u; gR[i] = R; gC[i] = C; }
  const size_t kstep = (size_t)(BK * 2);
  const size_t hstep = (size_t)HALF * K * 2;
  const size_t bstep = BLAY ? (size_t)32 * K * 2 : hstep;
  const unsigned ldsw = (unsigned)wid * 1024u;
  const int aoff = lds_byte(wr * 64 + fr, fq * 8), boff = lds_byte(wc * 32 + fr, fq * 8);
  unsigned gcur[2][2], gnxt[2][2];
#define PG_GOFF(dst, u) do { _Pragma("unroll") for (int _h = 0; _h < 2; ++_h) _Pragma("unroll") for (int _i = 0; _i < 2; ++_i) { int _r = _h * HALF + gR[_i]; _r = _r < (u).nrow ? _r : (u).nrow - 1; \
      dst[_h][_i] = (unsigned)(((u).lst[_r] >> 1) * K + gC[_i]) * 2u; } } while (0)
#define PG_SA(b, h) (((b) * 2 + (h)) * HTB)
#define PG_SB(b, h) ((4 + (b) * 2 + (h)) * HTB)
#define PG_STAGE(bufoff, gbase, voff) do { _Pragma("unroll") for (int _i = 0; _i < 2; ++_i) \
      __builtin_amdgcn_global_load_lds((const unsigned*)((const char*)(gbase) + (voff)[_i]), (LAS unsigned*)(lds + (bufoff) + ldsw + _i * 8192), 16, 0, 0); } while (0)
#define PG_STAGE_A(bufoff, base, h, nx) do { if constexpr (GATHER) { unsigned _vo[2]; _vo[0] = (nx) ? gnxt[h][0] : gcur[h][0]; _vo[1] = (nx) ? gnxt[h][1] : gcur[h][1]; PG_STAGE(bufoff, base, _vo); } \
      else { PG_STAGE(bufoff, (base) + (h) * hstep, voffA); } } while (0)
#define PG_LD8(p) ({ const i32x4_t lo_ = *(const LAS i32x4_t*)(p), hi_ = *(const LAS i32x4_t*)((p) + 1024); __builtin_shufflevector(lo_, hi_, 0, 1, 2, 3, 4, 5, 6, 7); })
#define PG_LDA(dst, b, h) do { _Pragma("unroll") for (int m = 0; m < 4; ++m) { if constexpr (FP8) dst##8[m] = PG_LD8(lds + PG_SA(b, h) + aoff + m * 2048); else { _Pragma("unroll") for (int k = 0; k < 2; ++k) dst[m][k] = *(const LAS bf16x8*)(lds + PG_SA(b, h) + aoff + m * 2048 + k * 1024); } } } while (0)
#define PG_LDB(dst, b, h) do { _Pragma("unroll") for (int n = 0; n < 2; ++n) { if constexpr (FP8) dst##8[n] = PG_LD8(lds + PG_SB(b, h) + boff + n * 2048); else { _Pragma("unroll") for (int k = 0; k < 2; ++k) dst[n][k] = *(const LAS bf16x8*)(lds + PG_SB(b, h) + boff + n * 2048 + k * 1024); } } } while (0)
#define PG_MMA(ai, bj, At, Bt) do { __builtin_amdgcn_s_setprio(1); _Pragma("unroll") for (int m = 0; m < 4; ++m) _Pragma("unroll") for (int n = 0; n < 2; ++n) { \
      if constexpr (FP8) asm volatile("s_nop 1\n\tv_mfma_scale_f32_16x16x128_f8f6f4 %0, %1, %2, %0, %3, %4 op_sel_hi:[0,0,0]" : "+v"(acc[ai][bj][m][n]) : "v"(Bt##8[n]), "v"(At##8[m]), "v"(sa), "v"(sb));   \
      else { _Pragma("unroll") for (int k = 0; k < 2; ++k) acc[ai][bj][m][n] = __builtin_amdgcn_mfma_f32_16x16x32_bf16(Bt[n][k], At[m][k], acc[ai][bj][m][n], 0, 0, 0); } } __builtin_amdgcn_s_setprio(0); } while (0)
#define PG_WAIT_V(n) asm volatile("s_waitcnt vmcnt(" #n ")" ::: "memory")
#define PG_WAIT_L(n) asm volatile("s_waitcnt lgkmcnt(" #n ")" ::: "memory")
#define PG_BAR __builtin_amdgcn_s_barrier()
#define PG_SCHED __builtin_amdgcn_sched_barrier(0)
  GUnit cur, nxt; int ui = 0;
  if (!S.next(0, cur)) return;
  if constexpr (GATHER) { PG_GOFF(gcur, cur); PG_GOFF(gnxt, cur); }
  f32x4 acc[2][2][4][2];
#pragma unroll
  for (int a = 0; a < 2; ++a)
#pragma unroll
    for (int b = 0; b < 2; ++b)
#pragma unroll
      for (int m = 0; m < 4; ++m)
#pragma unroll
        for (int n = 0; n < 2; ++n) acc[a][b][m][n] = (f32x4){0.f, 0.f, 0.f, 0.f};
  bf16x8 At[4][2], B0[2][2], B1[2][2]; i32x8_t At8[4], B08[2], B18[2];
  const char* cA = cur.A; const char* cB = cur.B;
  PG_STAGE(PG_SB(0, 0), cB, voffB); PG_STAGE(PG_SB(0, 1), cB + bstep, voffB); PG_STAGE_A(PG_SA(0, 0), cA, 0, false); PG_STAGE_A(PG_SA(0, 1), cA, 1, false);
  if (wr == 1) PG_BAR;
  PG_WAIT_V(2); PG_BAR;
  PG_STAGE(PG_SB(1, 0), cB + kstep, voffB); PG_STAGE_A(PG_SA(1, 0), cA + kstep, 0, false); PG_STAGE(PG_SB(1, 1), cB + bstep + kstep, voffB);
  PG_WAIT_V(6); PG_BAR;
  for (;;) {
    const bool has_next = S.next(ui + 1, nxt);
    if constexpr (GATHER) { if (has_next) PG_GOFF(gnxt, nxt); }
    const char* nA = has_next ? nxt.A : cA; const char* nB = has_next ? nxt.B : cB;
    const bool nxg = has_next;
    for (int t = 0; t < nt; t += 2) {
      const bool last = (t == nt - 2);
      const char* a1 = cA + (size_t)(t + 1) * kstep;
      const char* a2 = last ? nA : cA + (size_t)(t + 2) * kstep; const char* b2 = last ? nB : cB + (size_t)(t + 2) * kstep;
      const char* a3 = a2 + kstep; const char* b3 = b2 + kstep;
      const bool nx = last && nxg;
      PG_LDB(B0, 0, 0); PG_LDB(B1, 0, 1); PG_SCHED; PG_LDA(At, 0, 0); PG_STAGE_A(PG_SA(1, 1), a1, 1, false);
      PG_WAIT_V(8); PG_WAIT_L(0); PG_BAR; PG_MMA(0, 0, At, B0); PG_MMA(0, 1, At, B1); PG_BAR; PG_SCHED;
      PG_LDA(At, 0, 1); PG_STAGE(PG_SB(0, 0), b2, voffB); PG_STAGE(PG_SB(0, 1), b2 + bstep, voffB); PG_STAGE_A(PG_SA(0, 0), a2, 0, nx);
      PG_WAIT_V(8); PG_WAIT_L(0); PG_BAR; PG_MMA(1, 0, At, B0); PG_MMA(1, 1, At, B1); PG_BAR; PG_SCHED;
      PG_LDB(B0, 1, 0); PG_LDB(B1, 1, 1); PG_SCHED; PG_LDA(At, 1, 0); PG_STAGE_A(PG_SA(0, 1), a2, 1, nx);
      PG_WAIT_V(8); PG_WAIT_L(0); PG_BAR; PG_MMA(0, 0, At, B0); PG_MMA(0, 1, At, B1); PG_BAR; PG_SCHED;
      PG_LDA(At, 1, 1); PG_STAGE(PG_SB(1, 0), b3, voffB); PG_STAGE(PG_SB(1, 1), b3 + bstep, voffB); PG_STAGE_A(PG_SA(1, 0), a3, 0, nx);
      PG_WAIT_V(8); PG_WAIT_L(0); PG_BAR; PG_MMA(1, 0, At, B0); PG_MMA(1, 1, At, B1); PG_BAR; PG_SCHED;
    }
    if (wr == 0) PG_BAR;
    if constexpr (FP8) asm volatile("s_nop 15\n\ts_nop 15\n\ts_nop 15\n\ts_nop 15" ::: "memory");
    E(acc, cur, wr, wc, fr, fq);
    if (!has_next) break;
#pragma unroll
    for (int a = 0; a < 2; ++a)
#pragma unroll
      for (int b = 0; b < 2; ++b)
#pragma unroll
        for (int m = 0; m < 4; ++m)
#pragma unroll
          for (int n = 0; n < 2; ++n) acc[a][b][m][n] = (f32x4){0.f, 0.f, 0.f, 0.f};
    cur = nxt; cA = nA; cB = nB; ++ui;
    if constexpr (GATHER) {
#pragma unroll
      for (int h = 0; h < 2; ++h) { gcur[h][0] = gnxt[h][0]; gcur[h][1] = gnxt[h][1]; }
    }
    if (wr == 1) PG_BAR;
  }
  PG_WAIT_V(0);
  PG_BAR;
#undef PG_GOFF
#undef PG_SA
#undef PG_SB
#undef PG_STAGE
#undef PG_STAGE_A
#undef PG_LDA
#undef PG_LDB
#undef PG_MMA
#undef PG_LD8
#undef PG_WAIT_V
#undef PG_WAIT_L
#undef PG_BAR
#undef PG_SCHED
}
}

__device__ __forceinline__ void moe_tables(const Frame& F, int l, int tile) {
  int* tstart = (int*)(F.lds + LDS_CTL + 64); int* sbase = tstart + 40; int* cntl = sbase + 40;
  const unsigned* COUNT = (const unsigned*)(F.ws + WS_CTL + CW_CNT) + l * 32;
  __syncthreads();
  if (F.tid == 0) { int ts = 0, sb = 0; for (int e = 0; e < 32; ++e) { const int c = (int)COUNT[e]; cntl[e] = c; tstart[e] = ts; sbase[e] = sb; ts += (c + tile - 1) / tile; sb += c; } tstart[32] = ts; sbase[32] = sb; }
  __syncthreads();
}


__device__ __forceinline__ void moe_up_fast(const Frame& F, int l) {
  moe_tables(F, l, 256);
  const int* tstart = (const int*)(F.lds + LDS_CTL + 64); const int* sbase = tstart + 40; const int* cntl = sbase + 40;
  pg::MoeOrder S{tstart, sbase, cntl, (const char*)WSP(const unsigned char, WS_HB), (const char*)(WSP(const unsigned char, WS_WUP) + (size_t)l * 32 * 1024 * 1024), WSP(const int, WS_LIST), 512, F.G, F.bid, 1};
  pg::EpiSwiglu E{WSP(unsigned char, A_ACT)};
  pg::gemm_phase<pg::EpiSwiglu, pg::MoeOrder, true, true>((LAS unsigned char*)F.lds, 512, S, E, 121  , 127);
}
__device__ __forceinline__ void moe_down_fast(const Frame& F, int l) {
  moe_tables(F, l, 256);
  const int* tstart = (const int*)(F.lds + LDS_CTL + 64); const int* sbase = tstart + 40; const int* cntl = sbase + 40;
  pg::MoeOrder S{tstart, sbase, cntl, (const char*)WSP(const unsigned char, A_ACT), (const char*)(WSP(const unsigned char, WS_WDN) + (size_t)l * 32 * 1024 * 512), WSP(const int, WS_LIST), 256, F.G, F.bid, 0};
  pg::EpiDown E{WSP(bf16_t, A_YB), WSP(const float, WS_GATEW)};
  pg::gemm_phase<pg::EpiDown, pg::MoeOrder, false, true>((LAS unsigned char*)F.lds, 256, S, E, 122  , 125  );
}

__device__ __forceinline__ int t5_bucket(int rel) {
  const int n = rel < 0 ? -rel : rel;
  int bkt;
  if (n < 8) bkt = n; else if (n < 12) bkt = 8; else if (n < 16) bkt = 9; else if (n < 23) bkt = 10; else if (n < 32) bkt = 11;
  else if (n < 46) bkt = 12; else if (n < 64) bkt = 13; else if (n < 91) bkt = 14; else bkt = 15;
  return bkt + (rel > 0 ? 16 : 0);
}


namespace fa {
using bf16x8 = __attribute__((ext_vector_type(8))) short;
using s16x4  = __attribute__((ext_vector_type(4))) short;
using f32x16 = __attribute__((ext_vector_type(16))) float;
constexpr int NW = 8, QBLK = 32, KVBLK = 64;
constexpr float THR2 = 8.f * 1.4426950408889634f;
#define FA_SBAR() __builtin_amdgcn_sched_barrier(0)
__device__ __forceinline__ int crow(int r, int hi) { return (r & 3) + 8 * (r >> 2) + 4 * hi; }
__device__ __forceinline__ unsigned cvtpk(float lo, float hi) { unsigned r; asm volatile("v_cvt_pk_bf16_f32 %0, %1, %2" : "=v"(r) : "v"(lo), "v"(hi)); return r; }

__device__ __forceinline__ void partialSM(f32x16& p0, f32x16& p1, float& m_reg, float& alpha, float Cmul, float tb) {
  float pmax = p0[0];
#pragma unroll
  for (int r = 1; r < 16; ++r) pmax = fmaxf(pmax, p0[r]);
#pragma unroll
  for (int r = 0; r < 16; ++r) pmax = fmaxf(pmax, p1[r]);
  { auto rr = __builtin_amdgcn_permlane32_swap(__float_as_uint(pmax), __float_as_uint(pmax), false, false);
    pmax = fmaxf(__uint_as_float(rr[0]), __uint_as_float(rr[1])); }
  const float tmax = fmaf(pmax, Cmul, tb);
  float mn;
  if (__builtin_expect(__all(tmax - m_reg <= THR2), 1)) { mn = m_reg; alpha = 1.f; }
  else { mn = fmaxf(m_reg, tmax); alpha = __builtin_amdgcn_exp2f(m_reg - mn); m_reg = mn; }
  const float off = tb - mn;
#pragma unroll
  for (int r = 0; r < 16; ++r) p0[r] = fmaf(p0[r], Cmul, off);
#pragma unroll
  for (int r = 0; r < 16; ++r) p1[r] = fmaf(p1[r], Cmul, off);
#pragma unroll
  for (int r = 0; r < 16; ++r) p0[r] = __builtin_amdgcn_exp2f(p0[r]);
}
__device__ __forceinline__ void partialSM_nomax(f32x16& p0) {
#pragma unroll
  for (int r = 0; r < 16; ++r) p0[r] = __builtin_amdgcn_exp2f(p0[r]);
}
__device__ __forceinline__ void finishSM(f32x16& p0, f32x16& p1, float alpha, float& l_reg, bf16x8& pa0, bf16x8& pa1, bf16x8& pa2, bf16x8& pa3) {
#pragma unroll
  for (int r = 0; r < 16; ++r) p1[r] = __builtin_amdgcn_exp2f(p1[r]);
  float ps = 0;
#pragma unroll
  for (int r = 0; r < 16; ++r) ps += p0[r];
#pragma unroll
  for (int r = 0; r < 16; ++r) ps += p1[r];
  { auto rr = __builtin_amdgcn_permlane32_swap(__float_as_uint(ps), __float_as_uint(ps), false, false);
    ps = __uint_as_float(rr[0]) + __uint_as_float(rr[1]); }
  l_reg = l_reg * alpha + ps;
#define FA_PK4(P, BASE, OUT) do { unsigned a0 = cvtpk(P[BASE + 0], P[BASE + 1]), a1 = cvtpk(P[BASE + 2], P[BASE + 3]);   \
    unsigned b0 = cvtpk(P[BASE + 4], P[BASE + 5]), b1 = cvtpk(P[BASE + 6], P[BASE + 7]);                              \
    auto r0 = __builtin_amdgcn_permlane32_swap(a0, b0, false, false); auto r1 = __builtin_amdgcn_permlane32_swap(a1, b1, false, false); \
    u32x4 w = {r0[0], r1[0], r0[1], r1[1]}; OUT = *reinterpret_cast<bf16x8*>(&w); } while (0)
  FA_PK4(p0, 0, pa0); FA_PK4(p0, 8, pa1); FA_PK4(p1, 0, pa2); FA_PK4(p1, 8, pa3);
#undef FA_PK4
}
template <int OFF> __device__ __forceinline__ s16x4 tr_read(int vb) {
  s16x4 r; asm volatile("ds_read_b64_tr_b16 %0, %1 offset:%2" : "=&v"(r) : "v"(vb), "i"(OFF) : "memory"); return r;
}
__device__ __forceinline__ int v_rd_base(int lane) { return ((lane & 3) << 3) | (((lane >> 2) & 3) << 6) | (((lane >> 4) & 1) << 5) | (((lane >> 5) & 1) << 8); }

template <int LDK, int NKS, int DV, bool BIAS, bool NOMAX = false>
struct Body {
  static constexpr int RB = LDK * 2;
  static constexpr int SHM_K = KVBLK * RB, SHM_V = KVBLK * DV * 2;
  static constexpr int NC = DV / 32;
  static constexpr int NKL = LDK / 64, NVL = DV / 64;
  static constexpr int OFF_V = 0, OFF_K = 2 * SHM_V, OFF_WS = 2 * SHM_V + 2 * SHM_K, OFF_TAB = OFF_WS + NW * 64 * 4, LDS_NEED = OFF_TAB + 392 * 4;
  static __device__ __forceinline__ int kswz(int row, int colB) { return row * RB + (colB ^ ((((RB == 128) ? (row ^ (row >> 3)) : row) & 7) << 4)); }
  static __device__ __forceinline__ int v_st(int k, int c) { const int kk = (k & ~0xC) | ((k & 4) << 1) | ((k & 8) >> 1); return ((kk >> 3) * NC + (c >> 5)) * 512 + ((kk & 7) * 32 + (c & 31)) * 2; }
  static constexpr int v_rd_off(int d0, int ks, int half) { return d0 * 512 + ks * (NC * 1024) + half * (NC * 512); }

  static __device__ __forceinline__ void qkt(f32x16& p0, f32x16& p1, const char* Ks, const bf16x8* qr, int r32, int hi) {
    p0 = f32x16{}; p1 = f32x16{};
#pragma unroll
    for (int d0 = 0; d0 < NKS; ++d0) { const int cb = (d0 * 16 + hi * 8) * 2;
      const bf16x8 b0 = *reinterpret_cast<const bf16x8*>(Ks + kswz(r32, cb));
      const bf16x8 b1 = *reinterpret_cast<const bf16x8*>(Ks + kswz(32 + r32, cb));
      p0 = __builtin_amdgcn_mfma_f32_32x32x16_bf16(b0, qr[d0], p0, 0, 0, 0);
      p1 = __builtin_amdgcn_mfma_f32_32x32x16_bf16(b1, qr[d0], p1, 0, 0, 0); }
  }
  template <int D0> static __device__ __forceinline__ void pv_one(f32x16& od, int vb, bf16x8 pa0, bf16x8 pa1, bf16x8 pa2, bf16x8 pa3) {
    const s16x4 l0 = tr_read<v_rd_off(D0, 0, 0)>(vb), h0 = tr_read<v_rd_off(D0, 0, 1)>(vb), l1 = tr_read<v_rd_off(D0, 1, 0)>(vb), h1 = tr_read<v_rd_off(D0, 1, 1)>(vb);
    const s16x4 l2 = tr_read<v_rd_off(D0, 2, 0)>(vb), h2 = tr_read<v_rd_off(D0, 2, 1)>(vb), l3 = tr_read<v_rd_off(D0, 3, 0)>(vb), h3 = tr_read<v_rd_off(D0, 3, 1)>(vb);
    asm volatile("s_waitcnt lgkmcnt(0)" ::: "memory"); FA_SBAR();
#define FA_PK(L, H) (bf16x8){L[0], L[1], L[2], L[3], H[0], H[1], H[2], H[3]}
    od = __builtin_amdgcn_mfma_f32_32x32x16_bf16(pa0, FA_PK(l0, h0), od, 0, 0, 0);
    od = __builtin_amdgcn_mfma_f32_32x32x16_bf16(pa1, FA_PK(l1, h1), od, 0, 0, 0);
    od = __builtin_amdgcn_mfma_f32_32x32x16_bf16(pa2, FA_PK(l2, h2), od, 0, 0, 0);
    od = __builtin_amdgcn_mfma_f32_32x32x16_bf16(pa3, FA_PK(l3, h3), od, 0, 0, 0);
#undef FA_PK
  }
  static __device__ __forceinline__ void pv_all(f32x16* o, int vb, bf16x8 pa0, bf16x8 pa1, bf16x8 pa2, bf16x8 pa3) {
    pv_one<0>(o[0], vb, pa0, pa1, pa2, pa3); pv_one<1>(o[1], vb, pa0, pa1, pa2, pa3);
    if constexpr (NC == 4) { pv_one<2>(o[2], vb, pa0, pa1, pa2, pa3); pv_one<3>(o[3], vb, pa0, pa1, pa2, pa3); }
  }
  static __device__ __forceinline__ void add_bias(f32x16& p0, f32x16& p1, float C, const float* tabl) {
#pragma unroll
    for (int r = 0; r < 16; ++r) { p0[r] = fmaf(p0[r], C, tabl[(r & 3) + 8 * (r >> 2)]); p1[r] = fmaf(p1[r], C, tabl[32 + (r & 3) + 8 * (r >> 2)]); }
  }

  template <class Store>
  static __device__ __forceinline__ void run(const bf16_t* __restrict__ Qb, const bf16_t* __restrict__ Kh, const bf16_t* __restrict__ Vh, int seq, char* lds, float C, int q0, Store store) {
    int tid_ = threadIdx.x; asm volatile("" : "+v"(tid_));
    const int tid = tid_, wid = tid >> 6, lane = tid & 63, r32 = lane & 31, hi = lane >> 5;
    char* V_lds = lds + OFF_V; char* K_lds = lds + OFF_K;
    float* ws = (float*)(lds + OFF_WS) + wid * 64; float* li_l = ws; float* al_l = ws + 32;
    const float* tab = (const float*)(lds + OFF_TAB);
    float m_reg = -1e30f, l_reg = 0; f32x16 o[NC] = {}; bf16x8 qr[NKS];
    const bf16_t* Qw = Qb + (size_t)(wid * QBLK + r32) * LDK + hi * 8;
#pragma unroll
    for (int d0 = 0; d0 < NKS; ++d0) qr[d0] = *reinterpret_cast<const bf16x8*>(Qw + d0 * 16);
    const int ksr = (LDK == 128) ? (tid >> 4) : (tid >> 3), ksc = (LDK == 128) ? (tid & 15) * 8 : (tid & 7) * 8;
    const int vsr = (DV == 128) ? (tid >> 4) : (tid >> 3), vsc = (DV == 128) ? (tid & 15) * 8 : (tid & 7) * 8;
    const int vst0 = v_st(vsr, vsc), vst1 = v_st(32 + vsr, vsc);
    const int vb0 = (int)(uintptr_t)V_lds + v_rd_base(lane);
    struct { bf16x8 v[NVL], k[NKL]; } sr_[2];
#define FA_SLOAD(i, k0) do { _Pragma("unroll") for (int _q = 0; _q < NVL; ++_q) sr_[i].v[_q] = *reinterpret_cast<const bf16x8*>(&Vh[(size_t)((k0) + vsr + 32 * _q) * DV + vsc]); \
    _Pragma("unroll") for (int _q = 0; _q < NKL; ++_q) sr_[i].k[_q] = *reinterpret_cast<const bf16x8*>(&Kh[(size_t)((k0) + ksr + 32 * _q) * LDK + ksc]); } while (0)
#define FA_SWRITE(b, i) do { *(bf16x8*)(V_lds + (b) * SHM_V + vst0) = sr_[i].v[0]; if constexpr (NVL == 2) *(bf16x8*)(V_lds + (b) * SHM_V + vst1) = sr_[i].v[NVL - 1]; \
    *(bf16x8*)(K_lds + (b) * SHM_K + kswz(ksr, ksc * 2)) = sr_[i].k[0]; if constexpr (NKL == 2) *(bf16x8*)(K_lds + (b) * SHM_K + kswz(32 + ksr, ksc * 2)) = sr_[i].k[NKL - 1]; } while (0)
#define FA_SWAIT() do { if constexpr (NVL + NKL == 2) asm volatile("s_waitcnt vmcnt(2)" ::: "memory"); else if constexpr (NVL + NKL == 3) asm volatile("s_waitcnt vmcnt(3)" ::: "memory"); else asm volatile("s_waitcnt vmcnt(4)" ::: "memory"); } while (0)
#define FA_RESC(a) do { if constexpr (NOMAX) { if ((a) != 1.f) { _Pragma("unroll") for (int d = 0; d < NC; ++d) _Pragma("unroll") for (int r = 0; r < 16; ++r) o[d][r] *= (a); } } \
    else if (__any((a) < 1.f)) { if (hi == 0) al_l[r32] = (a); asm volatile("s_waitcnt lgkmcnt(0)" ::: "memory"); \
    _Pragma("unroll") for (int d = 0; d < NC; ++d) _Pragma("unroll") for (int r = 0; r < 16; ++r) o[d][r] *= al_l[crow(r, hi)]; } } while (0)
    const int qw = q0 + wid * QBLK;
#define FA_CLS(jt) (((jt) * KVBLK + 63 - qw <= -91) ? 0 : (((jt) * KVBLK - qw - 31 >= 91) ? 2 : 1))
#define FA_PSM(P0, P1, AL, jt) do { if constexpr (NOMAX) { AL = 1.f; \
      if constexpr (BIAS) { const int c1_ = FA_CLS(jt); if ((jt) > 0) { const int c0_ = FA_CLS((jt) - 1); if (c1_ != c0_) AL = (c1_ == 1) ? __builtin_amdgcn_exp2f(tab[0]) : __builtin_amdgcn_exp2f(-tab[384]); } \
        if (c1_ == 1) add_bias(P0, P1, 1.f, tab + ((jt) * KVBLK - (qw + r32) + 192 + 4 * hi)); }     \
      partialSM_nomax(P0); } \
    else if constexpr (BIAS) { const int kt_ = (jt) * KVBLK; \
      if (kt_ + 63 - qw <= -91) partialSM(P0, P1, m_reg, AL, C, tab[0]); \
      else if (kt_ - qw - 31 >= 91) partialSM(P0, P1, m_reg, AL, C, tab[384]); \
      else { add_bias(P0, P1, C, tab + (kt_ - (qw + r32) + 192 + 4 * hi)); partialSM(P0, P1, m_reg, AL, 1.f, 0.f); } } \
    else partialSM(P0, P1, m_reg, AL, C, 0.f); } while (0)
    f32x16 pA0, pA1, pB0, pB1; float alA, alB; bf16x8 pa0, pa1, pa2, pa3; const int NT = seq / KVBLK;
    constexpr int SE = 0, SO = 1;
    FA_SLOAD(SE, 0); asm volatile("s_waitcnt vmcnt(0)" ::: "memory"); FA_SWRITE(0, SE); __syncthreads();
    qkt(pA0, pA1, K_lds, qr, r32, hi); FA_PSM(pA0, pA1, alA, 0);
    FA_SLOAD(SO, KVBLK); if (2 < NT) FA_SLOAD(SE, 2 * KVBLK);
    FA_SWAIT(); FA_SWRITE(1, SO); __syncthreads();
    for (int j = 1; j + 1 < NT; j += 2) {
      FA_SBAR(); qkt(pB0, pB1, K_lds + SHM_K, qr, r32, hi);
      finishSM(pA0, pA1, alA, l_reg, pa0, pa1, pa2, pa3); FA_SBAR();
      FA_SLOAD(SO, (j + 2) * KVBLK); FA_SBAR();
      pv_all(o, vb0, pa0, pa1, pa2, pa3); FA_PSM(pB0, pB1, alB, j);
      __syncthreads(); FA_SWAIT(); FA_SWRITE(0, SE);
      FA_RESC(alB); __syncthreads();
      FA_SBAR(); qkt(pA0, pA1, K_lds, qr, r32, hi);
      finishSM(pB0, pB1, alB, l_reg, pa0, pa1, pa2, pa3); FA_SBAR();
      if (j + 3 < NT) FA_SLOAD(SE, (j + 3) * KVBLK); FA_SBAR();
      pv_all(o, vb0 + SHM_V, pa0, pa1, pa2, pa3); FA_PSM(pA0, pA1, alA, j + 1);
      __syncthreads(); FA_SWAIT(); FA_SWRITE(1, SO);
      FA_RESC(alA); __syncthreads();
    }
    FA_SBAR(); qkt(pB0, pB1, K_lds + SHM_K, qr, r32, hi);
    finishSM(pA0, pA1, alA, l_reg, pa0, pa1, pa2, pa3); FA_SBAR();
    pv_all(o, vb0, pa0, pa1, pa2, pa3); FA_PSM(pB0, pB1, alB, NT - 1);
    __syncthreads(); FA_RESC(alB);
    finishSM(pB0, pB1, alB, l_reg, pa0, pa1, pa2, pa3); FA_SBAR();
    pv_all(o, vb0 + SHM_V, pa0, pa1, pa2, pa3);
    if (hi == 0) li_l[r32] = l_reg; asm volatile("s_waitcnt lgkmcnt(0)" ::: "memory");
    float rli[16];
#pragma unroll
    for (int r = 0; r < 16; ++r) rli[r] = __builtin_amdgcn_rcpf(li_l[crow(r, hi)]);
    store(o, rli, wid, r32, hi);
    __syncthreads();
#undef FA_SLOAD
#undef FA_SWRITE
#undef FA_SWAIT
#undef FA_RESC
#undef FA_PSM
#undef FA_CLS
  }
};
}


namespace fa8 {
using fa::f32x16; using fa::crow;
typedef int v8i __attribute__((ext_vector_type(8)));
typedef short v2s __attribute__((ext_vector_type(2)));
template <int NKB>
struct Body {
  static constexpr int RBK = 64 * NKB, SHM_K = 64 * RBK, SHM_V = 64 * 64, NP = (NKB == 1) ? 1 : 2;
  static constexpr int OFF_V = 0, OFF_K = 4 * SHM_V, OFF_WS = OFF_K + 4 * SHM_K, LDS_NEED = OFF_WS + 8 * 32 * 4;
  static __device__ __forceinline__ int swzk(int row) { return NKB == 1 ? ((row >> 2) & 3) : ((row >> 1) & 7); }
  static __device__ __forceinline__ int koffs(int row, int chunk) { return row * RBK + ((chunk ^ swzk(row)) << 4); }
  static __device__ __forceinline__ int voffs(int row, int chunk) { return row * 64 + ((chunk ^ ((row >> 2) & 3)) << 4); }

  template <class Store>
  static __device__ __forceinline__ void run(const unsigned char* __restrict__ Qb, const unsigned char* __restrict__ Kh, const unsigned char* __restrict__ VTh, int seq, LAS unsigned char* lds, int cexp, Store store) {
    int tid_ = threadIdx.x; asm volatile("" : "+v"(tid_));
    const int tid = tid_, wid = __builtin_amdgcn_readfirstlane(tid >> 6), lane = tid & 63, r32 = lane & 31, hi = lane >> 5;
    unsigned kgo, vgo;
    { const int pc = (NKB == 1) ? (wid & 3) : wid, pos = pc * 1024 + lane * 16, row = pos / RBK, ch = ((pos % RBK) >> 4) ^ swzk(row); kgo = (unsigned)(row * RBK + ch * 16); }
    { const int pc = wid & 3, pos = pc * 1024 + lane * 16, row = pos >> 6, ch = ((pos & 63) >> 4) ^ ((row >> 2) & 3); vgo = (unsigned)(row * seq + ch * 16); }
    const int NT = seq / 64;
#define F8_TCL(t) ((t) < NT ? (t) : NT - 1)
#define F8_DMA_K(t, b) __builtin_amdgcn_global_load_lds((const unsigned*)(Kh + (size_t)F8_TCL(t) * 64 * RBK + kgo), (LAS unsigned*)(lds + OFF_K + (b) * SHM_K + ((NKB == 1) ? (wid & 3) : wid) * 1024), 16, 0, 0)
#define F8_DMA_V(t, b) __builtin_amdgcn_global_load_lds((const unsigned*)(VTh + (size_t)F8_TCL(t) * 64 + vgo), (LAS unsigned*)(lds + OFF_V + (b) * SHM_V + (wid & 3) * 1024), 16, 0, 0)
#define F8_DMA2(a_) do { \
      if constexpr (NKB == 1) { const int kt_ = (a_) + 4 + (wid >> 2); F8_DMA_K(kt_, kt_ & 3); } \
      else { F8_DMA_K((a_) + 4, ((a_) + 4) & 3); F8_DMA_K((a_) + 5, ((a_) + 5) & 3); } \
      { const int vt_ = (a_) + 1 + (wid >> 2); F8_DMA_V(vt_, vt_ & 3); } } while (0)
#define F8_BAR() do { __builtin_amdgcn_sched_barrier(0); __builtin_amdgcn_s_barrier(); __builtin_amdgcn_sched_barrier(0); } while (0)
#define F8_VM0() asm volatile("s_waitcnt vmcnt(0)" ::: "memory")
#define F8_VMNP() do { if constexpr (NP == 1) asm volatile("s_waitcnt vmcnt(1)" ::: "memory"); else asm volatile("s_waitcnt vmcnt(2)" ::: "memory"); } while (0)
    f32x16 o[2] = {}, ol = {}; f32x16 sA0, sA1, sB0, sB1; v8i pA, pB; int saA = 127, saB = 127;
    const float csc = __builtin_bit_cast(float, (unsigned)(127 + cexp) << 23); const int sap = 127 + cexp;
    const v8i ones = {0x38383838, 0x38383838, 0x38383838, 0x38383838, 0x38383838, 0x38383838, 0x38383838, 0x38383838};
    int c127 = 127, c124 = 124; asm volatile("" : "+v"(c127), "+v"(c124));
    v8i qf[NKB], kf[2][NKB], vf[2];
    { const unsigned char* Qw = Qb + (size_t)(wid * 32 + r32) * RBK + hi * 32;
#pragma unroll
      for (int c = 0; c < NKB; ++c) { const u32x4 a = *(const u32x4*)(Qw + c * 64), b = *(const u32x4*)(Qw + c * 64 + 16); qf[c] = (v8i){(int)a[0], (int)a[1], (int)a[2], (int)a[3], (int)b[0], (int)b[1], (int)b[2], (int)b[3]}; } }
#define F8_LD32(p0_, p1_) ({ const u32x4 a_ = *(const LAS u32x4*)(p0_), b_ = *(const LAS u32x4*)(p1_); (v8i){(int)a_[0], (int)a_[1], (int)a_[2], (int)a_[3], (int)b_[0], (int)b_[1], (int)b_[2], (int)b_[3]}; })
#define F8_KLOAD(kb) do { const LAS unsigned char* Ks_ = lds + OFF_K + (kb) * SHM_K; \
      _Pragma("unroll") for (int h2 = 0; h2 < 2; ++h2) _Pragma("unroll") for (int c = 0; c < NKB; ++c) { const int row = h2 * 32 + r32, ch = c * 4 + 2 * hi; \
        kf[h2][c] = F8_LD32(Ks_ + koffs(row, ch), Ks_ + koffs(row, ch + 1)); } } while (0)
#define F8_VLOAD(vb) do { const LAS unsigned char* Vs_ = lds + OFF_V + (vb) * SHM_V; \
      _Pragma("unroll") for (int d = 0; d < 2; ++d) { const int row = d * 32 + r32; vf[d] = F8_LD32(Vs_ + voffs(row, 2 * hi), Vs_ + voffs(row, 2 * hi + 1)); } } while (0)
#define F8_QKN(S, KF, QF) asm volatile("s_nop 1\n\tv_mfma_scale_f32_32x32x64_f8f6f4 %0, %1, %2, 0, %3, %4 op_sel_hi:[0,0,0]" : "=&v"(S) : "v"(KF), "v"(QF), "v"(c127), "v"(c124))
#define F8_QKA(S, KF, QF) asm volatile("s_nop 1\n\tv_mfma_scale_f32_32x32x64_f8f6f4 %0, %1, %2, %0, %3, %4 op_sel_hi:[0,0,0]" : "+v"(S) : "v"(KF), "v"(QF), "v"(c127), "v"(c124))
#define F8_QK(S0, S1) do { __builtin_amdgcn_sched_barrier(0); F8_QKN(S0, kf[0][0], qf[0]); F8_QKN(S1, kf[1][0], qf[0]); \
      if constexpr (NKB == 2) { F8_QKA(S0, kf[0][1], qf[1]); F8_QKA(S1, kf[1][1], qf[1]); } __builtin_amdgcn_sched_barrier(0); } while (0)
#define F8_PVX(ACC, P, B, SA) do { __builtin_amdgcn_sched_barrier(0); asm volatile("s_nop 1\n\tv_mfma_scale_f32_32x32x64_f8f6f4 %0, %1, %2, %0, %3, %4 op_sel_hi:[0,0,0] cbsz:1" : "+v"(ACC) : "v"(P), "v"(B), "v"(SA), "v"(c127)); __builtin_amdgcn_sched_barrier(0); } while (0)
#define F8_PV(P, SA) do { F8_PVX(o[0], P, vf[0], SA); F8_PVX(o[1], P, vf[1], SA); F8_PVX(ol, P, ones, SA); } while (0)
#define F8_ONOP() asm volatile("s_nop 15\n\ts_nop 15\n\ts_nop 15\n\ts_nop 15" ::: "memory")
#define F8_CV4(S, B4, SC) ({ v2s z_; asm volatile("" : "=v"(z_)); z_ = __builtin_amdgcn_cvt_scalef32_pk_bf8_f32(z_, S[B4], S[B4 + 1], SC, false); z_ = __builtin_amdgcn_cvt_scalef32_pk_bf8_f32(z_, S[B4 + 2], S[B4 + 3], SC, true); (unsigned)__builtin_bit_cast(int, z_); })
#define F8_SM(S0, S1, P, SA) F8_SMX(S0, S1, P, SA, P, SA, false)
#define F8_SMX(S0, S1, P, SA, PP_, SAP_, DOPV_) do { \
      _Pragma("unroll") for (int r = 0; r < 16; ++r) S0[r] = __builtin_amdgcn_exp2f(S0[r]); \
      if (DOPV_) F8_PVX(o[0], PP_, vf[0], SAP_); \
      _Pragma("unroll") for (int r = 0; r < 16; ++r) S1[r] = __builtin_amdgcn_exp2f(S1[r]); \
      if (DOPV_) F8_PVX(o[1], PP_, vf[1], SAP_); \
      unsigned x_[4], y_[4]; \
      _Pragma("unroll") for (int i = 0; i < 4; ++i) x_[i] = F8_CV4(S0, 4 * i, csc); \
      if (DOPV_) F8_PVX(ol, PP_, ones, SAP_); \
      _Pragma("unroll") for (int i = 0; i < 4; ++i) y_[i] = F8_CV4(S1, 4 * i, csc); \
      P = (v8i){(int)x_[0], (int)x_[1], (int)x_[2], (int)x_[3], (int)y_[0], (int)y_[1], (int)y_[2], (int)y_[3]}; \
      SA = sap; } while (0)
#define F8_STEP(j_, SI0, SI1, SO0, SO1, PP, SAP, PN, SAN, dopv) do { \
      F8_QK(SO0, SO1); \
      if (dopv) F8_VLOAD(((j_) - 1) & 3); \
      F8_SMX(SI0, SI1, PN, SAN, PP, SAP, dopv); \
      F8_KLOAD(((j_) + 2) & 3); \
      __builtin_amdgcn_sched_barrier(0); } while (0)
#define F8_PAIR_END() do { asm volatile("s_waitcnt lgkmcnt(0)" ::: "memory"); F8_VM0(); F8_BAR(); } while (0)

    if constexpr (NKB == 1) { if (wid < 4) { F8_DMA_K(0, 0); F8_DMA_K(1, 1); F8_DMA_K(2, 2); F8_DMA_K(3, 3); } else F8_DMA_V(0, 0); }
    else { F8_DMA_K(0, 0); F8_DMA_K(1, 1); F8_DMA_K(2, 2); F8_DMA_K(3, 3); F8_DMA_V(0, 0); }
    F8_VM0(); F8_BAR();
    F8_KLOAD(0); F8_QK(sA0, sA1); F8_ONOP(); F8_ONOP(); F8_ONOP(); F8_ONOP(); __builtin_amdgcn_sched_barrier(0); F8_KLOAD(1);
    asm volatile("s_waitcnt lgkmcnt(0)" ::: "memory"); F8_BAR();
    F8_DMA2(0); __builtin_amdgcn_sched_barrier(0);
    F8_STEP(0, sA0, sA1, sB0, sB1, pB, saB, pA, saA, false);
    F8_STEP(1, sB0, sB1, sA0, sA1, pA, saA, pB, saB, true);
    F8_PAIR_END();
    for (int j = 2; j + 1 < NT; j += 2) {
      F8_DMA2(j); __builtin_amdgcn_sched_barrier(0);
      F8_STEP(j, sA0, sA1, sB0, sB1, pB, saB, pA, saA, true);
      F8_STEP(j + 1, sB0, sB1, sA0, sA1, pA, saA, pB, saB, true);
      F8_PAIR_END();
    }
    F8_VLOAD((NT - 1) & 3); F8_PV(pB, saB);
    F8_ONOP();
    float rli[16];
#pragma unroll
    for (int r = 0; r < 16; ++r) rli[r] = __builtin_amdgcn_rcpf(ol[r]);
    store(o, rli, wid, r32, hi);
    __syncthreads();
#undef F8_TCL
#undef F8_DMA_K
#undef F8_DMA_V
#undef F8_BAR
#undef F8_VM0
#undef F8_VMNP
#undef F8_LD32
#undef F8_KLOAD
#undef F8_VLOAD
#undef F8_QK
#undef F8_QKN
#undef F8_QKA
#undef F8_PVX
#undef F8_ONOP
#undef F8_SMX
#undef F8_PV
#undef F8_CV4
#undef F8_SM
#undef F8_STEP
#undef F8_PAIR_END
#undef F8_DMA2
  }
};
}


namespace fa8v {
using fa::f32x16; using fa::crow;
typedef int v8i __attribute__((ext_vector_type(8)));
typedef short v2s __attribute__((ext_vector_type(2)));
struct Body {
  static constexpr int SHM_K = 64 * 64, SHM_V = 128 * 64;
  static constexpr int OFF_V = 0, OFF_K = 4 * SHM_V, OFF_TAB = fa::Body<64, 4, 128, true>::OFF_TAB, OFF_WS = OFF_TAB + 392 * 4, LDS_NEED = OFF_WS + 8 * 32 * 4;
  static_assert(OFF_K + 4 * SHM_K <= OFF_TAB && LDS_NEED <= LDS_CTL, "fa8v LDS map");
  static __device__ __forceinline__ int offs(int row, int chunk) { return row * 64 + ((chunk ^ ((row >> 2) & 3)) << 4); }

  template <class Store>
  static __device__ __forceinline__ void run(const unsigned char* __restrict__ Qb, const unsigned char* __restrict__ Kh, const unsigned char* __restrict__ VTh, int seq, LAS unsigned char* lds, int q0, int cexp, Store store) {
    int tid_ = threadIdx.x; asm volatile("" : "+v"(tid_));
    const int tid = tid_, wid = __builtin_amdgcn_readfirstlane(tid >> 6), lane = tid & 63, r32 = lane & 31, hi = lane >> 5;
    const float* tab = (const float*)(lds + OFF_TAB);
    float* li_l = (float*)(lds + OFF_WS) + wid * 32;
    unsigned kgo, vgo;
    { const int pos = (wid & 3) * 1024 + lane * 16, row = pos >> 6, ch = ((pos & 63) >> 4) ^ ((row >> 2) & 3); kgo = (unsigned)(row * 64 + ch * 16); }
    { const int pos = wid * 1024 + lane * 16, row = pos >> 6, ch = ((pos & 63) >> 4) ^ ((row >> 2) & 3); vgo = (unsigned)(row * seq + ch * 16); }
    const int NT = seq / 64;
#define FV_TCL(t) ((t) < NT ? (t) : NT - 1)
#define FV_DMA_K(t, b) do { if (wid < 4) __builtin_amdgcn_global_load_lds((const unsigned*)(Kh + (size_t)FV_TCL(t) * 4096 + kgo), (LAS unsigned*)(lds + OFF_K + (b) * SHM_K + wid * 1024), 16, 0, 0); } while (0)
#define FV_DMA_V(t, b) __builtin_amdgcn_global_load_lds((const unsigned*)(VTh + (size_t)FV_TCL(t) * 64 + vgo), (LAS unsigned*)(lds + OFF_V + (b) * SHM_V + wid * 1024), 16, 0, 0)
#define FV_DMA2(a_) do { const int kt_ = (a_) + 4 + (wid >> 2); \
      __builtin_amdgcn_global_load_lds((const unsigned*)(Kh + (size_t)FV_TCL(kt_) * 4096 + kgo), (LAS unsigned*)(lds + OFF_K + (kt_ & 3) * SHM_K + (wid & 3) * 1024), 16, 0, 0); \
      __builtin_amdgcn_global_load_lds((const unsigned*)(VTh + (size_t)FV_TCL((a_) + 1) * 64 + vgo), (LAS unsigned*)(lds + OFF_V + (((a_) + 1) & 3) * SHM_V + wid * 1024), 16, 0, 0); \
      __builtin_amdgcn_global_load_lds((const unsigned*)(VTh + (size_t)FV_TCL((a_) + 2) * 64 + vgo), (LAS unsigned*)(lds + OFF_V + (((a_) + 2) & 3) * SHM_V + wid * 1024), 16, 0, 0); } while (0)
#define FV_BAR() do { __builtin_amdgcn_sched_barrier(0); __builtin_amdgcn_s_barrier(); __builtin_amdgcn_sched_barrier(0); } while (0)
#define FV_VM0() asm volatile("s_waitcnt vmcnt(0)" ::: "memory")
#define FV_VMNP() do { if (wid < 4) asm volatile("s_waitcnt vmcnt(2)" ::: "memory"); else asm volatile("s_waitcnt vmcnt(1)" ::: "memory"); } while (0)
    f32x16 o[4] = {}; f32x16 sA0, sA1, sB0, sB1; v8i pA, pB; int saA = 127, saB = 127;
    typedef float f32x4_t __attribute__((ext_vector_type(4)));
    f32x4_t ol4 = {0.f, 0.f, 0.f, 0.f};
    int c127 = 127, c124 = 124; asm volatile("" : "+v"(c127), "+v"(c124));
    v8i onesB; { const int on = ((((lane & 15) < 8) ? 0 : 1) == ((lane >> 4) & 1)) ? 0x38383838 : 0; onesB = (v8i){on, on, on, on, on, on, on, on}; }
    const float csc = __builtin_bit_cast(float, (unsigned)(127 + cexp) << 23); const int sap = 127 + cexp;
    v8i qf, kf[2], vf[4];
    { const unsigned char* Qw = Qb + (size_t)(wid * 32 + r32) * 64 + hi * 32;
      const u32x4 a = *(const u32x4*)Qw, b = *(const u32x4*)(Qw + 16); qf = (v8i){(int)a[0], (int)a[1], (int)a[2], (int)a[3], (int)b[0], (int)b[1], (int)b[2], (int)b[3]}; }
    const int qw = q0 + wid * 32;
    const int Lf = (qw - 154) >> 6, Rf = (qw + 122 + 63) >> 6, jn0 = (Lf >= 0) ? Lf + 1 : -1;
#define FV_CLS1(jt) ((jt) > Lf && (jt) < Rf)
#define FV_LD32(p0_, p1_) ({ const u32x4 a_ = *(const LAS u32x4*)(p0_), b_ = *(const LAS u32x4*)(p1_); (v8i){(int)a_[0], (int)a_[1], (int)a_[2], (int)a_[3], (int)b_[0], (int)b_[1], (int)b_[2], (int)b_[3]}; })
#define FV_KLOAD(kb) do { const LAS unsigned char* Ks_ = lds + OFF_K + (kb) * SHM_K; \
      _Pragma("unroll") for (int h2 = 0; h2 < 2; ++h2) { const int row = h2 * 32 + r32; kf[h2] = FV_LD32(Ks_ + offs(row, 2 * hi), Ks_ + offs(row, 2 * hi + 1)); } } while (0)
#define FV_VLOAD(vb) do { const LAS unsigned char* Vs_ = lds + OFF_V + (vb) * SHM_V; \
      _Pragma("unroll") for (int d = 0; d < 4; ++d) { const int row = d * 32 + r32; vf[d] = FV_LD32(Vs_ + offs(row, 2 * hi), Vs_ + offs(row, 2 * hi + 1)); } } while (0)
#define FV_QK1(S, KF) asm volatile("s_nop 1\n\tv_mfma_scale_f32_32x32x64_f8f6f4 %0, %1, %2, 0, %3, %4 op_sel_hi:[0,0,0]" : "=&v"(S) : "v"(KF), "v"(qf), "v"(c127), "v"(c124))
#define FV_QK(S0, S1) do { __builtin_amdgcn_sched_barrier(0); FV_QK1(S0, kf[0]); FV_QK1(S1, kf[1]); __builtin_amdgcn_sched_barrier(0); } while (0)
#define FV_PV1(P, SA, d) do { __builtin_amdgcn_sched_barrier(0); asm volatile("s_nop 1\n\tv_mfma_scale_f32_32x32x64_f8f6f4 %0, %1, %2, %0, %3, %4 op_sel_hi:[0,0,0] cbsz:1" : "+v"(o[d]) : "v"(P), "v"(vf[d]), "v"(SA), "v"(c127)); __builtin_amdgcn_sched_barrier(0); } while (0)
#define FV_PVS(P, SA) do { ol4 = __builtin_amdgcn_mfma_scale_f32_16x16x128_f8f6f4(P, onesB, ol4, 1, 0, 0, SA, 0, 127); } while (0)
#define FV_PV(P, SA) do { FV_PV1(P, SA, 0); FV_PV1(P, SA, 1); FV_PV1(P, SA, 2); FV_PV1(P, SA, 3); FV_PVS(P, SA); } while (0)
#define FV_ONOP() asm volatile("s_nop 15\n\ts_nop 15\n\ts_nop 15\n\ts_nop 15" ::: "memory")
#define FV_CV4(S, B4, SC) ({ const unsigned w0_ = __builtin_bit_cast(unsigned, __builtin_amdgcn_cvt_pkrtz(S[B4], S[B4 + 1])), w1_ = __builtin_bit_cast(unsigned, __builtin_amdgcn_cvt_pkrtz(S[B4 + 2], S[B4 + 3])); __builtin_amdgcn_perm(w1_, w0_, 0x07050301u); })
#define FV_FAC(jt, f, chg) do { chg = false; f = 1.f; if ((jt) == jn0 || (jt) == Rf) { chg = true; f = ((jt) == jn0) ? __builtin_amdgcn_exp2f(tab[0]) : __builtin_amdgcn_exp2f(-tab[384]); } } while (0)
#define FV_SM(jt, S0, S1, P, SA) FV_SMX(jt, S0, S1, P, SA, P, SA, false)
#define FV_SMX(jt, S0, S1, P, SA, PP_, SAP_, DOPV_) do { \
      if (FV_CLS1(jt)) { const float* tl_ = tab + ((jt) * 64 - (qw + r32) + 192 + 4 * hi); \
        _Pragma("unroll") for (int r = 0; r < 16; ++r) { S0[r] += tl_[(r & 3) + 8 * (r >> 2)]; S1[r] += tl_[32 + (r & 3) + 8 * (r >> 2)]; } } \
      _Pragma("unroll") for (int r = 0; r < 16; ++r) S0[r] = __builtin_amdgcn_exp2f(S0[r]); \
      if (DOPV_) FV_PV1(PP_, SAP_, 0); \
      _Pragma("unroll") for (int r = 0; r < 8; ++r) S1[r] = __builtin_amdgcn_exp2f(S1[r]); \
      if (DOPV_) FV_PV1(PP_, SAP_, 1); \
      _Pragma("unroll") for (int r = 8; r < 16; ++r) S1[r] = __builtin_amdgcn_exp2f(S1[r]); \
      if (DOPV_) { FV_PV1(PP_, SAP_, 2); } \
      unsigned x_[4], y_[4]; \
      _Pragma("unroll") for (int i = 0; i < 4; ++i) x_[i] = FV_CV4(S0, 4 * i, csc); \
      if (DOPV_) { FV_PV1(PP_, SAP_, 3); FV_PVS(PP_, SAP_); } \
      _Pragma("unroll") for (int i = 0; i < 4; ++i) y_[i] = FV_CV4(S1, 4 * i, csc); \
      _Pragma("unroll") for (int i = 0; i < 4; ++i) asm volatile("" : "+v"(x_[i]), "+v"(y_[i])); \
      P = (v8i){(int)x_[0], (int)x_[1], (int)x_[2], (int)x_[3], (int)y_[0], (int)y_[1], (int)y_[2], (int)y_[3]}; SA = sap; } while (0)
#define FV_ORESC(jt) do { bool chg_; float f_; FV_FAC(jt, f_, chg_); if (chg_) { FV_ONOP(); _Pragma("unroll") for (int d = 0; d < 4; ++d) _Pragma("unroll") for (int r = 0; r < 16; ++r) o[d][r] *= f_; ol4 *= f_; } } while (0)
#define FV_STEP(j_, SI0, SI1, SO0, SO1, PP, SAP, PN, SAN, dopv) do { \
      FV_QK(SO0, SO1); \
      __builtin_amdgcn_sched_barrier(0); \
      if (dopv) { FV_VLOAD(((j_) - 1) & 3); FV_ORESC((j_) - 1); } \
      FV_SMX(j_, SI0, SI1, PN, SAN, PP, SAP, dopv); \
      FV_KLOAD(((j_) + 2) & 3); \
      __builtin_amdgcn_sched_barrier(0); } while (0)
#define FV_PAIR_END() do { asm volatile("s_waitcnt lgkmcnt(0)" ::: "memory"); FV_VM0(); FV_BAR(); } while (0)

    FV_DMA_K(0, 0); FV_DMA_K(1, 1); FV_DMA_K(2, 2); FV_DMA_K(3, 3); FV_DMA_V(0, 0);
    FV_VM0(); FV_BAR();
    FV_KLOAD(0); FV_QK(sA0, sA1); FV_ONOP(); FV_ONOP(); __builtin_amdgcn_sched_barrier(0); FV_KLOAD(1);
    asm volatile("s_waitcnt lgkmcnt(0)" ::: "memory"); FV_BAR();
    FV_DMA2(0); __builtin_amdgcn_sched_barrier(0);
    FV_STEP(0, sA0, sA1, sB0, sB1, pB, saB, pA, saA, false);
    FV_STEP(1, sB0, sB1, sA0, sA1, pA, saA, pB, saB, true);
    FV_PAIR_END();
    for (int j = 2; j + 1 < NT; j += 2) {
      FV_DMA2(j); __builtin_amdgcn_sched_barrier(0);
      FV_STEP(j, sA0, sA1, sB0, sB1, pB, saB, pA, saA, true);
      FV_STEP(j + 1, sB0, sB1, sA0, sA1, pA, saA, pB, saB, true);
      FV_PAIR_END();
    }
    FV_VLOAD((NT - 1) & 3); FV_ORESC(NT - 1); FV_PV(pB, saB);
    FV_ONOP();
    if ((lane & 7) == 0) { const int qb_ = ((lane & 15) ? 16 : 0) + 4 * (lane >> 4);
      li_l[qb_ + 0] = ol4[0]; li_l[qb_ + 1] = ol4[1]; li_l[qb_ + 2] = ol4[2]; li_l[qb_ + 3] = ol4[3]; }
    asm volatile("s_waitcnt lgkmcnt(0)" ::: "memory");
    float rli[16];
#pragma unroll
    for (int r = 0; r < 16; ++r) rli[r] = __builtin_amdgcn_rcpf(li_l[crow(r, hi)]);
    store(o, rli, wid, r32, hi);
    __syncthreads();
#undef FV_TCL
#undef FV_DMA_K
#undef FV_DMA_V
#undef FV_BAR
#undef FV_VM0
#undef FV_VMNP
#undef FV_CLS1
#undef FV_LD32
#undef FV_KLOAD
#undef FV_VLOAD
#undef FV_QK
#undef FV_QK1
#undef FV_PV
#undef FV_PV1
#undef FV_PVS
#undef FV_ONOP
#undef FV_SMX
#undef FV_CV4
#undef FV_FAC
#undef FV_SM
#undef FV_ORESC
#undef FV_STEP
#undef FV_PAIR_END
#undef FV_DMA2
  }
};
}

__device__ __forceinline__ void attn0_fast(const Frame& F) {
  bf16_t* OB = WSP(bf16_t, A_OB);
  const float bnd_mla = pp_mla_bound(F), bnd_gqa = pp_gqa_bound(F);
  const bool pp_mla = bnd_mla <= PP_BF8, pp_gqa = bnd_gqa <= PP_BF8;
  const int cexp_mla = max(-8, (int)ceilf(bnd_mla - 15.5f)), cexp_gqa = max(-8, (int)ceilf(bnd_gqa - 15.5f));
  const int vcu = (F.G % 8 == 0) ? (F.bid % 8) * (F.G / 8) + F.bid / 8 : F.bid;
  for (int u = vcu; u < 64 * 32; u += F.G) {
    const int item = u >> 5, qb = u & 31, q0 = qb * 256;
    if (item < 32) {
      const int b = item >> 3, h = item & 7;
      bf16_t* Ow = OB + ((size_t)b * S_ + q0) * 1024 + h * 64;
      auto st = [&](const fa::f32x16* o, const float* rli, int wid, int r32, int hi) {
#pragma unroll
        for (int r = 0; r < 16; ++r) { const int orow = wid * 32 + fa::crow(r, hi);
#pragma unroll
          for (int d0 = 0; d0 < 2; ++d0) Ow[(size_t)orow * 1024 + d0 * 32 + r32] = f2bf(o[d0][r] * rli[r]); } };
      if (pp_mla) {
        const unsigned char* Qp = WSP(const unsigned char, A_QA) + (((size_t)b * 8 + h) * S_ + q0) * 128;
        const unsigned char* Kp = WSP(const unsigned char, A_KA) + (((size_t)b * 8 + h) * S_) * 128;
        const unsigned char* Vp = WSP(const unsigned char, A_VA) + ((size_t)b * 8 + h) * 64 * S_;
        fa8::Body<2>::run(Qp, Kp, Vp, S_, (LAS unsigned char*)F.lds, cexp_mla, st);
      } else {
        const bf16_t* Qp = WSP(const bf16_t, A_QA) + (((size_t)b * 8 + h) * S_ + q0) * 128;
        const bf16_t* Kp = WSP(const bf16_t, A_KA) + (((size_t)b * 8 + h) * S_) * 128;
        const bf16_t* Vp = WSP(const bf16_t, A_VA) + (((size_t)b * 8 + h) * S_) * 64;
        fa::Body<128, 6, 64, false>::run(Qp, Kp, Vp, S_, (char*)F.lds, 1.f, q0, st);
      }
    } else {
      const int it = item - 32, b = it >> 3, hq = it & 7, hk = hq >> 2;
      bf16_t* Ow = OB + ((size_t)b * S_ + q0) * 1024 + 512 + hq * 64;
      auto st = [&](const fa::f32x16* o, const float* rli, int wid, int r32, int hi) {
#pragma unroll
        for (int r = 0; r < 16; ++r) { const int orow = wid * 32 + fa::crow(r, hi);
#pragma unroll
          for (int d0 = 0; d0 < 2; ++d0) Ow[(size_t)orow * 1024 + d0 * 32 + r32] = f2bf(o[d0][r] * rli[r]); } };
      if (pp_gqa) {
        const unsigned char* Qp = WSP(const unsigned char, A_QG) + (((size_t)b * 8 + hq) * S_ + q0) * 64;
        const unsigned char* Kp = WSP(const unsigned char, A_KG) + (((size_t)b * 2 + hk) * S_) * 64;
        const unsigned char* Vp = WSP(const unsigned char, A_VG) + ((size_t)b * 2 + hk) * 64 * S_;
        fa8::Body<1>::run(Qp, Kp, Vp, S_, (LAS unsigned char*)F.lds, cexp_gqa, st);
      } else {
        const bf16_t* Qp = WSP(const bf16_t, A_QG) + (((size_t)b * 8 + hq) * S_ + q0) * 64;
        const bf16_t* Kp = WSP(const bf16_t, A_KG) + (((size_t)b * 2 + hk) * S_) * 64;
        const bf16_t* Vp = WSP(const bf16_t, A_VG) + (((size_t)b * 2 + hk) * S_) * 64;
        fa::Body<64, 4, 64, false>::run(Qp, Kp, Vp, S_, (char*)F.lds, 1.f, q0, st);
      }
    }
  }
}
#ifndef FP8_FROM_COMP
#define FP8_FROM_COMP 0
#endif
__device__ __forceinline__ void attn1_fast(const Frame& F) {
  float* OD = WSP(float, A_OD);
  bf16_t* OB = WSP(bf16_t, A_OB1);
  using B1 = fa::Body<64, 4, 128, true>;
  const float bnd = pp_diff_bound(F);
  const bool pp = bnd <= PP_F16;
  const int cexp = 0;
  const float lambda_init = 0.8f - 0.6f * 0.7408182206817179f;
  float lam;
  { const float a = F.in[I_LQ1][F.lane] * F.in[I_LK1][F.lane], c = F.in[I_LQ2][F.lane] * F.in[I_LK2][F.lane];
    lam = __expf(wave_sum(a)) - __expf(wave_sum(c)) + lambda_init; }
  float* tab = (float*)(F.lds + B1::OFF_TAB);
  const int vcu = (F.G % 8 == 0) ? (F.bid % 8) * (F.G / 8) + F.bid / 8 : F.bid;
  const int nround = (64 * 32 + F.G - 1) / F.G;
  int curh = -1;
  for (int v = vcu; v < 32 * 32; v += F.G)
  for (int comp = 0; comp < 2; ++comp) {
    const int pair = v >> 5, qb = v & 31, q0 = qb * 256;
    const int b = pair >> 3, h = pair & 7, h16 = h * 2 + comp;
    if (h != curh) {
      for (int i = F.tid; i < 385; i += NTHR) tab[i] = F.in[I_RELB][t5_bucket(i - 192) * 8 + h] * LOG2E;
      curh = h; __syncthreads();
    }
    const bf16_t* Qp = WSP(const bf16_t, A_QD) + (((size_t)b * 16 + h16) * S_ + q0) * 64;
    const bf16_t* Kp = WSP(const bf16_t, A_KD) + (((size_t)b * 16 + h16) * S_) * 64;
    const bf16_t* Vp = WSP(const bf16_t, A_VD) + (((size_t)b * 8 + h) * S_) * 128;
    float* Od = OD + (((size_t)b * S_ + q0) * 8 + h) * 128;
    bf16_t* Ob = OB + ((size_t)b * S_ + q0) * 1024 + h * 128;
    const float* sub = F.in[I_SUBLN];
    auto st = [&](const fa::f32x16* o, const float* rli, int wid, int r32, int hi) {
      if (comp == 0) {
#pragma unroll
        for (int r = 0; r < 16; ++r) { const int orow = wid * 32 + fa::crow(r, hi);
#pragma unroll
          for (int d0 = 0; d0 < 4; ++d0) Od[(size_t)orow * 1024 + d0 * 32 + r32] = o[d0][r] * rli[r]; }
        asm volatile("s_waitcnt vmcnt(0)" ::: "memory");
      } else {
        float g[4];
#pragma unroll
        for (int d0 = 0; d0 < 4; ++d0) g[d0] = sub[d0 * 32 + r32] * (1.f - lambda_init);
#pragma unroll
        for (int r = 0; r < 16; ++r) { const int orow = wid * 32 + fa::crow(r, hi);
          float x[4]; float ss = 0.f;
#pragma unroll
          for (int d0 = 0; d0 < 4; ++d0) { x[d0] = Od[(size_t)orow * 1024 + d0 * 32 + r32] - lam * (o[d0][r] * rli[r]); ss += x[d0] * x[d0]; }
          ss += __shfl_xor(ss, 1); ss += __shfl_xor(ss, 2); ss += __shfl_xor(ss, 4); ss += __shfl_xor(ss, 8); ss += __shfl_xor(ss, 16);
          const float rn = rsqrtf(ss * (1.f / 128.f) + EPS_);
#pragma unroll
          for (int d0 = 0; d0 < 4; ++d0) Ob[(size_t)orow * 1024 + d0 * 32 + r32] = f2bf(x[d0] * rn * g[d0]); }
      } };
    if (pp && comp >= FP8_FROM_COMP) {
      const unsigned char* Q8 = WSP(const unsigned char, A_Q8D) + (((size_t)b * 16 + h16) * S_ + q0) * 64;
      const unsigned char* K8 = WSP(const unsigned char, A_K8D) + (((size_t)b * 16 + h16) * S_) * 64;
      const unsigned char* V8 = WSP(const unsigned char, A_VT8D) + ((size_t)b * 8 + h) * 128 * S_;
      fa8v::Body::run(Q8, K8, V8, S_, (LAS unsigned char*)F.lds, q0, cexp, st);
    }
    else if (pp) fa::Body<64, 4, 128, true, true>::run(Qp, Kp, Vp, S_, (char*)F.lds, 1.f, q0, st);
    else         B1::run(Qp, Kp, Vp, S_, (char*)F.lds, 1.f, q0, st);
  }
  (void)nround;
}


constexpr int NPH = 21;
__global__ void __launch_bounds__(NTHR, 2) mega(Args a) {
  extern __shared__ __attribute__((aligned(16))) unsigned char lds[];
  Frame F;
#pragma unroll
  for (int i = 0; i < N_IN; ++i) F.in[i] = a.in[i];
  F.out = a.out; F.ws = a.ws; F.lds = lds;
  F.tid = threadIdx.x; F.lane = F.tid & 63; F.wave = __builtin_amdgcn_readfirstlane(F.tid >> 6); F.G = gridDim.x; F.bid = blockIdx.x;
  if (F.tid < 4) ((unsigned*)(lds + LDS_CTL))[F.tid] = 0u;
  __syncthreads();
  XcdBarrier bar; bar.bar = (unsigned*)(F.ws + WS_CTL); bar.x = 0; bar.st = nullptr;
#if MK_ONE_LAUNCH
  bar = xcd_barrier_post((unsigned*)(F.ws + WS_CTL), (volatile LAS unsigned*)(lds + LDS_CTL));
#define GRID_BAR() xcd_barrier(bar)
#else
#define GRID_BAR() do {} while (0)
#endif
  const int lo = a.ph_lo, hi = a.ph_hi;
#define IN(k) (lo <= (k) && (k) < hi)
#define SEAM(k) do { if (IN((k) + 1)) GRID_BAR(); } while (0)

  if (IN(0)) { phase0(F); SEAM(0); }
  if (IN(1)) { phase_xnorm<0>(F, 0); SEAM(1); }
  if (IN(2)) {
    {
    pg::DenseOrder S; S.init(WSP(const bf16_t, WS_HB), WSP(const bf16_t, WS_WIN0), T_, P0LD, 512, F.G, F.bid);
    pg::EpiStoreBf16 E{WSP(bf16_t, A_PROJ0), P0LD};
    pg::gemm_phase<pg::EpiStoreBf16, pg::DenseOrder, false, true>((LAS unsigned char*)lds, 512, S, E, 121  , 127);
    }
    SEAM(2);
  }
  if (IN(3)) { phase_split0(F); SEAM(3); }
  if (IN(4)) {
    {
    { pg::DenseOrder S; S.init(WSP(const bf16_t, A_CQN), WSP(const bf16_t, WS_WQB), T_, 768, 512, F.G, F.bid);
      pg::EpiStoreBf16 E{WSP(bf16_t, A_QRAW), 768};
      pg::gemm_phase<pg::EpiStoreBf16, pg::DenseOrder, false>((LAS unsigned char*)lds, 512, S, E); }
    { pg::DenseOrder S; S.init(WSP(const bf16_t, A_CKVN), WSP(const bf16_t, WS_WKVB), T_, 1024, 256, F.G, F.bid);
      pg::EpiStoreBf16 E{WSP(bf16_t, A_KVRAW), 1024};
      pg::gemm_phase<pg::EpiStoreBf16, pg::DenseOrder, false>((LAS unsigned char*)lds, 256, S, E); }
    }
    SEAM(4);
  }
  if (IN(5)) { phase_mla(F); SEAM(5); }
  if (IN(6)) { attn0_fast(F); SEAM(6); }
  if (IN(7)) {
    {
    pg::DenseOrder S; S.init(WSP(const bf16_t, A_OB), WSP(const bf16_t, WS_WOUT0), T_, 1024, 1024, F.G, F.bid);
    pg::EpiResid E{F.in[I_X], F.out, WSP(const float, WS_MOD) + 2048, WSP(float, WS_ROWSS)};
    pg::gemm_phase<pg::EpiResid, pg::DenseOrder, false>((LAS unsigned char*)lds, 1024, S, E);
    }
    SEAM(7);
  }
  if (IN(8)) { phase_route(F, 0); SEAM(8); }
  if (IN(9)) { moe_up_fast(F, 0); SEAM(9); }
  if (IN(10)) { moe_down_fast(F, 0); SEAM(10); }
  if (IN(11)) { phase_xnorm<1>(F, 1); SEAM(11); }
  if (IN(12)) {
    const bool pp1 = pp_diff_ok(F);
    {
    pg::DenseOrder S; S.init(WSP(const bf16_t, WS_HB), WSP(const bf16_t, WS_WIN1), T_, 3072, 512, F.G, F.bid);
    pg::EpiSplit1 E{WSP(bf16_t, A_QD), WSP(bf16_t, A_KD), WSP(bf16_t, A_VD), F.in[I_CQN], F.in[I_CKN], WSP(unsigned char, A_Q8D), WSP(unsigned char, A_K8D), pp1 ? 0 : 1};
    pg::gemm_phase<pg::EpiSplit1, pg::DenseOrder, false, true, 1>((LAS unsigned char*)lds, 512, S, E, 121  , 127);
    }
    SEAM(12);
  }
  if (IN(13)) { phase_vt1(F); SEAM(13); }
  if (IN(14)) { attn1_fast(F); SEAM(14); }
  if (IN(16)) {
    pg::DenseOrder S; S.init(WSP(const bf16_t, A_OB1), WSP(const bf16_t, WS_WOUT1), T_, 1024, 1024, F.G, F.bid);
    pg::EpiResid E{F.out, F.out, WSP(const float, WS_MOD) + (size_t)4 * 6144 + 2048, WSP(float, WS_ROWSS)};
    pg::gemm_phase<pg::EpiResid, pg::DenseOrder, false>((LAS unsigned char*)lds, 1024, S, E);
    SEAM(16);
  }
  if (IN(17)) { phase_route(F, 1); SEAM(17); }
  if (IN(18)) { moe_up_fast(F, 1); SEAM(18); }
  if (IN(19)) { moe_down_fast(F, 1); SEAM(19); }
  if (IN(20)) { phase_xnorm<2>(F, 1); }
}
}

extern "C" void kernel_launch(void* const* d_in, const int* in_sizes, int n_in, void* d_out, int out_size, void* d_ws, size_t ws_size, hipStream_t stream) {
  static int grid = 0;
  if (grid == 0) {
    if (n_in != N_IN || out_size != T_ * D_ || ws_size < WS_END) { fprintf(stderr, "kernel_launch: bad shapes n_in %d out %d ws %zu (need %zu)\n", n_in, out_size, ws_size, (size_t)WS_END); grid = -1; return; }
    int dev = 0, cus = 0, per_cu = 0;
    if (hipGetDevice(&dev) != hipSuccess || hipDeviceGetAttribute(&cus, hipDeviceAttributeMultiprocessorCount, dev) != hipSuccess) { grid = -1; return; }
    if (hipFuncSetAttribute((const void*)mega, hipFuncAttributeMaxDynamicSharedMemorySize, LDS_BYTES) != hipSuccess) { fprintf(stderr, "kernel_launch: hipFuncSetAttribute failed\n"); grid = -1; return; }
    if (hipOccupancyMaxActiveBlocksPerMultiprocessor(&per_cu, (const void*)mega, NTHR, LDS_BYTES) != hipSuccess || per_cu < 1) { fprintf(stderr, "kernel_launch: occupancy query says %d\n", per_cu); }
    (void)hipGetLastError();
    grid = cus;
  }
  if (grid < 0) return;
  (void)in_sizes;
  (void)hipMemsetAsync((char*)d_ws + WS_CTL, 0, CTL_BYTES, stream);
  Args a{};
  for (int i = 0; i < N_IN; ++i) a.in[i] = (const float*)d_in[i];
  a.out = (float*)d_out; a.ws = (unsigned char*)d_ws;
#if MK_ONE_LAUNCH
  a.ph_lo = 0; a.ph_hi = NPH;
  hipLaunchKernelGGL(mega, dim3(grid), dim3(NTHR), LDS_BYTES, stream, a);
#else
  for (int p = 0; p < NPH; ++p) { a.ph_lo = p; a.ph_hi = p + 1; hipLaunchKernelGGL(mega, dim3(grid), dim3(NTHR), LDS_BYTES, stream, a); }
#endif
}
```

```cpp
#include <hip/hip_runtime.h>
#include <cstdio>
#include <cstdint>

#ifndef MK_ONE_LAUNCH
#define MK_ONE_LAUNCH 1
#endif

namespace {
typedef unsigned short bf16_t;
typedef float f32x4 __attribute__((ext_vector_type(4)));
typedef unsigned u32x2 __attribute__((ext_vector_type(2)));
typedef unsigned u32x4 __attribute__((ext_vector_type(4)));

constexpr int T_ = 32768, S_ = 8192, NB_ = 4, D_ = 1024;
constexpr int NTHR = 512;
constexpr int LDS_BYTES = 147456;
constexpr int LDS_CTL = 131072;
constexpr float EPS_ = 1e-6f;

constexpr size_t al256(size_t x) { return (x + 255) / 256 * 256; }
constexpr size_t WS_CTL   = 0;
constexpr size_t CTL_BYTES = 65536;
constexpr size_t CW_CNT   = 16384;
constexpr size_t WS_MODP  = WS_CTL + CTL_BYTES;
constexpr size_t WS_MOD   = WS_MODP + al256((size_t)8 * 2 * 4 * 6144 * 4);
constexpr size_t WS_COS   = WS_MOD + al256((size_t)2 * 4 * 6144 * 4);
constexpr size_t WS_SIN   = WS_COS + (size_t)8192 * 16 * 4;
constexpr int P0LD = 1792;
constexpr size_t WS_WR    = WS_SIN + (size_t)8192 * 16 * 4;
constexpr size_t WS_WIN0  = WS_WR + (size_t)2 * 2 * 48 * 1024 * 2;
constexpr size_t WS_WQB   = WS_WIN0 + (size_t)P0LD * 1024 * 2;
constexpr size_t WS_WKVB  = WS_WQB + (size_t)768 * 512 * 2;
constexpr size_t WS_WOUT0 = WS_WKVB + (size_t)1024 * 256 * 2;
constexpr size_t WS_WIN1  = WS_WOUT0 + (size_t)1024 * 1024 * 2;
constexpr size_t WS_WOUT1 = WS_WIN1 + (size_t)3072 * 1024 * 2;
constexpr size_t WS_WUP   = WS_WOUT1 + (size_t)1024 * 1024 * 2;
constexpr size_t WS_WDN   = WS_WUP + (size_t)64 * 1024 * 1024 * 2;
constexpr size_t WS_HB    = WS_WDN + (size_t)64 * 1024 * 512 * 2;
constexpr size_t WS_GATEW = WS_HB + (size_t)T_ * 1024 * 2;
constexpr size_t WS_ROWSS = WS_GATEW + (size_t)T_ * 2 * 4;
constexpr size_t WS_LIST  = WS_ROWSS + (size_t)T_ * 16 * 4;
constexpr size_t WS_ARENA = WS_LIST + (size_t)32 * 65536 * 4;
constexpr size_t A_PROJ0 = WS_ARENA;
constexpr size_t A_CQN   = A_PROJ0 + (size_t)T_ * P0LD * 2;
constexpr size_t A_CKVN  = A_CQN + (size_t)T_ * 512 * 2;
constexpr size_t A_QG    = A_CKVN + (size_t)T_ * 256 * 2;
constexpr size_t A_KG    = A_QG + (size_t)T_ * 512 * 2;
constexpr size_t A_VG    = A_KG + (size_t)T_ * 128 * 2;
constexpr size_t A_QRAW  = A_VG + (size_t)T_ * 128 * 2;
constexpr size_t A_KVRAW = A_QRAW + (size_t)T_ * 768 * 2;
constexpr size_t A_QA    = A_KVRAW + (size_t)T_ * 1024 * 2;
constexpr size_t A_KA    = A_QA + (size_t)T_ * 1024 * 2;
constexpr size_t A_VA    = A_KA + (size_t)T_ * 1024 * 2;
constexpr size_t A_OB    = A_VA + (size_t)T_ * 512 * 2;
constexpr size_t A_END0  = A_OB + (size_t)T_ * 1024 * 2;
constexpr size_t A_ACT   = WS_ARENA;
constexpr size_t A_YB    = A_ACT + (size_t)(65536 + 256) * 512 * 2;
constexpr size_t A_ENDM  = A_YB + (size_t)T_ * 2 * 1024 * 2;
constexpr size_t A_QD    = WS_ARENA;
constexpr size_t A_KD    = A_QD + (size_t)T_ * 1024 * 2;
constexpr size_t A_VD    = A_KD + (size_t)T_ * 1024 * 2;
constexpr size_t A_PROJ1 = A_VD + (size_t)T_ * 1024 * 2;
constexpr size_t A_OD    = A_PROJ1;
constexpr size_t A_Q8D   = A_OD + (size_t)T_ * 1024 * 4;
constexpr size_t A_K8D   = A_Q8D + (size_t)T_ * 1024;
constexpr size_t A_VT8D  = A_K8D + (size_t)T_ * 1024;
constexpr size_t A_OB1   = A_OD + (size_t)T_ * 2048 * 4;
constexpr size_t A_END1  = A_OB1 + (size_t)T_ * 1024 * 2;
constexpr size_t WS_END  = (A_END0 > A_END1 ? (A_END0 > A_ENDM ? A_END0 : A_ENDM) : (A_END1 > A_ENDM ? A_END1 : A_ENDM));

enum { I_X = 0, I_C, I_ADAW, I_ADAB, I_NMIX, I_NFFN, I_RELB, I_ABWIN, I_ABQAN, I_ABWQB, I_ABKVAN, I_ABWKVB, I_MLAQN, I_MLAKN, I_GQAQN, I_GQAKN,
       I_ABWOUT, I_CWIN, I_CQN, I_CKN, I_LQ1, I_LK1, I_LQ2, I_LK2, I_SUBLN, I_CWOUT, I_WG, I_BG, I_WE, I_BE, I_WUP, I_WDN, N_IN };

struct Args { const float* in[N_IN]; float* out; unsigned char* ws; int ph_lo, ph_hi; };

__device__ __forceinline__ float bf2f(unsigned short h) { return __uint_as_float((unsigned)h << 16); }
__device__ __forceinline__ unsigned short f2bf(float f) { unsigned u = __float_as_uint(f); u += 0x7fffu + ((u >> 16) & 1u); return (unsigned short)(u >> 16); }
__device__ __forceinline__ unsigned pack2(float lo, float hi) { return (unsigned)f2bf(lo) | ((unsigned)f2bf(hi) << 16); }
__device__ __forceinline__ float bflo(unsigned w) { return __uint_as_float(w << 16); }
__device__ __forceinline__ float bfhi(unsigned w) { return __uint_as_float(w & 0xffff0000u); }
__device__ __forceinline__ float wave_sum(float v) {
#pragma unroll
  for (int o = 32; o >= 1; o >>= 1) v += __shfl_xor(v, o);
  return v;
}
__device__ __forceinline__ float siluf(float x) { return x / (1.f + __expf(-x)); }

#define XB_TMO      128
#define XB_XCNT(j)  (256  + 64 * (j))
#define XB_XSUB(j)  (1280 + 64 * (j))
#define XB_XGEN(j)  (2304 + 64 * (j))
#define XB_TOP      3328
#define XB_TOPGEN   3392
#define XCD_BAR_WORDS 3456
#define XB_SPIN_CAP (1u << 24)
#define LAS __attribute__((address_space(3)))

__device__ __forceinline__ unsigned xb_ld(unsigned* p)              { return __hip_atomic_load(p, __ATOMIC_RELAXED, __HIP_MEMORY_SCOPE_AGENT); }
__device__ __forceinline__ unsigned xb_add(unsigned* p, unsigned v) { return __hip_atomic_fetch_add(p, v, __ATOMIC_RELAXED, __HIP_MEMORY_SCOPE_AGENT); }
__device__ __forceinline__ unsigned xb_xcc_id() { return (unsigned)__builtin_amdgcn_s_getreg((3 << 11) | 20) & 0xFu; }
#define XB_SPIN(cond, bar) do { unsigned _sp = 0; while (cond) { __builtin_amdgcn_s_sleep(1); \
    if ((++_sp & 255u) == 0u) { if (xb_ld(&(bar)[XB_TMO])) break; if (_sp > XB_SPIN_CAP) { atomicAdd(&(bar)[XB_TMO], 1u); break; } } } } while (0)

struct XcdBarrier { unsigned* bar; unsigned x; volatile LAS unsigned* st; };

__device__ __forceinline__ XcdBarrier xcd_barrier_post(unsigned* bar, volatile LAS unsigned* st) {
    XcdBarrier b; b.bar = bar; b.x = xb_xcc_id(); b.st = st;
    if (threadIdx.x == 0) (void)xb_add(&bar[XB_XCNT(b.x)], 1u);
    return b;
}
__device__ __forceinline__ void xcd_barrier_complete(unsigned* bar, unsigned x, unsigned& nloc, unsigned& nx) {
    const unsigned G = gridDim.x * gridDim.y * gridDim.z;
    unsigned sum, cnt, mine, sp = 0u;
    for (;;) {
        sum = 0u; cnt = 0u; mine = 0u;
#pragma unroll
        for (unsigned j = 0; j < 16; ++j) { const unsigned c = xb_ld(&bar[XB_XCNT(j)]); sum += c; cnt += (c > 0u) ? 1u : 0u; mine = (j == x) ? c : mine; }
        if (sum == G) break;
        __builtin_amdgcn_s_sleep(1);
        if ((++sp & 255u) == 0u) { if (xb_ld(&bar[XB_TMO])) break; if (sp > XB_SPIN_CAP) { atomicAdd(&bar[XB_TMO], 1u); break; } }
    }
    nloc = mine > 0u ? mine : 1u; nx = cnt > 0u ? cnt : 1u;
}
__device__ __forceinline__ void xcd_barrier(const XcdBarrier& b) {
    asm volatile("s_waitcnt vmcnt(0)" ::: "memory");
    __syncthreads();
    if (threadIdx.x == 0) {
        unsigned* bar = b.bar;
        __builtin_amdgcn_s_waitcnt(0);
        unsigned nloc = b.st[0], nx = b.st[1];
        if (nloc == 0u) { xcd_barrier_complete(bar, b.x, nloc, nx); b.st[0] = nloc; b.st[1] = nx; }
        const unsigned old = xb_add(&bar[XB_XSUB(b.x)], 1u);
        const unsigned gen = old / nloc;
        if (old + 1u == (gen + 1u) * nloc) {
            __builtin_amdgcn_fence(__ATOMIC_RELEASE, "agent");
            asm volatile("s_waitcnt vmcnt(0)" ::: "memory");
            const unsigned og = xb_add(&bar[XB_TOP], 1u);
            const unsigned tg = og / nx;
            if (og + 1u == (tg + 1u) * nx) xb_add(&bar[XB_TOPGEN], 1u);
            else XB_SPIN(xb_ld(&bar[XB_TOPGEN]) == tg, bar);
            __builtin_amdgcn_fence(__ATOMIC_ACQUIRE, "agent");
            xb_add(&bar[XB_XGEN(b.x)], 1u);
            asm volatile("s_waitcnt vmcnt(0)" ::: "memory");
        } else {
            XB_SPIN(xb_ld(&bar[XB_XGEN(b.x)]) == gen, bar);
            __builtin_amdgcn_fence(__ATOMIC_ACQUIRE, "agent");
            asm volatile("s_waitcnt vmcnt(0)" ::: "memory");
        }
    }
    __syncthreads();
}

struct Frame {
  const float* in[N_IN]; float* out; unsigned char* ws; unsigned char* lds;
  int tid, lane, wave, G, bid;
};
#define WSP(T, off) ((T*)(F.ws + (off)))

__device__ __forceinline__ const float* modp(const Frame& F, int l, int b) { return WSP(const float, WS_MOD) + ((size_t)l * 4 + b) * 6144; }

__device__ __forceinline__ unsigned pk4_fp8(float a, float b, float c, float d) { int r = __builtin_amdgcn_cvt_pk_fp8_f32(a, b, 0, false); r = __builtin_amdgcn_cvt_pk_fp8_f32(c, d, r, true); return (unsigned)r; }
constexpr float MOE_WUP_SC = 64.f, MOE_WDN_SC = 32.f, MOE_ACT_SC = 4.f;
constexpr float INPROJ_W_SC = 64.f;
struct CvtJob { const float* src; bf16_t* dst; int K, Nsrc, k0, n0, perm; float f8s; };
__device__ __forceinline__ void cvt_fetch(const CvtJob& J, int tid, f32x4& v0, f32x4& v1) {
  const int r = tid >> 4, c4 = (tid & 15) * 4;
  v0 = f32x4{0.f, 0.f, 0.f, 0.f}; v1 = v0;
  if (J.n0 + c4 < J.Nsrc) {
    v0 = *(const f32x4*)(J.src + (size_t)(J.k0 + r) * J.Nsrc + J.n0 + c4);
    v1 = *(const f32x4*)(J.src + (size_t)(J.k0 + r + 32) * J.Nsrc + J.n0 + c4);
  }
}
__device__ __forceinline__ void cvt_put(const Frame& F, const f32x4& v0, const f32x4& v1) {
  float* tile = (float*)(F.lds + 1024);
  const int r = F.tid >> 4, c4 = (F.tid & 15) * 4;
  tile[r * 65 + c4 + 0] = v0[0]; tile[r * 65 + c4 + 1] = v0[1]; tile[r * 65 + c4 + 2] = v0[2]; tile[r * 65 + c4 + 3] = v0[3];
  tile[(r + 32) * 65 + c4 + 0] = v1[0]; tile[(r + 32) * 65 + c4 + 1] = v1[1]; tile[(r + 32) * 65 + c4 + 2] = v1[2]; tile[(r + 32) * 65 + c4 + 3] = v1[3];
}
__device__ __forceinline__ void cvt_emit(const Frame& F, const CvtJob& J) {
  const float* tile = (const float*)(F.lds + 1024);
  const int tid = F.tid;
  const int n = tid >> 3, kc = (tid & 7) * 8;
  int nd = J.n0 + n;
  if (J.perm) nd = (nd < 512) ? 2 * nd : 2 * (nd - 512) + 1;
  const float f8scale = J.f8s;
  if (f8scale > 0.f) {
    u32x2 w8; w8[0] = pk4_fp8(tile[(kc + 0) * 65 + n] * f8scale, tile[(kc + 1) * 65 + n] * f8scale, tile[(kc + 2) * 65 + n] * f8scale, tile[(kc + 3) * 65 + n] * f8scale);
    w8[1] = pk4_fp8(tile[(kc + 4) * 65 + n] * f8scale, tile[(kc + 5) * 65 + n] * f8scale, tile[(kc + 6) * 65 + n] * f8scale, tile[(kc + 7) * 65 + n] * f8scale);
    *(u32x2*)((unsigned char*)J.dst + (size_t)nd * J.K + J.k0 + kc) = w8;
  } else {
    u32x4 w;
    w[0] = pack2(tile[(kc + 0) * 65 + n], tile[(kc + 1) * 65 + n]);
    w[1] = pack2(tile[(kc + 2) * 65 + n], tile[(kc + 3) * 65 + n]);
    w[2] = pack2(tile[(kc + 4) * 65 + n], tile[(kc + 5) * 65 + n]);
    w[3] = pack2(tile[(kc + 6) * 65 + n], tile[(kc + 7) * 65 + n]);
    *(u32x4*)(J.dst + (size_t)nd * J.K + J.k0 + kc) = w;
  }
}

__device__ __forceinline__ void phase0(const Frame& F) {
  constexpr int J0 = 16 * 28, J1 = 8 * 12, J2 = 4 * 16, J3 = 16 * 16, J4 = 16 * 48, J5 = 16 * 16, J6 = 64 * 256, J7 = 64 * 128;
  constexpr int E0 = J0, E1 = E0 + J1, E2 = E1 + J2, E3 = E2 + J3, E4 = E3 + J4, E5 = E4 + J5, E6 = E5 + J6, E7 = E6 + J7;
  auto decode = [&](int u) -> CvtJob {
    const float* src; bf16_t* dst; int K, Nsrc, ntn, perm = 0, v; float f8s = 0.f;
    if (u < E0)      { v = u;      src = F.in[I_ABWIN];  dst = WSP(bf16_t, WS_WIN0);  K = 1024; Nsrc = 1568; ntn = 28; f8s = INPROJ_W_SC; }
    else if (u < E1) { v = u - E0; src = F.in[I_ABWQB];  dst = WSP(bf16_t, WS_WQB);   K = 512;  Nsrc = 768;  ntn = 12; }
    else if (u < E2) { v = u - E1; src = F.in[I_ABWKVB]; dst = WSP(bf16_t, WS_WKVB);  K = 256;  Nsrc = 1024; ntn = 16; }
    else if (u < E3) { v = u - E2; src = F.in[I_ABWOUT]; dst = WSP(bf16_t, WS_WOUT0); K = 1024; Nsrc = 1024; ntn = 16; }
    else if (u < E4) { v = u - E3; src = F.in[I_CWIN];   dst = WSP(bf16_t, WS_WIN1);  K = 1024; Nsrc = 3072; ntn = 48; f8s = INPROJ_W_SC; }
    else if (u < E5) { v = u - E4; src = F.in[I_CWOUT];  dst = WSP(bf16_t, WS_WOUT1); K = 1024; Nsrc = 1024; ntn = 16; }
    else if (u < E6) { v = u - E5; const int m = v >> 8; v &= 255; src = F.in[I_WUP] + (size_t)m * 1024 * 1024; dst = (bf16_t*)(WSP(unsigned char, WS_WUP) + (size_t)m * 1024 * 1024); K = 1024; Nsrc = 1024; ntn = 16; perm = 1; f8s = MOE_WUP_SC; }
    else             { v = u - E6; const int m = v >> 7; v &= 127; src = F.in[I_WDN] + (size_t)m * 512 * 1024;  dst = (bf16_t*)(WSP(unsigned char, WS_WDN) + (size_t)m * 1024 * 512);  K = 512;  Nsrc = 1024; ntn = 16; f8s = MOE_WDN_SC; }
    const int kt = v / ntn, nt = v % ntn;
    return CvtJob{src, dst, K, Nsrc, kt * 64, nt * 64, perm, f8s};
  };
  {
    int u = F.bid;
    CvtJob J = decode(u < E7 ? u : 0);
    f32x4 a0, a1;
    if (u < E7) cvt_fetch(J, F.tid, a0, a1);
    while (u < E7) {
      cvt_put(F, a0, a1);
      asm volatile("s_waitcnt lgkmcnt(0)\n\ts_barrier" ::: "memory");
      const CvtJob Jc = J;
      const int un = u + F.G;
      if (un < E7) { J = decode(un); cvt_fetch(J, F.tid, a0, a1); }
      cvt_emit(F, Jc);
      asm volatile("s_waitcnt lgkmcnt(0)\n\ts_barrier" ::: "memory");
      u = un;
    }
  }
  for (int i = F.bid * NTHR + F.tid; i < 2 * 48 * 1024; i += F.G * NTHR) {
    const int l = i / (48 * 1024), j = (i >> 10) % 48, k = i & 1023;
    float v = 0.f;
    if (j < 4) v = F.in[I_WG][((size_t)l * 1024 + k) * 4 + j];
    else if (j < 36) v = F.in[I_WE][(((size_t)l * 4 + ((j - 4) >> 3)) * 1024 + k) * 8 + ((j - 4) & 7)];
    const unsigned short hi = f2bf(v);
    WSP(unsigned short, WS_WR)[(size_t)(l * 2 + 0) * 48 * 1024 + j * 1024 + k] = hi;
    WSP(unsigned short, WS_WR)[(size_t)(l * 2 + 1) * 48 * 1024 + j * 1024 + k] = f2bf(v - bf2f(hi));
  }
  {
    float* sc = (float*)(F.lds + 1024);
    for (int u = F.bid; u < 192; u += F.G) {
      const int kc = u & 7, cb = (u >> 3) % 12, l = u / 96;
      __syncthreads();
      { const int b = F.tid >> 7, k = F.tid & 127; sc[F.tid] = siluf(F.in[I_C][b * 1024 + kc * 128 + k]); }
      __syncthreads();
      const int j = cb * 512 + F.tid;
      const float* w = F.in[I_ADAW] + ((size_t)l * 1024 + kc * 128) * 6144 + j;
      float a0 = 0.f, a1 = 0.f, a2 = 0.f, a3 = 0.f;
#pragma unroll 8
      for (int k = 0; k < 128; ++k) { const float wv = w[(size_t)k * 6144]; a0 += sc[k] * wv; a1 += sc[128 + k] * wv; a2 += sc[256 + k] * wv; a3 += sc[384 + k] * wv; }
      float* mp = WSP(float, WS_MODP) + ((size_t)kc * 2 + l) * 4 * 6144 + j;
      mp[0] = a0; mp[6144] = a1; mp[2 * 6144] = a2; mp[3 * 6144] = a3;
    }
  }
  for (int i = F.bid * NTHR + F.tid; i < 8192 * 16; i += F.G * NTHR) {
    const int pos = i >> 4, j = i & 15;
    const float inv = (float)pow(10000.0, -(double)j / 16.0);
    const float ang = (float)pos * inv;
    const double rev = (double)ang * 0.15915494309189533577;
    const float fr = (float)(rev - rint(rev));
    WSP(float, WS_COS)[i] = __builtin_amdgcn_cosf(fr);
    WSP(float, WS_SIN)[i] = __builtin_amdgcn_sinf(fr);
  }
}

__device__ __forceinline__ float mod_sum(const Frame& F, int l, int b, int idx) {
  float s = F.in[I_ADAB][l * 6144 + idx];
#pragma unroll
  for (int kc = 0; kc < 8; ++kc) s += WSP(const float, WS_MODP)[(((size_t)kc * 2 + l) * 4 + b) * 6144 + idx];
  return s;
}

template <int MODE>
__device__ __forceinline__ void phase_xnorm(const Frame& F, int l) {
  float* gs = (float*)(F.lds + 1024);
  float* sh = gs + 1024;
  float* g2 = sh + 1024;
  if (MODE == 0) {
    for (int i = F.bid * NTHR + F.tid; i < 2 * 4 * 6144; i += F.G * NTHR) {
      const int idx = i % 6144, b = (i / 6144) & 3, ll = i / (4 * 6144);
      WSP(float, WS_MOD)[i] = mod_sum(F, ll, b, idx);
    }
  }
  const float* Xin = (MODE == 0) ? F.in[I_X] : F.out;
  const bf16_t* YB = WSP(const bf16_t, A_YB);
  bf16_t* HB = WSP(bf16_t, WS_HB);
  int curb = -1;
  for (int u = F.bid; u < T_ / 64; u += F.G) {
    const int b = u >> 7;
    if (b != curb) {
      __syncthreads();
      for (int c = F.tid; c < 1024; c += NTHR) {
        if (MODE == 0) { gs[c] = F.in[I_NMIX][l * 1024 + c] * (1.f + mod_sum(F, l, b, 1024 + c)); sh[c] = mod_sum(F, l, b, c); }
        if (MODE == 1) { gs[c] = F.in[I_NMIX][l * 1024 + c] * (1.f + modp(F, l, b)[1024 + c]); sh[c] = modp(F, l, b)[c]; }
        if (MODE >= 1) g2[c] = modp(F, l - (MODE == 1 ? 1 : 0), b)[5120 + c];
      }
      __syncthreads(); curb = b;
    }
    for (int i = 0; i < 8; ++i) {
      const size_t t = (size_t)u * 64 + F.wave * 8 + i;
      f32x4 v[4];
#pragma unroll
      for (int k = 0; k < 4; ++k) v[k] = *(const f32x4*)(Xin + t * 1024 + k * 256 + F.lane * 4);
      if (MODE >= 1) {
#pragma unroll
        for (int k = 0; k < 4; ++k) {
          const int c = k * 256 + F.lane * 4;
          const u32x2 y0 = *(const u32x2*)(YB + (t * 2) * 1024 + c), y1 = *(const u32x2*)(YB + (t * 2 + 1) * 1024 + c);
          v[k][0] += g2[c + 0] * (bflo(y0[0]) + bflo(y1[0]));
          v[k][1] += g2[c + 1] * (bfhi(y0[0]) + bfhi(y1[0]));
          v[k][2] += g2[c + 2] * (bflo(y0[1]) + bflo(y1[1]));
          v[k][3] += g2[c + 3] * (bfhi(y0[1]) + bfhi(y1[1]));
          *(f32x4*)(F.out + t * 1024 + c) = v[k];
        }
      }
      if (MODE <= 1) {
        float ss = 0.f;
#pragma unroll
        for (int k = 0; k < 4; ++k) ss += v[k][0] * v[k][0] + v[k][1] * v[k][1] + v[k][2] * v[k][2] + v[k][3] * v[k][3];
        ss = wave_sum(ss);
        const float r = rsqrtf(ss * (1.f / 1024.f) + EPS_);
#pragma unroll
        for (int k = 0; k < 4; ++k) {
          const int c = k * 256 + F.lane * 4;
          const float h0 = v[k][0] * r * gs[c] + sh[c], h1 = v[k][1] * r * gs[c + 1] + sh[c + 1], h2 = v[k][2] * r * gs[c + 2] + sh[c + 2], h3 = v[k][3] * r * gs[c + 3] + sh[c + 3];
          *(unsigned*)((unsigned char*)HB + t * 1024 + c) = pk4_fp8(h0, h1, h2, h3);
        }
      }
    }
  }
}

__device__ __forceinline__ float gain_absmax(const Frame& F, const float* g, int n) {
  float* red = (float*)(F.lds + LDS_CTL + 1024);
  float m = 0.f;
  for (int i = F.tid; i < n; i += NTHR) m = fmaxf(m, fabsf(g[i]));
#pragma unroll
  for (int o = 32; o >= 1; o >>= 1) m = fmaxf(m, __shfl_xor(m, o));
  __syncthreads();
  if (F.lane == 0) red[F.wave] = m;
  __syncthreads();
  float r = red[0];
#pragma unroll
  for (int w = 1; w < 8; ++w) r = fmaxf(r, red[w]);
  return r;
}
constexpr float LOG2E = 1.4426950408889634f;
constexpr float PP_BF8 = 20.f;
constexpr float PP_BOUND = 60.f;


__device__ __forceinline__ int vt_pos(int tau) { const int kq = tau & 31, i = kq >> 3, r = kq & 7; return (tau & 32) + ((r < 4) ? (4 * i + r) : (16 + 4 * i + (r - 4))); }
__device__ __forceinline__ int vt_pos0(int tau) { return 32 * ((tau >> 2) & 1) + 16 * (tau >> 5) + 4 * ((tau & 31) >> 3) + (tau & 3); }
__device__ __forceinline__ float pp_mla_bound(const Frame& F) { return 9.797959f * gain_absmax(F, F.in[I_MLAQN], 96) * gain_absmax(F, F.in[I_MLAKN], 96) * LOG2E * 1.04f; }
__device__ __forceinline__ bool pp_mla_ok(const Frame& F) { return pp_mla_bound(F) <= PP_BF8; }
__device__ __forceinline__ float pp_diff_bound(const Frame& F) { return (8.f * gain_absmax(F, F.in[I_CQN], 128) * gain_absmax(F, F.in[I_CKN], 128) * 1.04f + gain_absmax(F, F.in[I_RELB], 256)) * LOG2E; }
constexpr float PP_F16 = 15.9f;
__device__ __forceinline__ bool pp_diff_ok(const Frame& F) { return pp_diff_bound(F) <= PP_F16; }
__device__ __forceinline__ float pp_gqa_bound(const Frame& F) { return 8.f * gain_absmax(F, F.in[I_GQAQN], 64) * gain_absmax(F, F.in[I_GQAKN], 64) * LOG2E * 1.04f; }
__device__ __forceinline__ bool pp_gqa_ok(const Frame& F) { return pp_gqa_bound(F) <= PP_BF8; }

__device__ __forceinline__ void phase_split0(const Frame& F) {
  const bf16_t* PROJ = WSP(const bf16_t, A_PROJ0);
  bf16_t* CQN = WSP(bf16_t, A_CQN); bf16_t* CKVN = WSP(bf16_t, A_CKVN);
  bf16_t* QG = WSP(bf16_t, A_QG); bf16_t* KG = WSP(bf16_t, A_KG); bf16_t* VG = WSP(bf16_t, A_VG);
  unsigned char* QG8 = WSP(unsigned char, A_QG); unsigned char* KG8 = WSP(unsigned char, A_KG); unsigned char* VGT8 = WSP(unsigned char, A_VG);
  const float* COS = WSP(const float, WS_COS); const float* SIN = WSP(const float, WS_SIN);
  const int lane = F.lane;
  const bool pp = pp_gqa_ok(F);
  unsigned char* vt = F.lds + 1024;
  for (int u = F.bid; u < T_ / 64; u += F.G) {
   for (int tb = 0; tb < 8; tb += 4) {
    u32x4 Lcq[4], Lgq[4], Lgk[4], Lgv[4]; u32x2 Lckv[4]; float Lcs[4][8], Lsn[4][8];
#pragma unroll
    for (int k = 0; k < 4; ++k) {
      const int t = u * 64 + F.wave * 8 + tb + k, s = t & 8191;
      const bf16_t* row = PROJ + (size_t)t * P0LD;
      Lcq[k] = *(const u32x4*)(row + lane * 8);
      Lckv[k] = *(const u32x2*)(row + 512 + lane * 4);
      Lgq[k] = *(const u32x4*)(row + 800 + lane * 8);
      Lgk[k] = u32x4{0u, 0u, 0u, 0u}; Lgv[k] = u32x4{0u, 0u, 0u, 0u};
      if (lane < 16) { Lgk[k] = *(const u32x4*)(row + 1312 + lane * 8); Lgv[k] = *(const u32x4*)(row + 1440 + lane * 8); }
      const int pos = ((lane & 7) < 4) ? (s >> 6) : (s & 63), jb = (lane & 1) * 8;
#pragma unroll
      for (int i = 0; i < 8; ++i) { Lcs[k][i] = COS[pos * 16 + jb + i]; Lsn[k][i] = SIN[pos * 16 + jb + i]; }
    }
#pragma unroll
    for (int k = 0; k < 4; ++k) {
    const int ti = tb + k;
    const int tau = F.wave * 8 + ti, t = u * 64 + tau;
    const int b = t >> 13, s = t & 8191;
    {
      const u32x4 w = Lcq[k];
      float x[8] = {bflo(w[0]), bfhi(w[0]), bflo(w[1]), bfhi(w[1]), bflo(w[2]), bfhi(w[2]), bflo(w[3]), bfhi(w[3])};
      float ss = 0.f;
#pragma unroll
      for (int i = 0; i < 8; ++i) ss += x[i] * x[i];
      ss = wave_sum(ss);
      const float r = rsqrtf(ss * (1.f / 512.f) + EPS_);
      const float* g = F.in[I_ABQAN] + lane * 8;
      u32x4 o;
#pragma unroll
      for (int i = 0; i < 4; ++i) o[i] = pack2(x[2 * i] * r * g[2 * i], x[2 * i + 1] * r * g[2 * i + 1]);
      *(u32x4*)(CQN + (size_t)t * 512 + lane * 8) = o;
    }
    {
      const u32x2 w = Lckv[k];
      float x[4] = {bflo(w[0]), bfhi(w[0]), bflo(w[1]), bfhi(w[1])};
      float ss = x[0] * x[0] + x[1] * x[1] + x[2] * x[2] + x[3] * x[3];
      ss = wave_sum(ss);
      const float r = rsqrtf(ss * (1.f / 256.f) + EPS_);
      const float* g = F.in[I_ABKVAN] + lane * 4;
      u32x2 o; o[0] = pack2(x[0] * r * g[0], x[1] * r * g[1]); o[1] = pack2(x[2] * r * g[2], x[3] * r * g[3]);
      *(u32x2*)(CKVN + (size_t)t * 256 + lane * 4) = o;
    }
#pragma unroll
    for (int which = 0; which < 2; ++which) {
      const bool act = (which == 0) || (lane < 16);
      const u32x4 w = (which == 0) ? Lgq[k] : Lgk[k];
      float x[8] = {bflo(w[0]), bfhi(w[0]), bflo(w[1]), bfhi(w[1]), bflo(w[2]), bfhi(w[2]), bflo(w[3]), bfhi(w[3])};
      float ss = 0.f;
#pragma unroll
      for (int i = 0; i < 8; ++i) ss += x[i] * x[i];
      ss += __shfl_xor(ss, 1); ss += __shfl_xor(ss, 2); ss += __shfl_xor(ss, 4);
      const float r = rsqrtf(ss * (1.f / 64.f) + EPS_);
      const int ch = lane & 7;
      const float* g = F.in[which == 0 ? I_GQAQN : I_GQAKN] + ch * 8;
#pragma unroll
      for (int i = 0; i < 8; ++i) x[i] = x[i] * r * g[i];
      const bool second = (ch & 2) != 0;
      float y[8];
#pragma unroll
      for (int i = 0; i < 8; ++i) {
        const float p = __shfl_xor(x[i], 2);
        const float cs = Lcs[k][i], sn = Lsn[k][i];
        y[i] = second ? (x[i] * cs + p * sn) : (x[i] * cs - p * sn);
      }
      const float qs = (which == 0) ? (0.125f * 1.4426950408889634f * (pp ? 8.f : 1.f)) : 1.f;
      const int hd = lane >> 3;
      if (pp) {
        u32x2 o; o[0] = pk4_fp8(y[0] * qs, y[1] * qs, y[2] * qs, y[3] * qs); o[1] = pk4_fp8(y[4] * qs, y[5] * qs, y[6] * qs, y[7] * qs);
        if (act) {
          if (which == 0) *(u32x2*)(QG8 + (((size_t)b * 8 + hd) * S_ + s) * 64 + ch * 8) = o;
          else            *(u32x2*)(KG8 + (((size_t)b * 2 + hd) * S_ + s) * 64 + ch * 8) = o;
        }
      } else {
        u32x4 o;
#pragma unroll
        for (int i = 0; i < 4; ++i) o[i] = pack2(y[2 * i] * qs, y[2 * i + 1] * qs);
        if (act) {
          if (which == 0) *(u32x4*)(QG + (((size_t)b * 8 + hd) * S_ + s) * 64 + ch * 8) = o;
          else            *(u32x4*)(KG + (((size_t)b * 2 + hd) * S_ + s) * 64 + ch * 8) = o;
        }
      }
    }
    if (lane < 16) {
      const u32x4 w = Lgv[k];
      if (pp) {
        const unsigned a = pk4_fp8(bflo(w[0]), bfhi(w[0]), bflo(w[1]), bfhi(w[1])), c = pk4_fp8(bflo(w[2]), bfhi(w[2]), bflo(w[3]), bfhi(w[3]));
        unsigned char* dst = vt + ((lane >> 3) * 64 + (lane & 7) * 8) * 64 + vt_pos0(tau);
        dst[0 * 64] = (unsigned char)a; dst[1 * 64] = (unsigned char)(a >> 8); dst[2 * 64] = (unsigned char)(a >> 16); dst[3 * 64] = (unsigned char)(a >> 24);
        dst[4 * 64] = (unsigned char)c; dst[5 * 64] = (unsigned char)(c >> 8); dst[6 * 64] = (unsigned char)(c >> 16); dst[7 * 64] = (unsigned char)(c >> 24);
      } else {
        *(u32x4*)(VG + (((size_t)b * 2 + (lane >> 3)) * S_ + s) * 64 + (lane & 7) * 8) = w;
      }
    }
    }
   }
   if (pp) {
     __syncthreads();
     const int t0 = u * 64, b = t0 >> 13, s0 = t0 & 8191, rid = F.tid >> 2, chk = F.tid & 3;
     *(u32x4*)(VGT8 + ((size_t)(b * 2 * 64 + rid)) * S_ + s0 + chk * 16) = *(const u32x4*)(vt + rid * 64 + chk * 16);
     __syncthreads();
   }
  }
}

__device__ __forceinline__ void phase_mla(const Frame& F) {
  const bf16_t* PROJ = WSP(const bf16_t, A_PROJ0);
  const bf16_t* QRAW = WSP(const bf16_t, A_QRAW); const bf16_t* KVRAW = WSP(const bf16_t, A_KVRAW);
  bf16_t* QA = WSP(bf16_t, A_QA); bf16_t* KA = WSP(bf16_t, A_KA); bf16_t* VA = WSP(bf16_t, A_VA);
  unsigned char* QA8 = WSP(unsigned char, A_QA); unsigned char* KA8 = WSP(unsigned char, A_KA); unsigned char* VAT8 = WSP(unsigned char, A_VA);
  const float* COS = WSP(const float, WS_COS); const float* SIN = WSP(const float, WS_SIN);
  const int lane = F.lane, hd = lane >> 3, ch = lane & 7;
  const bool pp = pp_mla_ok(F);
  unsigned char* vt = F.lds + 1024;
  for (int u = F.bid; u < T_ / 64; u += F.G) {
   for (int tb = 0; tb < 8; tb += 4) {
    u32x4 Lq[4], Lkv[4], Lv[4]; u32x2 Lqr[4], Lkr[4]; float Lcs[4][4], Lsn[4][4];
#pragma unroll
    for (int k = 0; k < 4; ++k) {
      const int t = u * 64 + F.wave * 8 + tb + k, s = t & 8191;
      Lq[k] = *(const u32x4*)(QRAW + (size_t)t * 768 + hd * 96 + ch * 8);
      Lqr[k] = *(const u32x2*)(QRAW + (size_t)t * 768 + hd * 96 + 64 + ch * 4);
      Lkv[k] = *(const u32x4*)(KVRAW + (size_t)t * 1024 + hd * 128 + ch * 8);
      Lkr[k] = *(const u32x2*)(PROJ + (size_t)t * P0LD + 768 + ch * 4);
      Lv[k] = *(const u32x4*)(KVRAW + (size_t)t * 1024 + hd * 128 + 64 + ch * 8);
#pragma unroll
      for (int i = 0; i < 4; ++i) { Lcs[k][i] = COS[s * 16 + (ch & 3) * 4 + i]; Lsn[k][i] = SIN[s * 16 + (ch & 3) * 4 + i]; }
    }
#pragma unroll
    for (int k = 0; k < 4; ++k) {
    const int ti = tb + k;
    const int tau = F.wave * 8 + ti, t = u * 64 + tau;
    const int b = t >> 13, s = t & 8191;
#pragma unroll
    for (int which = 0; which < 2; ++which) {
      float xn[8], xr[4];
      if (which == 0) {
        const u32x4 w = Lq[k];
        const u32x2 v = Lqr[k];
        xn[0] = bflo(w[0]); xn[1] = bfhi(w[0]); xn[2] = bflo(w[1]); xn[3] = bfhi(w[1]); xn[4] = bflo(w[2]); xn[5] = bfhi(w[2]); xn[6] = bflo(w[3]); xn[7] = bfhi(w[3]);
        xr[0] = bflo(v[0]); xr[1] = bfhi(v[0]); xr[2] = bflo(v[1]); xr[3] = bfhi(v[1]);
      } else {
        const u32x4 w = Lkv[k];
        const u32x2 v = Lkr[k];
        xn[0] = bflo(w[0]); xn[1] = bfhi(w[0]); xn[2] = bflo(w[1]); xn[3] = bfhi(w[1]); xn[4] = bflo(w[2]); xn[5] = bfhi(w[2]); xn[6] = bflo(w[3]); xn[7] = bfhi(w[3]);
        xr[0] = bflo(v[0]); xr[1] = bfhi(v[0]); xr[2] = bflo(v[1]); xr[3] = bfhi(v[1]);
      }
      float ss = 0.f;
#pragma unroll
      for (int i = 0; i < 8; ++i) ss += xn[i] * xn[i];
#pragma unroll
      for (int i = 0; i < 4; ++i) ss += xr[i] * xr[i];
      ss += __shfl_xor(ss, 1); ss += __shfl_xor(ss, 2); ss += __shfl_xor(ss, 4);
      const float r = rsqrtf(ss * (1.f / 96.f) + EPS_);
      const float* g = F.in[which == 0 ? I_MLAQN : I_MLAKN];
#pragma unroll
      for (int i = 0; i < 8; ++i) xn[i] = xn[i] * r * g[ch * 8 + i];
#pragma unroll
      for (int i = 0; i < 4; ++i) xr[i] = xr[i] * r * g[64 + ch * 4 + i];
      const bool second = (ch & 4) != 0;
      float y[4];
#pragma unroll
      for (int i = 0; i < 4; ++i) {
        const float p = __shfl_xor(xr[i], 4);
        const float cs = Lcs[k][i], sn = Lsn[k][i];
        y[i] = second ? (xr[i] * cs + p * sn) : (xr[i] * cs - p * sn);
      }
      const float qs = (which == 0) ? (0.10206207261596575f * 1.4426950408889634f * (pp ? 8.f : 1.f)) : 1.f;
      if (pp) {
        unsigned char* dst = (which == 0 ? QA8 : KA8) + (((size_t)b * 8 + hd) * S_ + s) * 128;
        u32x2 o; o[0] = pk4_fp8(xn[0] * qs, xn[1] * qs, xn[2] * qs, xn[3] * qs); o[1] = pk4_fp8(xn[4] * qs, xn[5] * qs, xn[6] * qs, xn[7] * qs);
        *(u32x2*)(dst + ch * 8) = o;
        *(unsigned*)(dst + 64 + ch * 4) = pk4_fp8(y[0] * qs, y[1] * qs, y[2] * qs, y[3] * qs);
        *(unsigned*)(dst + 96 + ch * 4) = 0u;
      } else {
        bf16_t* dst = (which == 0 ? QA : KA) + (((size_t)b * 8 + hd) * S_ + s) * 128;
        u32x4 o;
#pragma unroll
        for (int i = 0; i < 4; ++i) o[i] = pack2(xn[2 * i] * qs, xn[2 * i + 1] * qs);
        *(u32x4*)(dst + ch * 8) = o;
        u32x2 o2; o2[0] = pack2(y[0] * qs, y[1] * qs); o2[1] = pack2(y[2] * qs, y[3] * qs);
        *(u32x2*)(dst + 64 + ch * 4) = o2;
        u32x2 z; z[0] = 0u; z[1] = 0u;
        *(u32x2*)(dst + 96 + ch * 4) = z;
      }
    }
    {
      const u32x4 w = Lv[k];
      if (pp) {
        const unsigned a = pk4_fp8(bflo(w[0]), bfhi(w[0]), bflo(w[1]), bfhi(w[1])), c = pk4_fp8(bflo(w[2]), bfhi(w[2]), bflo(w[3]), bfhi(w[3]));
        unsigned char* dst = vt + (hd * 64 + ch * 8) * 64 + vt_pos0(tau);
        dst[0 * 64] = (unsigned char)a; dst[1 * 64] = (unsigned char)(a >> 8); dst[2 * 64] = (unsigned char)(a >> 16); dst[3 * 64] = (unsigned char)(a >> 24);
        dst[4 * 64] = (unsigned char)c; dst[5 * 64] = (unsigned char)(c >> 8); dst[6 * 64] = (unsigned char)(c >> 16); dst[7 * 64] = (unsigned char)(c >> 24);
      } else {
        *(u32x4*)(VA + (((size_t)b * 8 + hd) * S_ + s) * 64 + ch * 8) = w;
      }
    }
    }
   }
   if (pp) {
     __syncthreads();
     const int t0 = u * 64, b = t0 >> 13, s0 = t0 & 8191;
#pragma unroll
     for (int q = 0; q < 4; ++q) { const int idx = F.tid + q * NTHR, rid = idx >> 2, chk = idx & 3;
       *(u32x4*)(VAT8 + ((size_t)(b * 8 * 64 + rid)) * S_ + s0 + chk * 16) = *(const u32x4*)(vt + rid * 64 + chk * 16); }
     __syncthreads();
   }
  }
}


__device__ __forceinline__ void phase_vt1(const Frame& F) {
  const bf16_t* VD = WSP(const bf16_t, A_VD);
  unsigned char* VT = WSP(unsigned char, A_VT8D);
  unsigned char* vt = F.lds + 1024;
  for (int u = F.bid; u < 32 * 128; u += F.G) {
    const int bh = u >> 7, s0 = (u & 127) * 64;
#pragma unroll
    for (int q = 0; q < 2; ++q) {
      const int idx = F.tid + q * NTHR, tau = idx >> 4, c8 = (idx & 15) * 8;
      const u32x4 w = *(const u32x4*)(VD + ((size_t)bh * S_ + s0 + tau) * 128 + c8);
      const unsigned a = pk4_fp8(bflo(w[0]), bfhi(w[0]), bflo(w[1]), bfhi(w[1])), c = pk4_fp8(bflo(w[2]), bfhi(w[2]), bflo(w[3]), bfhi(w[3]));
      unsigned char* dst = vt + c8 * 64 + vt_pos0(tau);
      dst[0 * 64] = (unsigned char)a; dst[1 * 64] = (unsigned char)(a >> 8); dst[2 * 64] = (unsigned char)(a >> 16); dst[3 * 64] = (unsigned char)(a >> 24);
      dst[4 * 64] = (unsigned char)c; dst[5 * 64] = (unsigned char)(c >> 8); dst[6 * 64] = (unsigned char)(c >> 16); dst[7 * 64] = (unsigned char)(c >> 24);
    }
    __syncthreads();
    { const int rid = F.tid >> 2, chk = F.tid & 3;
      *(u32x4*)(VT + ((size_t)bh * 128 + rid) * S_ + s0 + chk * 16) = *(const u32x4*)(vt + rid * 64 + chk * 16); }
    __syncthreads();
  }
}

__device__ __forceinline__ void phase_route(const Frame& F, int l) {
  typedef short bf16x8_t __attribute__((ext_vector_type(8)));
  constexpr int KC = 128, LDX = KC + 8;
  float* gs = (float*)(F.lds + 1024);
  float* sh = gs + 1024;
  float* rs = sh + 1024;
  bf16_t* XH = (bf16_t*)(rs + 64);
  bf16_t* XL = XH + 64 * LDX;
  bf16_t* WH = XL + 64 * LDX;
  bf16_t* WL = WH + 48 * LDX;
  float* lg = (float*)(WL + 48 * LDX);
  int* cnt = (int*)(lg + 64 * 49);
  int* base = cnt + 32;
  unsigned char* HB8 = WSP(unsigned char, WS_HB);
  const float* X = F.out;
  unsigned* COUNT = (unsigned*)(F.ws + WS_CTL + CW_CNT) + l * 32;
  int* LIST = WSP(int, WS_LIST); float* GATEW = WSP(float, WS_GATEW);
  const int lane = F.lane, mb = F.wave & 3, nb0 = (F.wave >> 2) ? 2 : 0, nnb = (F.wave >> 2) ? 1 : 2;
  int curb = -1;
  const bf16_t* WRg = WSP(const bf16_t, WS_WR) + (size_t)l * 2 * 48 * 1024;
  for (int u = F.bid; u < T_ / 64; u += F.G) {
    const int b = u >> 7;
    __syncthreads();
    if (b != curb) {
      for (int c = F.tid; c < 1024; c += NTHR) { gs[c] = F.in[I_NFFN][l * 1024 + c] * (1.f + modp(F, l, b)[4096 + c]); sh[c] = modp(F, l, b)[3072 + c]; }
      curb = b;
    }
    if (F.tid < 32) cnt[F.tid] = 0;
    if (F.tid < 64) {
      const float* sp = WSP(const float, WS_ROWSS) + ((size_t)u * 64 + F.tid) * 16;
      float ss = 0.f;
#pragma unroll
      for (int q = 0; q < 4; ++q) { const f32x4 v = *(const f32x4*)(sp + 4 * q); ss += v[0]; ss += v[1]; ss += v[2]; ss += v[3]; }
      rs[F.tid] = rsqrtf(ss * (1.f / 1024.f) + EPS_);
    }
    f32x4 acc[2] = {{0.f, 0.f, 0.f, 0.f}, {0.f, 0.f, 0.f, 0.f}};
    u32x4 wpre[3]; f32x4 xpre[4];
#define RT_FETCH(kc_) do { \
      _Pragma("unroll") for (int q = 0; q < 3; ++q) { const int idx = F.tid + NTHR * q, img = idx / 768, rem = idx % 768, row = rem >> 4, seg = rem & 15; \
        wpre[q] = *(const u32x4*)(WRg + ((size_t)img * 48 + row) * 1024 + (kc_) * KC + seg * 8); } \
      _Pragma("unroll") for (int i = 0; i < 4; ++i) { const int tl = F.wave * 8 + 2 * i + (lane >> 5); \
        xpre[i] = *(const f32x4*)(X + ((size_t)u * 64 + tl) * 1024 + (kc_) * KC + (lane & 31) * 4); } } while (0)
    RT_FETCH(0);
    for (int kc = 0; kc < 1024 / KC; ++kc) {
      __syncthreads();
#pragma unroll
      for (int q = 0; q < 3; ++q) { const int idx = F.tid + NTHR * q, img = idx / 768, rem = idx % 768, row = rem >> 4, seg = rem & 15;
        *(u32x4*)((img ? WL : WH) + row * LDX + seg * 8) = wpre[q]; }
#pragma unroll
      for (int i = 0; i < 4; ++i) {
        const int tl = F.wave * 8 + 2 * i + (lane >> 5); const size_t t = (size_t)u * 64 + tl;
        const int cl = (lane & 31) * 4, c = kc * KC + cl;
        const f32x4 v = xpre[i];
        const float r = rs[tl];
        const float h0 = v[0] * r * gs[c] + sh[c], h1 = v[1] * r * gs[c + 1] + sh[c + 1], h2 = v[2] * r * gs[c + 2] + sh[c + 2], h3 = v[3] * r * gs[c + 3] + sh[c + 3];
        u32x2 w; w[0] = pack2(h0, h1); w[1] = pack2(h2, h3);
        *(unsigned*)(HB8 + t * 1024 + c) = pk4_fp8(h0, h1, h2, h3);
        *(u32x2*)(XH + tl * LDX + cl) = w;
        u32x2 wl; wl[0] = pack2(h0 - bflo(w[0]), h1 - bfhi(w[0])); wl[1] = pack2(h2 - bflo(w[1]), h3 - bfhi(w[1]));
        *(u32x2*)(XL + tl * LDX + cl) = wl;
      }
      if (kc + 1 < 1024 / KC) RT_FETCH(kc + 1);
      __syncthreads();
#pragma unroll
      for (int ks = 0; ks < KC / 32; ++ks) {
        const int xo = (mb * 16 + (lane & 15)) * LDX + ks * 32 + 8 * (lane >> 4);
        const bf16x8_t ah = *(const bf16x8_t*)(XH + xo), al = *(const bf16x8_t*)(XL + xo);
#pragma unroll
        for (int q = 0; q < 2; ++q) if (q < nnb) {
          const int wo = ((nb0 + q) * 16 + (lane & 15)) * LDX + ks * 32 + 8 * (lane >> 4);
          const bf16x8_t bh = *(const bf16x8_t*)(WH + wo), bl = *(const bf16x8_t*)(WL + wo);
          acc[q] = __builtin_amdgcn_mfma_f32_16x16x32_bf16(ah, bh, acc[q], 0, 0, 0);
          acc[q] = __builtin_amdgcn_mfma_f32_16x16x32_bf16(ah, bl, acc[q], 0, 0, 0);
          acc[q] = __builtin_amdgcn_mfma_f32_16x16x32_bf16(al, bh, acc[q], 0, 0, 0);
        }
      }
    }
#undef RT_FETCH
#pragma unroll
    for (int q = 0; q < 2; ++q) if (q < nnb) {
#pragma unroll
      for (int r = 0; r < 4; ++r) lg[(mb * 16 + 4 * (lane >> 4) + r) * 49 + (nb0 + q) * 16 + (lane & 15)] = acc[q][r];
    }
    __syncthreads();
    int e0 = 0, e1 = 0, i0 = 0, i1 = 0; float w0 = 0.f, w1 = 0.f;
    if (F.tid < 64) {
      const float* L = lg + F.tid * 49;
      const float* bg = F.in[I_BG] + l * 4; const float* be = F.in[I_BE] + l * 32;
      float gl[4]; int g = 0; float gm;
#pragma unroll
      for (int j = 0; j < 4; ++j) gl[j] = L[j] + bg[j];
      gm = gl[0];
#pragma unroll
      for (int j = 1; j < 4; ++j) if (gl[j] > gm) { gm = gl[j]; g = j; }
      float gsum = 0.f;
#pragma unroll
      for (int j = 0; j < 4; ++j) gsum += __expf(gl[j] - gm);
      const float pg = 1.f / gsum;
      float el[8];
#pragma unroll
      for (int j = 0; j < 8; ++j) el[j] = L[4 + g * 8 + j] + be[g * 8 + j];
      int a0 = 0; float m0 = el[0];
#pragma unroll
      for (int j = 1; j < 8; ++j) if (el[j] > m0) { m0 = el[j]; a0 = j; }
      int a1 = -1; float m1 = -3.0e38f;
#pragma unroll
      for (int j = 0; j < 8; ++j) if (j != a0 && el[j] > m1) { m1 = el[j]; a1 = j; }
      const float ex = __expf(m1 - m0);
      w0 = pg / (1.f + ex); w1 = pg * ex / (1.f + ex);
      e0 = g * 8 + a0; e1 = g * 8 + a1;
      i0 = atomicAdd(&cnt[e0], 1); i1 = atomicAdd(&cnt[e1], 1);
    }
    __syncthreads();
    if (F.tid < 32) base[F.tid] = (int)__hip_atomic_fetch_add(COUNT + F.tid, (unsigned)cnt[F.tid], __ATOMIC_RELAXED, __HIP_MEMORY_SCOPE_AGENT);
    __syncthreads();
    if (F.tid < 64) {
      const int t = u * 64 + F.tid;
      LIST[(size_t)e0 * 65536 + base[e0] + i0] = t * 2;
      LIST[(size_t)e1 * 65536 + base[e1] + i1] = t * 2 + 1;
      GATEW[t * 2] = w0; GATEW[t * 2 + 1] = w1;
    }
  }
}


namespace pg {
typedef short bf16x8 __attribute__((ext_vector_type(8)));
typedef int i32x4_t __attribute__((ext_vector_type(4)));
typedef int i32x8_t __attribute__((ext_vector_type(8)));
constexpr int BM = 256, BK = 64, HALF = 128, HTB = HALF * BK * 2, STAGE_BYTES = 8 * HTB, NXCD = 8, WGM = 8;
__device__ __forceinline__ int lds_byte(int r, int c) { const int st = (r >> 4) * 2 + (c >> 5), rr = r & 15, cc = c & 31, ob = rr * 64 + cc * 2; return st * 1024 + (ob ^ (((ob >> 9) & 1) << 5)); }
__device__ __forceinline__ void stage_rc(int b, int& R, int& C) { const int st = b / 1024, sb = b % 1024, swz = sb ^ (((sb >> 9) & 1) << 5); R = (st >> 1) * 16 + swz / 64; C = (st & 1) * 32 + (swz % 64) / 2; }
__device__ __forceinline__ int perm32(int rho) { const int n = rho >> 4, i = rho & 15; return 8 * (i >> 2) + 4 * n + (i & 3); }
__device__ __forceinline__ unsigned cvt_pk_bf16(float lo, float hi) { unsigned r; asm volatile("v_cvt_pk_bf16_f32 %0, %1, %2" : "=v"(r) : "v"(lo), "v"(hi)); return r; }

struct GUnit { const char* A; const char* B; const int* lst; int row0, col0, nrow, e; };

struct DenseOrder {
  const char* A; const char* Bt; int K, nM, nN, nwg, G, c;
  __device__ void init(const bf16_t* A_, const bf16_t* Bt_, int M, int N, int K_, int G_, int c_) { A = (const char*)A_; Bt = (const char*)Bt_; K = K_; nM = M / BM; nN = N / BM; nwg = nM * nN; G = G_; c = c_; }
  __device__ __forceinline__ bool next(int i, GUnit& u) const {
    const long L = (long)i * G + c; if (L >= nwg) return false;
    int wgid = (int)L; { const int q = nwg / NXCD, r = nwg % NXCD, xcd = wgid % NXCD, off = wgid / NXCD; wgid = (xcd < r ? xcd * (q + 1) : r * (q + 1) + (xcd - r) * q) + off; }
    const int nig = WGM * nN, gid = wgid / nig, fm = gid * WGM, gsz = (nM - fm) < WGM ? (nM - fm) : WGM;
    const int pm = fm + ((wgid % nig) % gsz), pn = (wgid % nig) / gsz;
    u.A = A + (size_t)pm * BM * K * 2; u.B = Bt + (size_t)pn * BM * K * 2; u.lst = nullptr; u.row0 = pm * BM; u.col0 = pn * BM; u.nrow = BM; u.e = 0;
    return true;
  }
};
struct MoeOrder {
  const int* tstart; const int* sbase; const int* cntl; const char* Abase; const char* Wbase; const int* LIST; int K, G, c, up;
  __device__ __forceinline__ bool next(int i, GUnit& u) const {
    const int L = i * G + c; if (L >= tstart[32] * 4) return false;
    const int rtg = L >> 2, pn = L & 3;
    int e = 0; while (tstart[e + 1] <= rtg) ++e;
    const int rt = rtg - tstart[e];
    u.e = e; u.nrow = cntl[e] - rt * BM; if (u.nrow > BM) u.nrow = BM;
    u.lst = LIST + (size_t)e * 65536 + rt * BM; u.row0 = sbase[e] + rt * BM; u.col0 = pn * BM;
    u.A = up ? Abase : Abase + (size_t)u.row0 * K * 2;
    u.B = Wbase + ((size_t)e * 1024 + pn * BM) * K * 2;
    return true;
  }
};

struct EpiStoreBf16 {
  static constexpr bool PERM = true;
  bf16_t* O; int ldc;
  __device__ __forceinline__ void operator()(const f32x4 (&acc)[2][2][4][2], const GUnit& u, int wr, int wc, int fr, int fq) const {
#pragma unroll
    for (int ai = 0; ai < 2; ++ai)
#pragma unroll
      for (int m = 0; m < 4; ++m) { bf16_t* rowp = O + (size_t)(u.row0 + ai * HALF + wr * 64 + m * 16 + fr) * ldc + u.col0 + wc * 32 + 8 * fq;
#pragma unroll
        for (int bj = 0; bj < 2; ++bj) { const f32x4 v0 = acc[ai][bj][m][0], v1 = acc[ai][bj][m][1];
          u32x4 w; w[0] = cvt_pk_bf16(v0[0], v0[1]); w[1] = cvt_pk_bf16(v0[2], v0[3]); w[2] = cvt_pk_bf16(v1[0], v1[1]); w[3] = cvt_pk_bf16(v1[2], v1[3]);
          *(u32x4*)(rowp + bj * HALF) = w; } }
  }
};
struct EpiResid {
  static constexpr bool PERM = false;
  const float* R; float* O; const float* gate; float* SS;
  __device__ __forceinline__ void operator()(const f32x4 (&acc)[2][2][4][2], const GUnit& u, int wr, int wc, int fr, int fq) const {
    const int b = u.row0 >> 13; const float* gp = gate + (size_t)b * 6144 + u.col0 + wc * 32 + 4 * fq;
    f32x4 gv[2][2];
#pragma unroll
    for (int bj = 0; bj < 2; ++bj)
#pragma unroll
      for (int n = 0; n < 2; ++n) gv[bj][n] = *(const f32x4*)(gp + bj * HALF + n * 16);
#pragma unroll
    for (int ai = 0; ai < 2; ++ai)
#pragma unroll
      for (int m = 0; m < 4; ++m) { const int row = u.row0 + ai * HALF + wr * 64 + m * 16 + fr; const size_t off = (size_t)row * 1024 + u.col0 + wc * 32 + 4 * fq;
        float ss = 0.f;
#pragma unroll
        for (int bj = 0; bj < 2; ++bj)
#pragma unroll
          for (int n = 0; n < 2; ++n) { const f32x4 r = *(const f32x4*)(R + off + bj * HALF + n * 16); const f32x4 x = r + gv[bj][n] * acc[ai][bj][m][n]; *(f32x4*)(O + off + bj * HALF + n * 16) = x;
            ss += x[0] * x[0] + x[1] * x[1] + x[2] * x[2] + x[3] * x[3]; }
        ss += __shfl_xor(ss, 16); ss += __shfl_xor(ss, 32);
        if (fq == 0) SS[(size_t)row * 16 + (u.col0 >> 8) * 4 + wc] = ss; }
  }
};
struct EpiSplit1 {
  static constexpr bool PERM = true;
  bf16_t* QD; bf16_t* KD; bf16_t* VD; const float* qn; const float* kn; unsigned char* Q8; unsigned char* K8; int wbf;
  __device__ __forceinline__ void operator()(const f32x4 (&acc)[2][2][4][2], const GUnit& u, int wr, int wc, int fr, int fq) const {
    const int pn = u.col0 >> 8;
    if (pn < 8) {
      const int which = pn >> 2, head16 = (pn & 3) * 4 + wc, comp = head16 & 1;
      const float* gp = (which ? kn : qn) + comp * 64 + 8 * fq;
      const float qs = which ? 1.f : (0.125f * 1.4426950408889634f);
      f32x4 g[2][2];
#pragma unroll
      for (int bj = 0; bj < 2; ++bj)
#pragma unroll
        for (int n = 0; n < 2; ++n) g[bj][n] = *(const f32x4*)(gp + 32 * bj + 4 * n) * qs;
      bf16_t* base = (which ? KD : QD);
#pragma unroll
      for (int ai = 0; ai < 2; ++ai)
#pragma unroll
        for (int m = 0; m < 4; ++m) {
          const int t = u.row0 + ai * HALF + wr * 64 + m * 16 + fr, b = t >> 13, s = t & 8191;
          float ss = 0.f;
#pragma unroll
          for (int bj = 0; bj < 2; ++bj)
#pragma unroll
            for (int n = 0; n < 2; ++n) { const f32x4 v = acc[ai][bj][m][n]; ss += v[0] * v[0] + v[1] * v[1] + v[2] * v[2] + v[3] * v[3]; }
          ss += __shfl_xor(ss, 16); ss += __shfl_xor(ss, 32);
          const float r = rsqrtf(ss * (1.f / 64.f) + EPS_);
          bf16_t* dst = base + (((size_t)b * 16 + head16) * S_ + s) * 64 + 8 * fq;
          unsigned char* dst8 = (which ? K8 : Q8) + (((size_t)b * 16 + head16) * S_ + s) * 64 + 8 * fq;
          const float f8 = which ? 1.f : 8.f;
#pragma unroll
          for (int bj = 0; bj < 2; ++bj) { const f32x4 v0 = acc[ai][bj][m][0] * r * g[bj][0], v1 = acc[ai][bj][m][1] * r * g[bj][1];
            u32x4 w; w[0] = cvt_pk_bf16(v0[0], v0[1]); w[1] = cvt_pk_bf16(v0[2], v0[3]); w[2] = cvt_pk_bf16(v1[0], v1[1]); w[3] = cvt_pk_bf16(v1[2], v1[3]);
            if (wbf) *(u32x4*)(dst + 32 * bj) = w;
            { u32x2 w8; w8[0] = pk4_fp8(v0[0] * f8, v0[1] * f8, v0[2] * f8, v0[3] * f8); w8[1] = pk4_fp8(v1[0] * f8, v1[1] * f8, v1[2] * f8, v1[3] * f8); *(u32x2*)(dst8 + 32 * bj) = w8; } }
        }
    } else {
      const int h = (pn - 8) * 2 + (wc >> 1), e0 = (wc & 1) * 64 + 8 * fq;
#pragma unroll
      for (int ai = 0; ai < 2; ++ai)
#pragma unroll
        for (int m = 0; m < 4; ++m) {
          const int t = u.row0 + ai * HALF + wr * 64 + m * 16 + fr, b = t >> 13, s = t & 8191;
          bf16_t* dst = VD + (((size_t)b * 8 + h) * S_ + s) * 128 + e0;
#pragma unroll
          for (int bj = 0; bj < 2; ++bj) { const f32x4 v0 = acc[ai][bj][m][0], v1 = acc[ai][bj][m][1];
            u32x4 w; w[0] = cvt_pk_bf16(v0[0], v0[1]); w[1] = cvt_pk_bf16(v0[2], v0[3]); w[2] = cvt_pk_bf16(v1[0], v1[1]); w[3] = cvt_pk_bf16(v1[2], v1[3]);
            *(u32x4*)(dst + 32 * bj) = w; }
        }
    }
  }
};
struct EpiSwiglu {
  static constexpr bool PERM = true;
  unsigned char* ACT;
  __device__ __forceinline__ void operator()(const f32x4 (&acc)[2][2][4][2], const GUnit& u, int wr, int wc, int fr, int fq) const {
#pragma unroll
    for (int ai = 0; ai < 2; ++ai)
#pragma unroll
      for (int m = 0; m < 4; ++m) { const int r = ai * HALF + wr * 64 + m * 16 + fr;
        if (r < u.nrow) { unsigned char* rowp = ACT + (size_t)(u.row0 + r) * 512 + ((u.col0 + wc * 32 + 8 * fq) >> 1);
#pragma unroll
          for (int bj = 0; bj < 2; ++bj) { const f32x4 v0 = acc[ai][bj][m][0], v1 = acc[ai][bj][m][1];
            *(unsigned*)(rowp + bj * (HALF / 2)) = pk4_fp8(MOE_ACT_SC * siluf(v0[0]) * v0[1], MOE_ACT_SC * siluf(v0[2]) * v0[3], MOE_ACT_SC * siluf(v1[0]) * v1[1], MOE_ACT_SC * siluf(v1[2]) * v1[3]); } } }
  }
};
struct EpiDown {
  static constexpr bool PERM = true;
  bf16_t* YB; const float* GATEW;
  __device__ __forceinline__ void operator()(const f32x4 (&acc)[2][2][4][2], const GUnit& u, int wr, int wc, int fr, int fq) const {
#pragma unroll
    for (int ai = 0; ai < 2; ++ai)
#pragma unroll
      for (int m = 0; m < 4; ++m) { const int r = ai * HALF + wr * 64 + m * 16 + fr;
        if (r < u.nrow) { const int ent = u.lst[r]; const float gw = GATEW[ent];
          bf16_t* rowp = YB + (size_t)ent * 1024 + u.col0 + wc * 32 + 8 * fq;
#pragma unroll
          for (int bj = 0; bj < 2; ++bj) { const f32x4 v0 = acc[ai][bj][m][0] * gw, v1 = acc[ai][bj][m][1] * gw;
            u32x4 w; w[0] = cvt_pk_bf16(v0[0], v0[1]); w[1] = cvt_pk_bf16(v0[2], v0[3]); w[2] = cvt_pk_bf16(v1[0], v1[1]); w[3] = cvt_pk_bf16(v1[2], v1[3]);
            *(u32x4*)(rowp + bj * HALF) = w; } } }
  }
};

template <class Epi, class Sched, bool GATHER, bool FP8 = false, int BLAY = 0>
__device__ __forceinline__ void gemm_phase(LAS unsigned char* lds, const int K, const Sched& S, const Epi& E, const int sa = 127, const int sb = 127) {
  const int tid = threadIdx.x, wid = __builtin_amdgcn_readfirstlane(tid >> 6), lane = tid & 63, wr = wid >> 2, wc = wid & 3, fr = lane & 15, fq = lane >> 4;
  const int nt = K / BK;
  unsigned voffA[2], voffB[2]; int gR[2], gC[2];
#pragma unroll
  for (int i = 0; i < 2; ++i) { int R, C; stage_rc(tid * 16 + i * 8192, R, C); const int Rb = Epi::PERM ? ((R & ~31) + perm32(R & 31)) : R;
    const int Rg = BLAY ? (64 * (R >> 5) + (Epi::PERM ? perm32(R & 31) : (R & 31))) : Rb;
    voffA[i] = (unsigned)(R * K + C) * 2u; voffB[i] = (unsigned)(Rg * K + C) * 2u; gR[i] = R; gC[i] = C; }
  const size_t kstep = (size_t)(BK * 2);
  const size_t hstep = (size_t)HALF * K * 2;
  const size_t bstep = BLAY ? (size_t)32 * K * 2 : hstep;
  const unsigned ldsw = (unsigned)wid * 1024u;
  const int aoff = lds_byte(wr * 64 + fr, fq * 8), boff = lds_byte(wc * 32 + fr, fq * 8);
  unsigned gcur[2][2], gnxt[2][2];
#define PG_GOFF(dst, u) do { _Pragma("unroll") for (int _h = 0; _h < 2; ++_h) _Pragma("unroll") for (int _i = 0; _i < 2; ++_i) { int _r = _h * HALF + gR[_i]; _r = _r < (u).nrow ? _r : (u).nrow - 1; \
      dst[_h][_i] = (unsigned)(((u).lst[_r] >> 1) * K + gC[_i]) * 2u; } } while (0)
#define PG_SA(b, h) (((b) * 2 + (h)) * HTB)
#define PG_SB(b, h) ((4 + (b) * 2 + (h)) * HTB)
#define PG_STAGE(bufoff, gbase, voff) do { _Pragma("unroll") for (int _i = 0; _i < 2; ++_i) \
      __builtin_amdgcn_global_load_lds((const unsigned*)((const char*)(gbase) + (voff)[_i]), (LAS unsigned*)(lds + (bufoff) + ldsw + _i * 8192), 16, 0, 0); } while (0)
#define PG_STAGE_A(bufoff, base, h, nx) do { if constexpr (GATHER) { unsigned _vo[2]; _vo[0] = (nx) ? gnxt[h][0] : gcur[h][0]; _vo[1] = (nx) ? gnxt[h][1] : gcur[h][1]; PG_STAGE(bufoff, base, _vo); } \
      else { PG_STAGE(bufoff, (base) + (h) * hstep, voffA); } } while (0)
#define PG_LD8(p) ({ const i32x4_t lo_ = *(const LAS i32x4_t*)(p), hi_ = *(const LAS i32x4_t*)((p) + 1024); __builtin_shufflevector(lo_, hi_, 0, 1, 2, 3, 4, 5, 6, 7); })
#define PG_LDA(dst, b, h) do { _Pragma("unroll") for (int m = 0; m < 4; ++m) { if constexpr (FP8) dst##8[m] = PG_LD8(lds + PG_SA(b, h) + aoff + m * 2048); else { _Pragma("unroll") for (int k = 0; k < 2; ++k) dst[m][k] = *(const LAS bf16x8*)(lds + PG_SA(b, h) + aoff + m * 2048 + k * 1024); } } } while (0)
#define PG_LDB(dst, b, h) do { _Pragma("unroll") for (int n = 0; n < 2; ++n) { if constexpr (FP8) dst##8[n] = PG_LD8(lds + PG_SB(b, h) + boff + n * 2048); else { _Pragma("unroll") for (int k = 0; k < 2; ++k) dst[n][k] = *(const LAS bf16x8*)(lds + PG_SB(b, h) + boff + n * 2048 + k * 1024); } } } while (0)
#define PG_MMA(ai, bj, At, Bt) do { __builtin_amdgcn_s_setprio(1); _Pragma("unroll") for (int m = 0; m < 4; ++m) _Pragma("unroll") for (int n = 0; n < 2; ++n) { \
      if constexpr (FP8) asm volatile("s_nop 1\n\tv_mfma_scale_f32_16x16x128_f8f6f4 %0, %1, %2, %0, %3, %4 op_sel_hi:[0,0,0]" : "+v"(acc[ai][bj][m][n]) : "v"(Bt##8[n]), "v"(At##8[m]), "v"(sa), "v"(sb));   \
      else { _Pragma("unroll") for (int k = 0; k < 2; ++k) acc[ai][bj][m][n] = __builtin_amdgcn_mfma_f32_16x16x32_bf16(Bt[n][k], At[m][k], acc[ai][bj][m][n], 0, 0, 0); } } __builtin_amdgcn_s_setprio(0); } while (0)
#define PG_WAIT_V(n) asm volatile("s_waitcnt vmcnt(" #n ")" ::: "memory")
#define PG_WAIT_L(n) asm volatile("s_waitcnt lgkmcnt(" #n ")" ::: "memory")
#define PG_BAR __builtin_amdgcn_s_barrier()
#define PG_SCHED __builtin_amdgcn_sched_barrier(0)
  GUnit cur, nxt; int ui = 0;
  if (!S.next(0, cur)) return;
  if constexpr (GATHER) { PG_GOFF(gcur, cur); PG_GOFF(gnxt, cur); }
  f32x4 acc[2][2][4][2];
#pragma unroll
  for (int a = 0; a < 2; ++a)
#pragma unroll
    for (int b = 0; b < 2; ++b)
#pragma unroll
      for (int m = 0; m < 4; ++m)
#pragma unroll
        for (int n = 0; n < 2; ++n) acc[a][b][m][n] = (f32x4){0.f, 0.f, 0.f, 0.f};
  bf16x8 At[4][2], B0[2][2], B1[2][2]; i32x8_t At8[4], B08[2], B18[2];
  const char* cA = cur.A; const char* cB = cur.B;
  PG_STAGE(PG_SB(0, 0), cB, voffB); PG_STAGE(PG_SB(0, 1), cB + bstep, voffB); PG_STAGE_A(PG_SA(0, 0), cA, 0, false); PG_STAGE_A(PG_SA(0, 1), cA, 1, false);
  if (wr == 1) PG_BAR;
  PG_WAIT_V(2); PG_BAR;
  PG_STAGE(PG_SB(1, 0), cB + kstep, voffB); PG_STAGE_A(PG_SA(1, 0), cA + kstep, 0, false); PG_STAGE(PG_SB(1, 1), cB + bstep + kstep, voffB);
  PG_WAIT_V(6); PG_BAR;
  for (;;) {
    const bool has_next = S.next(ui + 1, nxt);
    if constexpr (GATHER) { if (has_next) PG_GOFF(gnxt, nxt); }
    const char* nA = has_next ? nxt.A : cA; const char* nB = has_next ? nxt.B : cB;
    const bool nxg = has_next;
    for (int t = 0; t < nt; t += 2) {
      const bool last = (t == nt - 2);
      const char* a1 = cA + (size_t)(t + 1) * kstep;
      const char* a2 = last ? nA : cA + (size_t)(t + 2) * kstep; const char* b2 = last ? nB : cB + (size_t)(t + 2) * kstep;
      const char* a3 = a2 + kstep; const char* b3 = b2 + kstep;
      const bool nx = last && nxg;
      PG_LDB(B0, 0, 0); PG_LDB(B1, 0, 1); PG_SCHED; PG_LDA(At, 0, 0); PG_STAGE_A(PG_SA(1, 1), a1, 1, false);
      PG_WAIT_V(8); PG_WAIT_L(0); PG_BAR; PG_MMA(0, 0, At, B0); PG_MMA(0, 1, At, B1); PG_BAR; PG_SCHED;
      PG_LDA(At, 0, 1); PG_STAGE(PG_SB(0, 0), b2, voffB); PG_STAGE(PG_SB(0, 1), b2 + bstep, voffB); PG_STAGE_A(PG_SA(0, 0), a2, 0, nx);
      PG_WAIT_V(8); PG_WAIT_L(0); PG_BAR; PG_MMA(1, 0, At, B0); PG_MMA(1, 1, At, B1); PG_BAR; PG_SCHED;
      PG_LDB(B0, 1, 0); PG_LDB(B1, 1, 1); PG_SCHED; PG_LDA(At, 1, 0); PG_STAGE_A(PG_SA(0, 1), a2, 1, nx);
      PG_WAIT_V(8); PG_WAIT_L(0); PG_BAR; PG_MMA(0, 0, At, B0); PG_MMA(0, 1, At, B1); PG_BAR; PG_SCHED;
      PG_LDA(At, 1, 1); PG_STAGE(PG_SB(1, 0), b3, voffB); PG_STAGE(PG_SB(1, 1), b3 + bstep, voffB); PG_STAGE_A(PG_SA(1, 0), a3, 0, nx);
      PG_WAIT_V(8); PG_WAIT_L(0); PG_BAR; PG_MMA(1, 0, At, B0); PG_MMA(1, 1, At, B1); PG_BAR; PG_SCHED;
    }
    if (wr == 0) PG_BAR;
    if constexpr (FP8) asm volatile("s_nop 15\n\ts_nop 15\n\ts_nop 15\n\ts_nop 15" ::: "memory");
    E(acc, cur, wr, wc, fr, fq);
    if (!has_next) break;
#pragma unroll
    for (int a = 0; a < 2; ++a)
#pragma unroll
      for (int b = 0; b < 2; ++b)
#pragma unroll
        for (int m = 0; m < 4; ++m)
#pragma unroll
          for (int n = 0; n < 2; ++n) acc[a][b][m][n] = (f32x4){0.f, 0.f, 0.f, 0.f};
    cur = nxt; cA = nA; cB = nB; ++ui;
    if constexpr (GATHER) {
#pragma unroll
      for (int h = 0; h < 2; ++h) { gcur[h][0] = gnxt[h][0]; gcur[h][1] = gnxt[h][1]; }
    }
    if (wr == 1) PG_BAR;
  }
  PG_WAIT_V(0);
  PG_BAR;
#undef PG_GOFF
#undef PG_SA
#undef PG_SB
#undef PG_STAGE
#undef PG_STAGE_A
#undef PG_LDA
#undef PG_LDB
#undef PG_MMA
#undef PG_LD8
#undef PG_WAIT_V
#undef PG_WAIT_L
#undef PG_BAR
#undef PG_SCHED
}
}

__device__ __forceinline__ void moe_tables(const Frame& F, int l, int tile) {
  int* tstart = (int*)(F.lds + LDS_CTL + 64); int* sbase = tstart + 40; int* cntl = sbase + 40;
  const unsigned* COUNT = (const unsigned*)(F.ws + WS_CTL + CW_CNT) + l * 32;
  __syncthreads();
  if (F.tid == 0) { int ts = 0, sb = 0; for (int e = 0; e < 32; ++e) { const int c = (int)COUNT[e]; cntl[e] = c; tstart[e] = ts; sbase[e] = sb; ts += (c + tile - 1) / tile; sb += c; } tstart[32] = ts; sbase[32] = sb; }
  __syncthreads();
}


__device__ __forceinline__ void moe_up_fast(const Frame& F, int l) {
  moe_tables(F, l, 256);
  const int* tstart = (const int*)(F.lds + LDS_CTL + 64); const int* sbase = tstart + 40; const int* cntl = sbase + 40;
  pg::MoeOrder S{tstart, sbase, cntl, (const char*)WSP(const unsigned char, WS_HB), (const char*)(WSP(const unsigned char, WS_WUP) + (size_t)l * 32 * 1024 * 1024), WSP(const int, WS_LIST), 512, F.G, F.bid, 1};
  pg::EpiSwiglu E{WSP(unsigned char, A_ACT)};
  pg::gemm_phase<pg::EpiSwiglu, pg::MoeOrder, true, true>((LAS unsigned char*)F.lds, 512, S, E, 121  , 127);
}
__device__ __forceinline__ void moe_down_fast(const Frame& F, int l) {
  moe_tables(F, l, 256);
  const int* tstart = (const int*)(F.lds + LDS_CTL + 64); const int* sbase = tstart + 40; const int* cntl = sbase + 40;
  pg::MoeOrder S{tstart, sbase, cntl, (const char*)WSP(const unsigned char, A_ACT), (const char*)(WSP(const unsigned char, WS_WDN) + (size_t)l * 32 * 1024 * 512), WSP(const int, WS_LIST), 256, F.G, F.bid, 0};
  pg::EpiDown E{WSP(bf16_t, A_YB), WSP(const float, WS_GATEW)};
  pg::gemm_phase<pg::EpiDown, pg::MoeOrder, false, true>((LAS unsigned char*)F.lds, 256, S, E, 122  , 125  );
}

__device__ __forceinline__ int t5_bucket(int rel) {
  const int n = rel < 0 ? -rel : rel;
  int bkt;
  if (n < 8) bkt = n; else if (n < 12) bkt = 8; else if (n < 16) bkt = 9; else if (n < 23) bkt = 10; else if (n < 32) bkt = 11;
  else if (n < 46) bkt = 12; else if (n < 64) bkt = 13; else if (n < 91) bkt = 14; else bkt = 15;
  return bkt + (rel > 0 ? 16 : 0);
}


namespace fa {
using bf16x8 = __attribute__((ext_vector_type(8))) short;
using s16x4  = __attribute__((ext_vector_type(4))) short;
using f32x16 = __attribute__((ext_vector_type(16))) float;
constexpr int NW = 8, QBLK = 32, KVBLK = 64;
constexpr float THR2 = 8.f * 1.4426950408889634f;
#define FA_SBAR() __builtin_amdgcn_sched_barrier(0)
__device__ __forceinline__ int crow(int r, int hi) { return (r & 3) + 8 * (r >> 2) + 4 * hi; }
__device__ __forceinline__ unsigned cvtpk(float lo, float hi) { unsigned r; asm volatile("v_cvt_pk_bf16_f32 %0, %1, %2" : "=v"(r) : "v"(lo), "v"(hi)); return r; }

__device__ __forceinline__ void partialSM(f32x16& p0, f32x16& p1, float& m_reg, float& alpha, float Cmul, float tb) {
  float pmax = p0[0];
#pragma unroll
  for (int r = 1; r < 16; ++r) pmax = fmaxf(pmax, p0[r]);
#pragma unroll
  for (int r = 0; r < 16; ++r) pmax = fmaxf(pmax, p1[r]);
  { auto rr = __builtin_amdgcn_permlane32_swap(__float_as_uint(pmax), __float_as_uint(pmax), false, false);
    pmax = fmaxf(__uint_as_float(rr[0]), __uint_as_float(rr[1])); }
  const float tmax = fmaf(pmax, Cmul, tb);
  float mn;
  if (__builtin_expect(__all(tmax - m_reg <= THR2), 1)) { mn = m_reg; alpha = 1.f; }
  else { mn = fmaxf(m_reg, tmax); alpha = __builtin_amdgcn_exp2f(m_reg - mn); m_reg = mn; }
  const float off = tb - mn;
#pragma unroll
  for (int r = 0; r < 16; ++r) p0[r] = fmaf(p0[r], Cmul, off);
#pragma unroll
  for (int r = 0; r < 16; ++r) p1[r] = fmaf(p1[r], Cmul, off);
#pragma unroll
  for (int r = 0; r < 16; ++r) p0[r] = __builtin_amdgcn_exp2f(p0[r]);
}
__device__ __forceinline__ void partialSM_nomax(f32x16& p0) {
#pragma unroll
  for (int r = 0; r < 16; ++r) p0[r] = __builtin_amdgcn_exp2f(p0[r]);
}
__device__ __forceinline__ void finishSM(f32x16& p0, f32x16& p1, float alpha, float& l_reg, bf16x8& pa0, bf16x8& pa1, bf16x8& pa2, bf16x8& pa3) {
#pragma unroll
  for (int r = 0; r < 16; ++r) p1[r] = __builtin_amdgcn_exp2f(p1[r]);
  float ps = 0;
#pragma unroll
  for (int r = 0; r < 16; ++r) ps += p0[r];
#pragma unroll
  for (int r = 0; r < 16; ++r) ps += p1[r];
  { auto rr = __builtin_amdgcn_permlane32_swap(__float_as_uint(ps), __float_as_uint(ps), false, false);
    ps = __uint_as_float(rr[0]) + __uint_as_float(rr[1]); }
  l_reg = l_reg * alpha + ps;
#define FA_PK4(P, BASE, OUT) do { unsigned a0 = cvtpk(P[BASE + 0], P[BASE + 1]), a1 = cvtpk(P[BASE + 2], P[BASE + 3]);   \
    unsigned b0 = cvtpk(P[BASE + 4], P[BASE + 5]), b1 = cvtpk(P[BASE + 6], P[BASE + 7]);                              \
    auto r0 = __builtin_amdgcn_permlane32_swap(a0, b0, false, false); auto r1 = __builtin_amdgcn_permlane32_swap(a1, b1, false, false); \
    u32x4 w = {r0[0], r1[0], r0[1], r1[1]}; OUT = *reinterpret_cast<bf16x8*>(&w); } while (0)
  FA_PK4(p0, 0, pa0); FA_PK4(p0, 8, pa1); FA_PK4(p1, 0, pa2); FA_PK4(p1, 8, pa3);
#undef FA_PK4
}
template <int OFF> __device__ __forceinline__ s16x4 tr_read(int vb) {
  s16x4 r; asm volatile("ds_read_b64_tr_b16 %0, %1 offset:%2" : "=&v"(r) : "v"(vb), "i"(OFF) : "memory"); return r;
}
__device__ __forceinline__ int v_rd_base(int lane) { return ((lane & 3) << 3) | (((lane >> 2) & 3) << 6) | (((lane >> 4) & 1) << 5) | (((lane >> 5) & 1) << 8); }

template <int LDK, int NKS, int DV, bool BIAS, bool NOMAX = false>
struct Body {
  static constexpr int RB = LDK * 2;
  static constexpr int SHM_K = KVBLK * RB, SHM_V = KVBLK * DV * 2;
  static constexpr int NC = DV / 32;
  static constexpr int NKL = LDK / 64, NVL = DV / 64;
  static constexpr int OFF_V = 0, OFF_K = 2 * SHM_V, OFF_WS = 2 * SHM_V + 2 * SHM_K, OFF_TAB = OFF_WS + NW * 64 * 4, LDS_NEED = OFF_TAB + 392 * 4;
  static __device__ __forceinline__ int kswz(int row, int colB) { return row * RB + (colB ^ ((((RB == 128) ? (row ^ (row >> 3)) : row) & 7) << 4)); }
  static __device__ __forceinline__ int v_st(int k, int c) { const int kk = (k & ~0xC) | ((k & 4) << 1) | ((k & 8) >> 1); return ((kk >> 3) * NC + (c >> 5)) * 512 + ((kk & 7) * 32 + (c & 31)) * 2; }
  static constexpr int v_rd_off(int d0, int ks, int half) { return d0 * 512 + ks * (NC * 1024) + half * (NC * 512); }

  static __device__ __forceinline__ void qkt(f32x16& p0, f32x16& p1, const char* Ks, const bf16x8* qr, int r32, int hi) {
    p0 = f32x16{}; p1 = f32x16{};
#pragma unroll
    for (int d0 = 0; d0 < NKS; ++d0) { const int cb = (d0 * 16 + hi * 8) * 2;
      const bf16x8 b0 = *reinterpret_cast<const bf16x8*>(Ks + kswz(r32, cb));
      const bf16x8 b1 = *reinterpret_cast<const bf16x8*>(Ks + kswz(32 + r32, cb));
      p0 = __builtin_amdgcn_mfma_f32_32x32x16_bf16(b0, qr[d0], p0, 0, 0, 0);
      p1 = __builtin_amdgcn_mfma_f32_32x32x16_bf16(b1, qr[d0], p1, 0, 0, 0); }
  }
  template <int D0> static __device__ __forceinline__ void pv_one(f32x16& od, int vb, bf16x8 pa0, bf16x8 pa1, bf16x8 pa2, bf16x8 pa3) {
    const s16x4 l0 = tr_read<v_rd_off(D0, 0, 0)>(vb), h0 = tr_read<v_rd_off(D0, 0, 1)>(vb), l1 = tr_read<v_rd_off(D0, 1, 0)>(vb), h1 = tr_read<v_rd_off(D0, 1, 1)>(vb);
    const s16x4 l2 = tr_read<v_rd_off(D0, 2, 0)>(vb), h2 = tr_read<v_rd_off(D0, 2, 1)>(vb), l3 = tr_read<v_rd_off(D0, 3, 0)>(vb), h3 = tr_read<v_rd_off(D0, 3, 1)>(vb);
    asm volatile("s_waitcnt lgkmcnt(0)" ::: "memory"); FA_SBAR();
#define FA_PK(L, H) (bf16x8){L[0], L[1], L[2], L[3], H[0], H[1], H[2], H[3]}
    od = __builtin_amdgcn_mfma_f32_32x32x16_bf16(pa0, FA_PK(l0, h0), od, 0, 0, 0);
    od = __builtin_amdgcn_mfma_f32_32x32x16_bf16(pa1, FA_PK(l1, h1), od, 0, 0, 0);
    od = __builtin_amdgcn_mfma_f32_32x32x16_bf16(pa2, FA_PK(l2, h2), od, 0, 0, 0);
    od = __builtin_amdgcn_mfma_f32_32x32x16_bf16(pa3, FA_PK(l3, h3), od, 0, 0, 0);
#undef FA_PK
  }
  static __device__ __forceinline__ void pv_all(f32x16* o, int vb, bf16x8 pa0, bf16x8 pa1, bf16x8 pa2, bf16x8 pa3) {
    pv_one<0>(o[0], vb, pa0, pa1, pa2, pa3); pv_one<1>(o[1], vb, pa0, pa1, pa2, pa3);
    if constexpr (NC == 4) { pv_one<2>(o[2], vb, pa0, pa1, pa2, pa3); pv_one<3>(o[3], vb, pa0, pa1, pa2, pa3); }
  }
  static __device__ __forceinline__ void add_bias(f32x16& p0, f32x16& p1, float C, const float* tabl) {
#pragma unroll
    for (int r = 0; r < 16; ++r) { p0[r] = fmaf(p0[r], C, tabl[(r & 3) + 8 * (r >> 2)]); p1[r] = fmaf(p1[r], C, tabl[32 + (r & 3) + 8 * (r >> 2)]); }
  }

  template <class Store>
  static __device__ __forceinline__ void run(const bf16_t* __restrict__ Qb, const bf16_t* __restrict__ Kh, const bf16_t* __restrict__ Vh, int seq, char* lds, float C, int q0, Store store) {
    int tid_ = threadIdx.x; asm volatile("" : "+v"(tid_));
    const int tid = tid_, wid = tid >> 6, lane = tid & 63, r32 = lane & 31, hi = lane >> 5;
    char* V_lds = lds + OFF_V; char* K_lds = lds + OFF_K;
    float* ws = (float*)(lds + OFF_WS) + wid * 64; float* li_l = ws; float* al_l = ws + 32;
    const float* tab = (const float*)(lds + OFF_TAB);
    float m_reg = -1e30f, l_reg = 0; f32x16 o[NC] = {}; bf16x8 qr[NKS];
    const bf16_t* Qw = Qb + (size_t)(wid * QBLK + r32) * LDK + hi * 8;
#pragma unroll
    for (int d0 = 0; d0 < NKS; ++d0) qr[d0] = *reinterpret_cast<const bf16x8*>(Qw + d0 * 16);
    const int ksr = (LDK == 128) ? (tid >> 4) : (tid >> 3), ksc = (LDK == 128) ? (tid & 15) * 8 : (tid & 7) * 8;
    const int vsr = (DV == 128) ? (tid >> 4) : (tid >> 3), vsc = (DV == 128) ? (tid & 15) * 8 : (tid & 7) * 8;
    const int vst0 = v_st(vsr, vsc), vst1 = v_st(32 + vsr, vsc);
    const int vb0 = (int)(uintptr_t)V_lds + v_rd_base(lane);
    struct { bf16x8 v[NVL], k[NKL]; } sr_[2];
#define FA_SLOAD(i, k0) do { _Pragma("unroll") for (int _q = 0; _q < NVL; ++_q) sr_[i].v[_q] = *reinterpret_cast<const bf16x8*>(&Vh[(size_t)((k0) + vsr + 32 * _q) * DV + vsc]); \
    _Pragma("unroll") for (int _q = 0; _q < NKL; ++_q) sr_[i].k[_q] = *reinterpret_cast<const bf16x8*>(&Kh[(size_t)((k0) + ksr + 32 * _q) * LDK + ksc]); } while (0)
#define FA_SWRITE(b, i) do { *(bf16x8*)(V_lds + (b) * SHM_V + vst0) = sr_[i].v[0]; if constexpr (NVL == 2) *(bf16x8*)(V_lds + (b) * SHM_V + vst1) = sr_[i].v[NVL - 1]; \
    *(bf16x8*)(K_lds + (b) * SHM_K + kswz(ksr, ksc * 2)) = sr_[i].k[0]; if constexpr (NKL == 2) *(bf16x8*)(K_lds + (b) * SHM_K + kswz(32 + ksr, ksc * 2)) = sr_[i].k[NKL - 1]; } while (0)
#define FA_SWAIT() do { if constexpr (NVL + NKL == 2) asm volatile("s_waitcnt vmcnt(2)" ::: "memory"); else if constexpr (NVL + NKL == 3) asm volatile("s_waitcnt vmcnt(3)" ::: "memory"); else asm volatile("s_waitcnt vmcnt(4)" ::: "memory"); } while (0)
#define FA_RESC(a) do { if constexpr (NOMAX) { if ((a) != 1.f) { _Pragma("unroll") for (int d = 0; d < NC; ++d) _Pragma("unroll") for (int r = 0; r < 16; ++r) o[d][r] *= (a); } } \
    else if (__any((a) < 1.f)) { if (hi == 0) al_l[r32] = (a); asm volatile("s_waitcnt lgkmcnt(0)" ::: "memory"); \
    _Pragma("unroll") for (int d = 0; d < NC; ++d) _Pragma("unroll") for (int r = 0; r < 16; ++r) o[d][r] *= al_l[crow(r, hi)]; } } while (0)
    const int qw = q0 + wid * QBLK;
#define FA_CLS(jt) (((jt) * KVBLK + 63 - qw <= -91) ? 0 : (((jt) * KVBLK - qw - 31 >= 91) ? 2 : 1))
#define FA_PSM(P0, P1, AL, jt) do { if constexpr (NOMAX) { AL = 1.f; \
      if constexpr (BIAS) { const int c1_ = FA_CLS(jt); if ((jt) > 0) { const int c0_ = FA_CLS((jt) - 1); if (c1_ != c0_) AL = (c1_ == 1) ? __builtin_amdgcn_exp2f(tab[0]) : __builtin_amdgcn_exp2f(-tab[384]); } \
        if (c1_ == 1) add_bias(P0, P1, 1.f, tab + ((jt) * KVBLK - (qw + r32) + 192 + 4 * hi)); }     \
      partialSM_nomax(P0); } \
    else if constexpr (BIAS) { const int kt_ = (jt) * KVBLK; \
      if (kt_ + 63 - qw <= -91) partialSM(P0, P1, m_reg, AL, C, tab[0]); \
      else if (kt_ - qw - 31 >= 91) partialSM(P0, P1, m_reg, AL, C, tab[384]); \
      else { add_bias(P0, P1, C, tab + (kt_ - (qw + r32) + 192 + 4 * hi)); partialSM(P0, P1, m_reg, AL, 1.f, 0.f); } } \
    else partialSM(P0, P1, m_reg, AL, C, 0.f); } while (0)
    f32x16 pA0, pA1, pB0, pB1; float alA, alB; bf16x8 pa0, pa1, pa2, pa3; const int NT = seq / KVBLK;
    constexpr int SE = 0, SO = 1;
    FA_SLOAD(SE, 0); asm volatile("s_waitcnt vmcnt(0)" ::: "memory"); FA_SWRITE(0, SE); __syncthreads();
    qkt(pA0, pA1, K_lds, qr, r32, hi); FA_PSM(pA0, pA1, alA, 0);
    FA_SLOAD(SO, KVBLK); if (2 < NT) FA_SLOAD(SE, 2 * KVBLK);
    FA_SWAIT(); FA_SWRITE(1, SO); __syncthreads();
    for (int j = 1; j + 1 < NT; j += 2) {
      FA_SBAR(); qkt(pB0, pB1, K_lds + SHM_K, qr, r32, hi);
      finishSM(pA0, pA1, alA, l_reg, pa0, pa1, pa2, pa3); FA_SBAR();
      FA_SLOAD(SO, (j + 2) * KVBLK); FA_SBAR();
      pv_all(o, vb0, pa0, pa1, pa2, pa3); FA_PSM(pB0, pB1, alB, j);
      __syncthreads(); FA_SWAIT(); FA_SWRITE(0, SE);
      FA_RESC(alB); __syncthreads();
      FA_SBAR(); qkt(pA0, pA1, K_lds, qr, r32, hi);
      finishSM(pB0, pB1, alB, l_reg, pa0, pa1, pa2, pa3); FA_SBAR();
      if (j + 3 < NT) FA_SLOAD(SE, (j + 3) * KVBLK); FA_SBAR();
      pv_all(o, vb0 + SHM_V, pa0, pa1, pa2, pa3); FA_PSM(pA0, pA1, alA, j + 1);
      __syncthreads(); FA_SWAIT(); FA_SWRITE(1, SO);
      FA_RESC(alA); __syncthreads();
    }
    FA_SBAR(); qkt(pB0, pB1, K_lds + SHM_K, qr, r32, hi);
    finishSM(pA0, pA1, alA, l_reg, pa0, pa1, pa2, pa3); FA_SBAR();
    pv_all(o, vb0, pa0, pa1, pa2, pa3); FA_PSM(pB0, pB1, alB, NT - 1);
    __syncthreads(); FA_RESC(alB);
    finishSM(pB0, pB1, alB, l_reg, pa0, pa1, pa2, pa3); FA_SBAR();
    pv_all(o, vb0 + SHM_V, pa0, pa1, pa2, pa3);
    if (hi == 0) li_l[r32] = l_reg; asm volatile("s_waitcnt lgkmcnt(0)" ::: "memory");
    float rli[16];
#pragma unroll
    for (int r = 0; r < 16; ++r) rli[r] = __builtin_amdgcn_rcpf(li_l[crow(r, hi)]);
    store(o, rli, wid, r32, hi);
    __syncthreads();
#undef FA_SLOAD
#undef FA_SWRITE
#undef FA_SWAIT
#undef FA_RESC
#undef FA_PSM
#undef FA_CLS
  }
};
}


namespace fa8 {
using fa::f32x16; using fa::crow;
typedef int v8i __attribute__((ext_vector_type(8)));
typedef short v2s __attribute__((ext_vector_type(2)));
template <int NKB>
struct Body {
  static constexpr int RBK = 64 * NKB, SHM_K = 64 * RBK, SHM_V = 64 * 64, NP = (NKB == 1) ? 1 : 2;
  static constexpr int OFF_V = 0, OFF_K = 4 * SHM_V, OFF_WS = OFF_K + 4 * SHM_K, LDS_NEED = OFF_WS + 8 * 32 * 4;
  static __device__ __forceinline__ int swzk(int row) { return NKB == 1 ? ((row >> 2) & 3) : ((row >> 1) & 7); }
  static __device__ __forceinline__ int koffs(int row, int chunk) { return row * RBK + ((chunk ^ swzk(row)) << 4); }
  static __device__ __forceinline__ int voffs(int row, int chunk) { return row * 64 + ((chunk ^ ((row >> 2) & 3)) << 4); }

  template <class Store>
  static __device__ __forceinline__ void run(const unsigned char* __restrict__ Qb, const unsigned char* __restrict__ Kh, const unsigned char* __restrict__ VTh, int seq, LAS unsigned char* lds, int cexp, Store store) {
    int tid_ = threadIdx.x; asm volatile("" : "+v"(tid_));
    const int tid = tid_, wid = __builtin_amdgcn_readfirstlane(tid >> 6), lane = tid & 63, r32 = lane & 31, hi = lane >> 5;
    unsigned kgo, vgo;
    { const int pc = (NKB == 1) ? (wid & 3) : wid, pos = pc * 1024 + lane * 16, row = pos / RBK, ch = ((pos % RBK) >> 4) ^ swzk(row); kgo = (unsigned)(row * RBK + ch * 16); }
    { const int pc = wid & 3, pos = pc * 1024 + lane * 16, row = pos >> 6, ch = ((pos & 63) >> 4) ^ ((row >> 2) & 3); vgo = (unsigned)(row * seq + ch * 16); }
    const int NT = seq / 64;
#define F8_TCL(t) ((t) < NT ? (t) : NT - 1)
#define F8_DMA_K(t, b) __builtin_amdgcn_global_load_lds((const unsigned*)(Kh + (size_t)F8_TCL(t) * 64 * RBK + kgo), (LAS unsigned*)(lds + OFF_K + (b) * SHM_K + ((NKB == 1) ? (wid & 3) : wid) * 1024), 16, 0, 0)
#define F8_DMA_V(t, b) __builtin_amdgcn_global_load_lds((const unsigned*)(VTh + (size_t)F8_TCL(t) * 64 + vgo), (LAS unsigned*)(lds + OFF_V + (b) * SHM_V + (wid & 3) * 1024), 16, 0, 0)
#define F8_DMA2(a_) do { \
      if constexpr (NKB == 1) { const int kt_ = (a_) + 4 + (wid >> 2); F8_DMA_K(kt_, kt_ & 3); } \
      else { F8_DMA_K((a_) + 4, ((a_) + 4) & 3); F8_DMA_K((a_) + 5, ((a_) + 5) & 3); } \
      { const int vt_ = (a_) + 1 + (wid >> 2); F8_DMA_V(vt_, vt_ & 3); } } while (0)
#define F8_BAR() do { __builtin_amdgcn_sched_barrier(0); __builtin_amdgcn_s_barrier(); __builtin_amdgcn_sched_barrier(0); } while (0)
#define F8_VM0() asm volatile("s_waitcnt vmcnt(0)" ::: "memory")
#define F8_VMNP() do { if constexpr (NP == 1) asm volatile("s_waitcnt vmcnt(1)" ::: "memory"); else asm volatile("s_waitcnt vmcnt(2)" ::: "memory"); } while (0)
    f32x16 o[2] = {}, ol = {}; f32x16 sA0, sA1, sB0, sB1; v8i pA, pB; int saA = 127, saB = 127;
    const float csc = __builtin_bit_cast(float, (unsigned)(127 + cexp) << 23); const int sap = 127 + cexp;
    const v8i ones = {0x38383838, 0x38383838, 0x38383838, 0x38383838, 0x38383838, 0x38383838, 0x38383838, 0x38383838};
    int c127 = 127, c124 = 124; asm volatile("" : "+v"(c127), "+v"(c124));
    v8i qf[NKB], kf[2][NKB], vf[2];
    { const unsigned char* Qw = Qb + (size_t)(wid * 32 + r32) * RBK + hi * 32;
#pragma unroll
      for (int c = 0; c < NKB; ++c) { const u32x4 a = *(const u32x4*)(Qw + c * 64), b = *(const u32x4*)(Qw + c * 64 + 16); qf[c] = (v8i){(int)a[0], (int)a[1], (int)a[2], (int)a[3], (int)b[0], (int)b[1], (int)b[2], (int)b[3]}; } }
#define F8_LD32(p0_, p1_) ({ const u32x4 a_ = *(const LAS u32x4*)(p0_), b_ = *(const LAS u32x4*)(p1_); (v8i){(int)a_[0], (int)a_[1], (int)a_[2], (int)a_[3], (int)b_[0], (int)b_[1], (int)b_[2], (int)b_[3]}; })
#define F8_KLOAD(kb) do { const LAS unsigned char* Ks_ = lds + OFF_K + (kb) * SHM_K; \
      _Pragma("unroll") for (int h2 = 0; h2 < 2; ++h2) _Pragma("unroll") for (int c = 0; c < NKB; ++c) { const int row = h2 * 32 + r32, ch = c * 4 + 2 * hi; \
        kf[h2][c] = F8_LD32(Ks_ + koffs(row, ch), Ks_ + koffs(row, ch + 1)); } } while (0)
#define F8_VLOAD(vb) do { const LAS unsigned char* Vs_ = lds + OFF_V + (vb) * SHM_V; \
      _Pragma("unroll") for (int d = 0; d < 2; ++d) { const int row = d * 32 + r32; vf[d] = F8_LD32(Vs_ + voffs(row, 2 * hi), Vs_ + voffs(row, 2 * hi + 1)); } } while (0)
#define F8_QKN(S, KF, QF) asm volatile("s_nop 1\n\tv_mfma_scale_f32_32x32x64_f8f6f4 %0, %1, %2, 0, %3, %4 op_sel_hi:[0,0,0]" : "=&v"(S) : "v"(KF), "v"(QF), "v"(c127), "v"(c124))
#define F8_QKA(S, KF, QF) asm volatile("s_nop 1\n\tv_mfma_scale_f32_32x32x64_f8f6f4 %0, %1, %2, %0, %3, %4 op_sel_hi:[0,0,0]" : "+v"(S) : "v"(KF), "v"(QF), "v"(c127), "v"(c124))
#define F8_QK(S0, S1) do { __builtin_amdgcn_sched_barrier(0); F8_QKN(S0, kf[0][0], qf[0]); F8_QKN(S1, kf[1][0], qf[0]); \
      if constexpr (NKB == 2) { F8_QKA(S0, kf[0][1], qf[1]); F8_QKA(S1, kf[1][1], qf[1]); } __builtin_amdgcn_sched_barrier(0); } while (0)
#define F8_PVX(ACC, P, B, SA) do { __builtin_amdgcn_sched_barrier(0); asm volatile("s_nop 1\n\tv_mfma_scale_f32_32x32x64_f8f6f4 %0, %1, %2, %0, %3, %4 op_sel_hi:[0,0,0] cbsz:1" : "+v"(ACC) : "v"(P), "v"(B), "v"(SA), "v"(c127)); __builtin_amdgcn_sched_barrier(0); } while (0)
#define F8_PV(P, SA) do { F8_PVX(o[0], P, vf[0], SA); F8_PVX(o[1], P, vf[1], SA); F8_PVX(ol, P, ones, SA); } while (0)
#define F8_ONOP() asm volatile("s_nop 15\n\ts_nop 15\n\ts_nop 15\n\ts_nop 15" ::: "memory")
#define F8_CV4(S, B4, SC) ({ v2s z_; asm volatile("" : "=v"(z_)); z_ = __builtin_amdgcn_cvt_scalef32_pk_bf8_f32(z_, S[B4], S[B4 + 1], SC, false); z_ = __builtin_amdgcn_cvt_scalef32_pk_bf8_f32(z_, S[B4 + 2], S[B4 + 3], SC, true); (unsigned)__builtin_bit_cast(int, z_); })
#define F8_SM(S0, S1, P, SA) F8_SMX(S0, S1, P, SA, P, SA, false, -1)
#define F8_SMX(S0, S1, P, SA, PP_, SAP_, DOPV_, KB_) do { \
      _Pragma("unroll") for (int r = 0; r < 16; ++r) S0[r] = __builtin_amdgcn_exp2f(S0[r]); \
      if (DOPV_) F8_PVX(o[0], PP_, vf[0], SAP_); \
      _Pragma("unroll") for (int r = 0; r < 16; ++r) S1[r] = __builtin_amdgcn_exp2f(S1[r]); \
      if (DOPV_) F8_PVX(o[1], PP_, vf[1], SAP_); \
      if ((KB_) >= 0) { __builtin_amdgcn_sched_barrier(0); F8_KLOAD(KB_); __builtin_amdgcn_sched_barrier(0); }        \
      unsigned x_[4], y_[4]; \
      _Pragma("unroll") for (int i = 0; i < 4; ++i) x_[i] = F8_CV4(S0, 4 * i, csc); \
      if (DOPV_) F8_PVX(ol, PP_, ones, SAP_); \
      _Pragma("unroll") for (int i = 0; i < 4; ++i) y_[i] = F8_CV4(S1, 4 * i, csc); \
      P = (v8i){(int)x_[0], (int)x_[1], (int)x_[2], (int)x_[3], (int)y_[0], (int)y_[1], (int)y_[2], (int)y_[3]}; \
      SA = sap; } while (0)
#define F8_STEP(j_, SI0, SI1, SO0, SO1, PP, SAP, PN, SAN, dopv) do { \
      F8_QK(SO0, SO1); \
      if (dopv) F8_VLOAD(((j_) - 1) & 3); \
      F8_SMX(SI0, SI1, PN, SAN, PP, SAP, dopv, ((j_) + 2) & 3); \
      __builtin_amdgcn_sched_barrier(0); } while (0)
#define F8_PAIR_END() do { asm volatile("s_waitcnt lgkmcnt(0)" ::: "memory"); F8_VM0(); F8_BAR(); } while (0)

    if constexpr (NKB == 1) { if (wid < 4) { F8_DMA_K(0, 0); F8_DMA_K(1, 1); F8_DMA_K(2, 2); F8_DMA_K(3, 3); } else F8_DMA_V(0, 0); }
    else { F8_DMA_K(0, 0); F8_DMA_K(1, 1); F8_DMA_K(2, 2); F8_DMA_K(3, 3); F8_DMA_V(0, 0); }
    F8_VM0(); F8_BAR();
    F8_KLOAD(0); F8_QK(sA0, sA1); F8_ONOP(); F8_ONOP(); F8_ONOP(); F8_ONOP(); __builtin_amdgcn_sched_barrier(0); F8_KLOAD(1);
    asm volatile("s_waitcnt lgkmcnt(0)" ::: "memory"); F8_BAR();
    F8_DMA2(0); __builtin_amdgcn_sched_barrier(0);
    F8_STEP(0, sA0, sA1, sB0, sB1, pB, saB, pA, saA, false);
    F8_STEP(1, sB0, sB1, sA0, sA1, pA, saA, pB, saB, true);
    F8_PAIR_END();
    for (int j = 2; j + 1 < NT; j += 2) {
      F8_DMA2(j); __builtin_amdgcn_sched_barrier(0);
      F8_STEP(j, sA0, sA1, sB0, sB1, pB, saB, pA, saA, true);
      F8_STEP(j + 1, sB0, sB1, sA0, sA1, pA, saA, pB, saB, true);
      F8_PAIR_END();
    }
    F8_VLOAD((NT - 1) & 3); F8_PV(pB, saB);
    F8_ONOP();
    float rli[16];
#pragma unroll
    for (int r = 0; r < 16; ++r) rli[r] = __builtin_amdgcn_rcpf(ol[r]);
    store(o, rli, wid, r32, hi);
    __syncthreads();
#undef F8_TCL
#undef F8_DMA_K
#undef F8_DMA_V
#undef F8_BAR
#undef F8_VM0
#undef F8_VMNP
#undef F8_LD32
#undef F8_KLOAD
#undef F8_VLOAD
#undef F8_QK
#undef F8_QKN
#undef F8_QKA
#undef F8_PVX
#undef F8_ONOP
#undef F8_SMX
#undef F8_PV
#undef F8_CV4
#undef F8_SM
#undef F8_STEP
#undef F8_PAIR_END
#undef F8_DMA2
  }
};
}


namespace fa8v {
using fa::f32x16; using fa::crow;
typedef int v8i __attribute__((ext_vector_type(8)));
typedef short v2s __attribute__((ext_vector_type(2)));
struct Body {
  static constexpr int SHM_K = 64 * 64, SHM_V = 128 * 64;
  static constexpr int OFF_V = 0, OFF_K = 4 * SHM_V, OFF_TAB = fa::Body<64, 4, 128, true>::OFF_TAB, OFF_WS = OFF_TAB + 392 * 4, LDS_NEED = OFF_WS + 8 * 32 * 4;
  static_assert(OFF_K + 4 * SHM_K <= OFF_TAB && LDS_NEED <= LDS_CTL, "fa8v LDS map");
  static __device__ __forceinline__ int offs(int row, int chunk) { return row * 64 + ((chunk ^ ((row >> 2) & 3)) << 4); }

  template <class Store>
  static __device__ __forceinline__ void run(const unsigned char* __restrict__ Qb, const unsigned char* __restrict__ Kh, const unsigned char* __restrict__ VTh, int seq, LAS unsigned char* lds, int q0, int cexp, Store store) {
    int tid_ = threadIdx.x; asm volatile("" : "+v"(tid_));
    const int tid = tid_, wid = __builtin_amdgcn_readfirstlane(tid >> 6), lane = tid & 63, r32 = lane & 31, hi = lane >> 5;
    const float* tab = (const float*)(lds + OFF_TAB);
    float* li_l = (float*)(lds + OFF_WS) + wid * 32;
    unsigned kgo, vgo;
    { const int pos = (wid & 3) * 1024 + lane * 16, row = pos >> 6, ch = ((pos & 63) >> 4) ^ ((row >> 2) & 3); kgo = (unsigned)(row * 64 + ch * 16); }
    { const int pos = wid * 1024 + lane * 16, row = pos >> 6, ch = ((pos & 63) >> 4) ^ ((row >> 2) & 3); vgo = (unsigned)(row * seq + ch * 16); }
    const int NT = seq / 64;
#define FV_TCL(t) ((t) < NT ? (t) : NT - 1)
#define FV_DMA_K(t, b) do { if (wid < 4) __builtin_amdgcn_global_load_lds((const unsigned*)(Kh + (size_t)FV_TCL(t) * 4096 + kgo), (LAS unsigned*)(lds + OFF_K + (b) * SHM_K + wid * 1024), 16, 0, 0); } while (0)
#define FV_DMA_V(t, b) __builtin_amdgcn_global_load_lds((const unsigned*)(VTh + (size_t)FV_TCL(t) * 64 + vgo), (LAS unsigned*)(lds + OFF_V + (b) * SHM_V + wid * 1024), 16, 0, 0)
#define FV_DMA2(a_) do { const int kt_ = (a_) + 4 + (wid >> 2); \
      __builtin_amdgcn_global_load_lds((const unsigned*)(Kh + (size_t)FV_TCL(kt_) * 4096 + kgo), (LAS unsigned*)(lds + OFF_K + (kt_ & 3) * SHM_K + (wid & 3) * 1024), 16, 0, 0); \
      __builtin_amdgcn_global_load_lds((const unsigned*)(VTh + (size_t)FV_TCL((a_) + 1) * 64 + vgo), (LAS unsigned*)(lds + OFF_V + (((a_) + 1) & 3) * SHM_V + wid * 1024), 16, 0, 0); \
      __builtin_amdgcn_global_load_lds((const unsigned*)(VTh + (size_t)FV_TCL((a_) + 2) * 64 + vgo), (LAS unsigned*)(lds + OFF_V + (((a_) + 2) & 3) * SHM_V + wid * 1024), 16, 0, 0); } while (0)
#define FV_BAR() do { __builtin_amdgcn_sched_barrier(0); __builtin_amdgcn_s_barrier(); __builtin_amdgcn_sched_barrier(0); } while (0)
#define FV_VM0() asm volatile("s_waitcnt vmcnt(0)" ::: "memory")
#define FV_VMNP() do { if (wid < 4) asm volatile("s_waitcnt vmcnt(2)" ::: "memory"); else asm volatile("s_waitcnt vmcnt(1)" ::: "memory"); } while (0)
    f32x16 o[4] = {}; f32x16 sA0, sA1, sB0, sB1; v8i pA, pB; int saA = 127, saB = 127;
    typedef float f32x4_t __attribute__((ext_vector_type(4)));
    f32x4_t ol4 = {0.f, 0.f, 0.f, 0.f};
    int c127 = 127, c124 = 124; asm volatile("" : "+v"(c127), "+v"(c124));
    v8i onesB; { const int on = ((((lane & 15) < 8) ? 0 : 1) == ((lane >> 4) & 1)) ? 0x38383838 : 0; onesB = (v8i){on, on, on, on, on, on, on, on}; }
    const float csc = __builtin_bit_cast(float, (unsigned)(127 + cexp) << 23); const int sap = 127 + cexp;
    v8i qf, kf[2], vf[4];
    { const unsigned char* Qw = Qb + (size_t)(wid * 32 + r32) * 64 + hi * 32;
      const u32x4 a = *(const u32x4*)Qw, b = *(const u32x4*)(Qw + 16); qf = (v8i){(int)a[0], (int)a[1], (int)a[2], (int)a[3], (int)b[0], (int)b[1], (int)b[2], (int)b[3]}; }
    const int qw = q0 + wid * 32;
    const int Lf = (qw - 154) >> 6, Rf = (qw + 122 + 63) >> 6, jn0 = (Lf >= 0) ? Lf + 1 : -1;
#define FV_CLS1(jt) ((jt) > Lf && (jt) < Rf)
#define FV_LD32(p0_, p1_) ({ const u32x4 a_ = *(const LAS u32x4*)(p0_), b_ = *(const LAS u32x4*)(p1_); (v8i){(int)a_[0], (int)a_[1], (int)a_[2], (int)a_[3], (int)b_[0], (int)b_[1], (int)b_[2], (int)b_[3]}; })
#define FV_KLOAD(kb) do { const LAS unsigned char* Ks_ = lds + OFF_K + (kb) * SHM_K; \
      _Pragma("unroll") for (int h2 = 0; h2 < 2; ++h2) { const int row = h2 * 32 + r32; kf[h2] = FV_LD32(Ks_ + offs(row, 2 * hi), Ks_ + offs(row, 2 * hi + 1)); } } while (0)
#define FV_VLOAD(vb) do { const LAS unsigned char* Vs_ = lds + OFF_V + (vb) * SHM_V; \
      _Pragma("unroll") for (int d = 0; d < 4; ++d) { const int row = d * 32 + r32; vf[d] = FV_LD32(Vs_ + offs(row, 2 * hi), Vs_ + offs(row, 2 * hi + 1)); } } while (0)
#define FV_QK1(S, KF) asm volatile("s_nop 1\n\tv_mfma_scale_f32_32x32x64_f8f6f4 %0, %1, %2, 0, %3, %4 op_sel_hi:[0,0,0]" : "=&v"(S) : "v"(KF), "v"(qf), "v"(c127), "v"(c124))
#define FV_QK(S0, S1) do { __builtin_amdgcn_sched_barrier(0); FV_QK1(S0, kf[0]); FV_QK1(S1, kf[1]); __builtin_amdgcn_sched_barrier(0); } while (0)
#define FV_PV1(P, SA, d) do { __builtin_amdgcn_sched_barrier(0); asm volatile("s_nop 1\n\tv_mfma_scale_f32_32x32x64_f8f6f4 %0, %1, %2, %0, %3, %4 op_sel_hi:[0,0,0] cbsz:1" : "+v"(o[d]) : "v"(P), "v"(vf[d]), "v"(SA), "v"(c127)); __builtin_amdgcn_sched_barrier(0); } while (0)
#define FV_PVS(P, SA) do { ol4 = __builtin_amdgcn_mfma_scale_f32_16x16x128_f8f6f4(P, onesB, ol4, 1, 0, 0, SA, 0, 127); } while (0)
#define FV_PV(P, SA) do { FV_PV1(P, SA, 0); FV_PV1(P, SA, 1); FV_PV1(P, SA, 2); FV_PV1(P, SA, 3); FV_PVS(P, SA); } while (0)
#define FV_ONOP() asm volatile("s_nop 15\n\ts_nop 15\n\ts_nop 15\n\ts_nop 15" ::: "memory")
#define FV_CV4(S, B4, SC) ({ const unsigned w0_ = __builtin_bit_cast(unsigned, __builtin_amdgcn_cvt_pkrtz(S[B4], S[B4 + 1])), w1_ = __builtin_bit_cast(unsigned, __builtin_amdgcn_cvt_pkrtz(S[B4 + 2], S[B4 + 3])); __builtin_amdgcn_perm(w1_, w0_, 0x07050301u); })
#define FV_FAC(jt, f, chg) do { chg = false; f = 1.f; if ((jt) == jn0 || (jt) == Rf) { chg = true; f = ((jt) == jn0) ? __builtin_amdgcn_exp2f(tab[0]) : __builtin_amdgcn_exp2f(-tab[384]); } } while (0)
#define FV_SM(jt, S0, S1, P, SA) FV_SMX(jt, S0, S1, P, SA, P, SA, false, -1)
#define FV_SMX(jt, S0, S1, P, SA, PP_, SAP_, DOPV_, KB_) do { \
      if (FV_CLS1(jt)) { const float* tl_ = tab + ((jt) * 64 - (qw + r32) + 192 + 4 * hi); \
        _Pragma("unroll") for (int r = 0; r < 16; ++r) { S0[r] += tl_[(r & 3) + 8 * (r >> 2)]; S1[r] += tl_[32 + (r & 3) + 8 * (r >> 2)]; } } \
      _Pragma("unroll") for (int r = 0; r < 16; ++r) S0[r] = __builtin_amdgcn_exp2f(S0[r]); \
      if (DOPV_) FV_PV1(PP_, SAP_, 0); \
      _Pragma("unroll") for (int r = 0; r < 8; ++r) S1[r] = __builtin_amdgcn_exp2f(S1[r]); \
      if (DOPV_) FV_PV1(PP_, SAP_, 1); \
      if ((KB_) >= 0) { __builtin_amdgcn_sched_barrier(0); FV_KLOAD(KB_); __builtin_amdgcn_sched_barrier(0); }        \
      _Pragma("unroll") for (int r = 8; r < 16; ++r) S1[r] = __builtin_amdgcn_exp2f(S1[r]); \
      if (DOPV_) { FV_PV1(PP_, SAP_, 2); } \
      unsigned x_[4], y_[4]; \
      _Pragma("unroll") for (int i = 0; i < 4; ++i) x_[i] = FV_CV4(S0, 4 * i, csc); \
      if (DOPV_) { FV_PV1(PP_, SAP_, 3); FV_PVS(PP_, SAP_); } \
      _Pragma("unroll") for (int i = 0; i < 4; ++i) y_[i] = FV_CV4(S1, 4 * i, csc); \
      _Pragma("unroll") for (int i = 0; i < 4; ++i) asm volatile("" : "+v"(x_[i]), "+v"(y_[i])); \
      P = (v8i){(int)x_[0], (int)x_[1], (int)x_[2], (int)x_[3], (int)y_[0], (int)y_[1], (int)y_[2], (int)y_[3]}; SA = sap; } while (0)
#define FV_ORESC(jt) do { bool chg_; float f_; FV_FAC(jt, f_, chg_); if (chg_) { FV_ONOP(); _Pragma("unroll") for (int d = 0; d < 4; ++d) _Pragma("unroll") for (int r = 0; r < 16; ++r) o[d][r] *= f_; ol4 *= f_; } } while (0)
#define FV_STEP(j_, SI0, SI1, SO0, SO1, PP, SAP, PN, SAN, dopv) do { \
      FV_QK(SO0, SO1); \
      __builtin_amdgcn_sched_barrier(0); \
      if (dopv) { FV_VLOAD(((j_) - 1) & 3); FV_ORESC((j_) - 1); } \
      FV_SMX(j_, SI0, SI1, PN, SAN, PP, SAP, dopv, ((j_) + 2) & 3); \
      __builtin_amdgcn_sched_barrier(0); } while (0)
#define FV_PAIR_END() do { asm volatile("s_waitcnt lgkmcnt(0)" ::: "memory"); FV_VM0(); FV_BAR(); } while (0)

    FV_DMA_K(0, 0); FV_DMA_K(1, 1); FV_DMA_K(2, 2); FV_DMA_K(3, 3); FV_DMA_V(0, 0);
    FV_VM0(); FV_BAR();
    FV_KLOAD(0); FV_QK(sA0, sA1); FV_ONOP(); FV_ONOP(); __builtin_amdgcn_sched_barrier(0); FV_KLOAD(1);
    asm volatile("s_waitcnt lgkmcnt(0)" ::: "memory"); FV_BAR();
    FV_DMA2(0); __builtin_amdgcn_sched_barrier(0);
    FV_STEP(0, sA0, sA1, sB0, sB1, pB, saB, pA, saA, false);
    FV_STEP(1, sB0, sB1, sA0, sA1, pA, saA, pB, saB, true);
    FV_PAIR_END();
    for (int j = 2; j + 1 < NT; j += 2) {
      FV_DMA2(j); __builtin_amdgcn_sched_barrier(0);
      FV_STEP(j, sA0, sA1, sB0, sB1, pB, saB, pA, saA, true);
      FV_STEP(j + 1, sB0, sB1, sA0, sA1, pA, saA, pB, saB, true);
      FV_PAIR_END();
    }
    FV_VLOAD((NT - 1) & 3); FV_ORESC(NT - 1); FV_PV(pB, saB);
    FV_ONOP();
    if ((lane & 7) == 0) { const int qb_ = ((lane & 15) ? 16 : 0) + 4 * (lane >> 4);
      li_l[qb_ + 0] = ol4[0]; li_l[qb_ + 1] = ol4[1]; li_l[qb_ + 2] = ol4[2]; li_l[qb_ + 3] = ol4[3]; }
    asm volatile("s_waitcnt lgkmcnt(0)" ::: "memory");
    float rli[16];
#pragma unroll
    for (int r = 0; r < 16; ++r) rli[r] = __builtin_amdgcn_rcpf(li_l[crow(r, hi)]);
    store(o, rli, wid, r32, hi);
    __syncthreads();
#undef FV_TCL
#undef FV_DMA_K
#undef FV_DMA_V
#undef FV_BAR
#undef FV_VM0
#undef FV_VMNP
#undef FV_CLS1
#undef FV_LD32
#undef FV_KLOAD
#undef FV_VLOAD
#undef FV_QK
#undef FV_QK1
#undef FV_PV
#undef FV_PV1
#undef FV_PVS
#undef FV_ONOP
#undef FV_SMX
#undef FV_CV4
#undef FV_FAC
#undef FV_SM
#undef FV_ORESC
#undef FV_STEP
#undef FV_PAIR_END
#undef FV_DMA2
  }
};
}

__device__ __forceinline__ void attn0_fast(const Frame& F) {
  bf16_t* OB = WSP(bf16_t, A_OB);
  const float bnd_mla = pp_mla_bound(F), bnd_gqa = pp_gqa_bound(F);
  const bool pp_mla = bnd_mla <= PP_BF8, pp_gqa = bnd_gqa <= PP_BF8;
  const int cexp_mla = max(-8, (int)ceilf(bnd_mla - 15.5f)), cexp_gqa = max(-8, (int)ceilf(bnd_gqa - 15.5f));
  const int vcu = (F.G % 8 == 0) ? (F.bid % 8) * (F.G / 8) + F.bid / 8 : F.bid;
  for (int u = vcu; u < 64 * 32; u += F.G) {
    const int item = u >> 5, qb = u & 31, q0 = qb * 256;
    if (item < 32) {
      const int b = item >> 3, h = item & 7;
      bf16_t* Ow = OB + ((size_t)b * S_ + q0) * 1024 + h * 64;
      auto st = [&](const fa::f32x16* o, const float* rli, int wid, int r32, int hi) {
#pragma unroll
        for (int r = 0; r < 16; ++r) { const int orow = wid * 32 + fa::crow(r, hi);
#pragma unroll
          for (int d0 = 0; d0 < 2; ++d0) Ow[(size_t)orow * 1024 + d0 * 32 + r32] = f2bf(o[d0][r] * rli[r]); } };
      if (pp_mla) {
        const unsigned char* Qp = WSP(const unsigned char, A_QA) + (((size_t)b * 8 + h) * S_ + q0) * 128;
        const unsigned char* Kp = WSP(const unsigned char, A_KA) + (((size_t)b * 8 + h) * S_) * 128;
        const unsigned char* Vp = WSP(const unsigned char, A_VA) + ((size_t)b * 8 + h) * 64 * S_;
        fa8::Body<2>::run(Qp, Kp, Vp, S_, (LAS unsigned char*)F.lds, cexp_mla, st);
      } else {
        const bf16_t* Qp = WSP(const bf16_t, A_QA) + (((size_t)b * 8 + h) * S_ + q0) * 128;
        const bf16_t* Kp = WSP(const bf16_t, A_KA) + (((size_t)b * 8 + h) * S_) * 128;
        const bf16_t* Vp = WSP(const bf16_t, A_VA) + (((size_t)b * 8 + h) * S_) * 64;
        fa::Body<128, 6, 64, false>::run(Qp, Kp, Vp, S_, (char*)F.lds, 1.f, q0, st);
      }
    } else {
      const int it = item - 32, b = it >> 3, hq = it & 7, hk = hq >> 2;
      bf16_t* Ow = OB + ((size_t)b * S_ + q0) * 1024 + 512 + hq * 64;
      auto st = [&](const fa::f32x16* o, const float* rli, int wid, int r32, int hi) {
#pragma unroll
        for (int r = 0; r < 16; ++r) { const int orow = wid * 32 + fa::crow(r, hi);
#pragma unroll
          for (int d0 = 0; d0 < 2; ++d0) Ow[(size_t)orow * 1024 + d0 * 32 + r32] = f2bf(o[d0][r] * rli[r]); } };
      if (pp_gqa) {
        const unsigned char* Qp = WSP(const unsigned char, A_QG) + (((size_t)b * 8 + hq) * S_ + q0) * 64;
        const unsigned char* Kp = WSP(const unsigned char, A_KG) + (((size_t)b * 2 + hk) * S_) * 64;
        const unsigned char* Vp = WSP(const unsigned char, A_VG) + ((size_t)b * 2 + hk) * 64 * S_;
        fa8::Body<1>::run(Qp, Kp, Vp, S_, (LAS unsigned char*)F.lds, cexp_gqa, st);
      } else {
        const bf16_t* Qp = WSP(const bf16_t, A_QG) + (((size_t)b * 8 + hq) * S_ + q0) * 64;
        const bf16_t* Kp = WSP(const bf16_t, A_KG) + (((size_t)b * 2 + hk) * S_) * 64;
        const bf16_t* Vp = WSP(const bf16_t, A_VG) + (((size_t)b * 2 + hk) * S_) * 64;
        fa::Body<64, 4, 64, false>::run(Qp, Kp, Vp, S_, (char*)F.lds, 1.f, q0, st);
      }
    }
  }
}
#ifndef FP8_FROM_COMP
#define FP8_FROM_COMP 0
#endif
__device__ __forceinline__ void attn1_fast(const Frame& F) {
  float* OD = WSP(float, A_OD);
  bf16_t* OB = WSP(bf16_t, A_OB1);
  using B1 = fa::Body<64, 4, 128, true>;
  const float bnd = pp_diff_bound(F);
  const bool pp = bnd <= PP_F16;
  const int cexp = 0;
  const float lambda_init = 0.8f - 0.6f * 0.7408182206817179f;
  float lam;
  { const float a = F.in[I_LQ1][F.lane] * F.in[I_LK1][F.lane], c = F.in[I_LQ2][F.lane] * F.in[I_LK2][F.lane];
    lam = __expf(wave_sum(a)) - __expf(wave_sum(c)) + lambda_init; }
  float* tab = (float*)(F.lds + B1::OFF_TAB);
  const int vcu = (F.G % 8 == 0) ? (F.bid % 8) * (F.G / 8) + F.bid / 8 : F.bid;
  const int nround = (64 * 32 + F.G - 1) / F.G;
  int curh = -1;
  for (int v = vcu; v < 32 * 32; v += F.G)
  for (int comp = 0; comp < 2; ++comp) {
    const int pair = v >> 5, qb = v & 31, q0 = qb * 256;
    const int b = pair >> 3, h = pair & 7, h16 = h * 2 + comp;
    if (h != curh) {
      for (int i = F.tid; i < 385; i += NTHR) tab[i] = F.in[I_RELB][t5_bucket(i - 192) * 8 + h] * LOG2E;
      curh = h; __syncthreads();
    }
    const bf16_t* Qp = WSP(const bf16_t, A_QD) + (((size_t)b * 16 + h16) * S_ + q0) * 64;
    const bf16_t* Kp = WSP(const bf16_t, A_KD) + (((size_t)b * 16 + h16) * S_) * 64;
    const bf16_t* Vp = WSP(const bf16_t, A_VD) + (((size_t)b * 8 + h) * S_) * 128;
    float* Od = OD + (((size_t)b * S_ + q0) * 8 + h) * 128;
    bf16_t* Ob = OB + ((size_t)b * S_ + q0) * 1024 + h * 128;
    const float* sub = F.in[I_SUBLN];
    auto st = [&](const fa::f32x16* o, const float* rli, int wid, int r32, int hi) {
      if (comp == 0) {
#pragma unroll
        for (int r = 0; r < 16; ++r) { const int orow = wid * 32 + fa::crow(r, hi);
#pragma unroll
          for (int d0 = 0; d0 < 4; ++d0) Od[(size_t)orow * 1024 + d0 * 32 + r32] = o[d0][r] * rli[r]; }
        asm volatile("s_waitcnt vmcnt(0)" ::: "memory");
      } else {
        float g[4];
#pragma unroll
        for (int d0 = 0; d0 < 4; ++d0) g[d0] = sub[d0 * 32 + r32] * (1.f - lambda_init);
#pragma unroll
        for (int r = 0; r < 16; ++r) { const int orow = wid * 32 + fa::crow(r, hi);
          float x[4]; float ss = 0.f;
#pragma unroll
          for (int d0 = 0; d0 < 4; ++d0) { x[d0] = Od[(size_t)orow * 1024 + d0 * 32 + r32] - lam * (o[d0][r] * rli[r]); ss += x[d0] * x[d0]; }
          ss += __shfl_xor(ss, 1); ss += __shfl_xor(ss, 2); ss += __shfl_xor(ss, 4); ss += __shfl_xor(ss, 8); ss += __shfl_xor(ss, 16);
          const float rn = rsqrtf(ss * (1.f / 128.f) + EPS_);
#pragma unroll
          for (int d0 = 0; d0 < 4; ++d0) Ob[(size_t)orow * 1024 + d0 * 32 + r32] = f2bf(x[d0] * rn * g[d0]); }
      } };
    if (pp && comp >= FP8_FROM_COMP) {
      const unsigned char* Q8 = WSP(const unsigned char, A_Q8D) + (((size_t)b * 16 + h16) * S_ + q0) * 64;
      const unsigned char* K8 = WSP(const unsigned char, A_K8D) + (((size_t)b * 16 + h16) * S_) * 64;
      const unsigned char* V8 = WSP(const unsigned char, A_VT8D) + ((size_t)b * 8 + h) * 128 * S_;
      fa8v::Body::run(Q8, K8, V8, S_, (LAS unsigned char*)F.lds, q0, cexp, st);
    }
    else if (pp) fa::Body<64, 4, 128, true, true>::run(Qp, Kp, Vp, S_, (char*)F.lds, 1.f, q0, st);
    else         B1::run(Qp, Kp, Vp, S_, (char*)F.lds, 1.f, q0, st);
  }
  (void)nround;
}


constexpr int NPH = 21;
__global__ void __launch_bounds__(NTHR, 2) mega(Args a) {
  extern __shared__ __attribute__((aligned(16))) unsigned char lds[];
  Frame F;
#pragma unroll
  for (int i = 0; i < N_IN; ++i) F.in[i] = a.in[i];
  F.out = a.out; F.ws = a.ws; F.lds = lds;
  F.tid = threadIdx.x; F.lane = F.tid & 63; F.wave = __builtin_amdgcn_readfirstlane(F.tid >> 6); F.G = gridDim.x; F.bid = blockIdx.x;
  if (F.tid < 4) ((unsigned*)(lds + LDS_CTL))[F.tid] = 0u;
  __syncthreads();
  XcdBarrier bar; bar.bar = (unsigned*)(F.ws + WS_CTL); bar.x = 0; bar.st = nullptr;
#if MK_ONE_LAUNCH
  bar = xcd_barrier_post((unsigned*)(F.ws + WS_CTL), (volatile LAS unsigned*)(lds + LDS_CTL));
#define GRID_BAR() xcd_barrier(bar)
#else
#define GRID_BAR() do {} while (0)
#endif
  const int lo = a.ph_lo, hi = a.ph_hi;
#define IN(k) (lo <= (k) && (k) < hi)
#define SEAM(k) do { if (IN((k) + 1)) GRID_BAR(); } while (0)

  if (IN(0)) { phase0(F); SEAM(0); }
  if (IN(1)) { phase_xnorm<0>(F, 0); SEAM(1); }
  if (IN(2)) {
    {
    pg::DenseOrder S; S.init(WSP(const bf16_t, WS_HB), WSP(const bf16_t, WS_WIN0), T_, P0LD, 512, F.G, F.bid);
    pg::EpiStoreBf16 E{WSP(bf16_t, A_PROJ0), P0LD};
    pg::gemm_phase<pg::EpiStoreBf16, pg::DenseOrder, false, true>((LAS unsigned char*)lds, 512, S, E, 121  , 127);
    }
    SEAM(2);
  }
  if (IN(3)) { phase_split0(F); SEAM(3); }
  if (IN(4)) {
    {
    { pg::DenseOrder S; S.init(WSP(const bf16_t, A_CQN), WSP(const bf16_t, WS_WQB), T_, 768, 512, F.G, F.bid);
      pg::EpiStoreBf16 E{WSP(bf16_t, A_QRAW), 768};
      pg::gemm_phase<pg::EpiStoreBf16, pg::DenseOrder, false>((LAS unsigned char*)lds, 512, S, E); }
    { pg::DenseOrder S; S.init(WSP(const bf16_t, A_CKVN), WSP(const bf16_t, WS_WKVB), T_, 1024, 256, F.G, F.bid);
      pg::EpiStoreBf16 E{WSP(bf16_t, A_KVRAW), 1024};
      pg::gemm_phase<pg::EpiStoreBf16, pg::DenseOrder, false>((LAS unsigned char*)lds, 256, S, E); }
    }
    SEAM(4);
  }
  if (IN(5)) { phase_mla(F); SEAM(5); }
  if (IN(6)) { attn0_fast(F); SEAM(6); }
  if (IN(7)) {
    {
    pg::DenseOrder S; S.init(WSP(const bf16_t, A_OB), WSP(const bf16_t, WS_WOUT0), T_, 1024, 1024, F.G, F.bid);
    pg::EpiResid E{F.in[I_X], F.out, WSP(const float, WS_MOD) + 2048, WSP(float, WS_ROWSS)};
    pg::gemm_phase<pg::EpiResid, pg::DenseOrder, false>((LAS unsigned char*)lds, 1024, S, E);
    }
    SEAM(7);
  }
  if (IN(8)) { phase_route(F, 0); SEAM(8); }
  if (IN(9)) { moe_up_fast(F, 0); SEAM(9); }
  if (IN(10)) { moe_down_fast(F, 0); SEAM(10); }
  if (IN(11)) { phase_xnorm<1>(F, 1); SEAM(11); }
  if (IN(12)) {
    const bool pp1 = pp_diff_ok(F);
    {
    pg::DenseOrder S; S.init(WSP(const bf16_t, WS_HB), WSP(const bf16_t, WS_WIN1), T_, 3072, 512, F.G, F.bid);
    pg::EpiSplit1 E{WSP(bf16_t, A_QD), WSP(bf16_t, A_KD), WSP(bf16_t, A_VD), F.in[I_CQN], F.in[I_CKN], WSP(unsigned char, A_Q8D), WSP(unsigned char, A_K8D), pp1 ? 0 : 1};
    pg::gemm_phase<pg::EpiSplit1, pg::DenseOrder, false, true, 1>((LAS unsigned char*)lds, 512, S, E, 121  , 127);
    }
    SEAM(12);
  }
  if (IN(13)) { phase_vt1(F); SEAM(13); }
  if (IN(14)) { attn1_fast(F); SEAM(14); }
  if (IN(16)) {
    pg::DenseOrder S; S.init(WSP(const bf16_t, A_OB1), WSP(const bf16_t, WS_WOUT1), T_, 1024, 1024, F.G, F.bid);
    pg::EpiResid E{F.out, F.out, WSP(const float, WS_MOD) + (size_t)4 * 6144 + 2048, WSP(float, WS_ROWSS)};
    pg::gemm_phase<pg::EpiResid, pg::DenseOrder, false>((LAS unsigned char*)lds, 1024, S, E);
    SEAM(16);
  }
  if (IN(17)) { phase_route(F, 1); SEAM(17); }
  if (IN(18)) { moe_up_fast(F, 1); SEAM(18); }
  if (IN(19)) { moe_down_fast(F, 1); SEAM(19); }
  if (IN(20)) { phase_xnorm<2>(F, 1); }
}
}

extern "C" void kernel_launch(void* const* d_in, const int* in_sizes, int n_in, void* d_out, int out_size, void* d_ws, size_t ws_size, hipStream_t stream) {
  static int grid = 0;
  if (grid == 0) {
    if (n_in != N_IN || out_size != T_ * D_ || ws_size < WS_END) { fprintf(stderr, "kernel_launch: bad shapes n_in %d out %d ws %zu (need %zu)\n", n_in, out_size, ws_size, (size_t)WS_END); grid = -1; return; }
    int dev = 0, cus = 0, per_cu = 0;
    if (hipGetDevice(&dev) != hipSuccess || hipDeviceGetAttribute(&cus, hipDeviceAttributeMultiprocessorCount, dev) != hipSuccess) { grid = -1; return; }
    if (hipFuncSetAttribute((const void*)mega, hipFuncAttributeMaxDynamicSharedMemorySize, LDS_BYTES) != hipSuccess) { fprintf(stderr, "kernel_launch: hipFuncSetAttribute failed\n"); grid = -1; return; }
    if (hipOccupancyMaxActiveBlocksPerMultiprocessor(&per_cu, (const void*)mega, NTHR, LDS_BYTES) != hipSuccess || per_cu < 1) { fprintf(stderr, "kernel_launch: occupancy query says %d\n", per_cu); }
    (void)hipGetLastError();
    grid = cus;
  }
  if (grid < 0) return;
  (void)in_sizes;
  (void)hipMemsetAsync((char*)d_ws + WS_CTL, 0, CTL_BYTES, stream);
  Args a{};
  for (int i = 0; i < N_IN; ++i) a.in[i] = (const float*)d_in[i];
  a.out = (float*)d_out; a.ws = (unsigned char*)d_ws;
#if MK_ONE_LAUNCH
  a.ph_lo = 0; a.ph_hi = NPH;
  hipLaunchKernelGGL(mega, dim3(grid), dim3(NTHR), LDS_BYTES, stream, a);
#else
  for (int p = 0; p < NPH; ++p) { a.ph_lo = p; a.ph_hi = p + 1; hipLaunchKernelGGL(mega, dim3(grid), dim3(NTHR), LDS_BYTES, stream, a); }
#endif
}
```

```cpp
#include <hip/hip_runtime.h>
#include <cstdio>
#include <cstdint>

#ifndef MK_ONE_LAUNCH
#define MK_ONE_LAUNCH 1
#endif

namespace {
typedef unsigned short bf16_t;
typedef float f32x4 __attribute__((ext_vector_type(4)));
typedef unsigned u32x2 __attribute__((ext_vector_type(2)));
typedef unsigned u32x4 __attribute__((ext_vector_type(4)));

constexpr int T_ = 32768, S_ = 8192, NB_ = 4, D_ = 1024;
constexpr int NTHR = 512;
constexpr int LDS_BYTES = 147456;
constexpr int LDS_CTL = 131072;
constexpr float EPS_ = 1e-6f;

constexpr size_t al256(size_t x) { return (x + 255) / 256 * 256; }
constexpr size_t WS_CTL   = 0;
constexpr size_t CTL_BYTES = 65536;
constexpr size_t CW_CNT   = 16384;
constexpr size_t WS_MODP  = WS_CTL + CTL_BYTES;
constexpr size_t WS_MOD   = WS_MODP + al256((size_t)8 * 2 * 4 * 6144 * 4);
constexpr size_t WS_COS   = WS_MOD + al256((size_t)2 * 4 * 6144 * 4);
constexpr size_t WS_SIN   = WS_COS + (size_t)8192 * 16 * 4;
constexpr int P0LD = 1792;
constexpr size_t WS_WR    = WS_SIN + (size_t)8192 * 16 * 4;
constexpr size_t WS_WIN0  = WS_WR + (size_t)2 * 2 * 48 * 1024 * 2;
constexpr size_t WS_WQB   = WS_WIN0 + (size_t)P0LD * 1024 * 2;
constexpr size_t WS_WKVB  = WS_WQB + (size_t)768 * 512 * 2;
constexpr size_t WS_WOUT0 = WS_WKVB + (size_t)1024 * 256 * 2;
constexpr size_t WS_WIN1  = WS_WOUT0 + (size_t)1024 * 1024 * 2;
constexpr size_t WS_WOUT1 = WS_WIN1 + (size_t)3072 * 1024 * 2;
constexpr size_t WS_WUP   = WS_WOUT1 + (size_t)1024 * 1024 * 2;
constexpr size_t WS_WDN   = WS_WUP + (size_t)64 * 1024 * 1024 * 2;
constexpr size_t WS_HB    = WS_WDN + (size_t)64 * 1024 * 512 * 2;
constexpr size_t WS_GATEW = WS_HB + (size_t)T_ * 1024 * 2;
constexpr size_t WS_ROWSS = WS_GATEW + (size_t)T_ * 2 * 4;
constexpr size_t WS_LIST  = WS_ROWSS + (size_t)T_ * 16 * 4;
constexpr size_t WS_ARENA = WS_LIST + (size_t)32 * 65536 * 4;
constexpr size_t A_PROJ0 = WS_ARENA;
constexpr size_t A_CQN   = A_PROJ0 + (size_t)T_ * P0LD * 2;
constexpr size_t A_CKVN  = A_CQN + (size_t)T_ * 512 * 2;
constexpr size_t A_QG    = A_CKVN + (size_t)T_ * 256 * 2;
constexpr size_t A_KG    = A_QG + (size_t)T_ * 512 * 2;
constexpr size_t A_VG    = A_KG + (size_t)T_ * 128 * 2;
constexpr size_t A_QRAW  = A_VG + (size_t)T_ * 128 * 2;
constexpr size_t A_KVRAW = A_QRAW + (size_t)T_ * 768 * 2;
constexpr size_t A_QA    = A_KVRAW + (size_t)T_ * 1024 * 2;
constexpr size_t A_KA    = A_QA + (size_t)T_ * 1024 * 2;
constexpr size_t A_VA    = A_KA + (size_t)T_ * 1024 * 2;
constexpr size_t A_OB    = A_VA + (size_t)T_ * 512 * 2;
constexpr size_t A_END0  = A_OB + (size_t)T_ * 1024 * 2;
constexpr size_t A_ACT   = WS_ARENA;
constexpr size_t A_YB    = A_ACT + (size_t)(65536 + 256) * 512 * 2;
constexpr size_t A_ENDM  = A_YB + (size_t)T_ * 2 * 1024 * 2;
constexpr size_t A_QD    = WS_ARENA;
constexpr size_t A_KD    = A_QD + (size_t)T_ * 1024 * 2;
constexpr size_t A_VD    = A_KD + (size_t)T_ * 1024 * 2;
constexpr size_t A_PROJ1 = A_VD + (size_t)T_ * 1024 * 2;
constexpr size_t A_OD    = A_PROJ1;
constexpr size_t A_Q8D   = A_OD + (size_t)T_ * 1024 * 4;
constexpr size_t A_K8D   = A_Q8D + (size_t)T_ * 1024;
constexpr size_t A_VT8D  = A_K8D + (size_t)T_ * 1024;
constexpr size_t A_OB1   = A_OD + (size_t)T_ * 2048 * 4;
constexpr size_t A_END1  = A_OB1 + (size_t)T_ * 1024 * 2;
constexpr size_t WS_END  = (A_END0 > A_END1 ? (A_END0 > A_ENDM ? A_END0 : A_ENDM) : (A_END1 > A_ENDM ? A_END1 : A_ENDM));

enum { I_X = 0, I_C, I_ADAW, I_ADAB, I_NMIX, I_NFFN, I_RELB, I_ABWIN, I_ABQAN, I_ABWQB, I_ABKVAN, I_ABWKVB, I_MLAQN, I_MLAKN, I_GQAQN, I_GQAKN,
       I_ABWOUT, I_CWIN, I_CQN, I_CKN, I_LQ1, I_LK1, I_LQ2, I_LK2, I_SUBLN, I_CWOUT, I_WG, I_BG, I_WE, I_BE, I_WUP, I_WDN, N_IN };

struct Args { const float* in[N_IN]; float* out; unsigned char* ws; int ph_lo, ph_hi; };

__device__ __forceinline__ float bf2f(unsigned short h) { return __uint_as_float((unsigned)h << 16); }
__device__ __forceinline__ unsigned short f2bf(float f) { unsigned u = __float_as_uint(f); u += 0x7fffu + ((u >> 16) & 1u); return (unsigned short)(u >> 16); }
__device__ __forceinline__ unsigned pack2(float lo, float hi) { return (unsigned)f2bf(lo) | ((unsigned)f2bf(hi) << 16); }
__device__ __forceinline__ float bflo(unsigned w) { return __uint_as_float(w << 16); }
__device__ __forceinline__ float bfhi(unsigned w) { return __uint_as_float(w & 0xffff0000u); }
__device__ __forceinline__ float wave_sum(float v) {
#pragma unroll
  for (int o = 32; o >= 1; o >>= 1) v += __shfl_xor(v, o);
  return v;
}
__device__ __forceinline__ float siluf(float x) { return x / (1.f + __expf(-x)); }

#define XB_TMO      128
#define XB_XCNT(j)  (256  + 64 * (j))
#define XB_XSUB(j)  (1280 + 64 * (j))
#define XB_XGEN(j)  (2304 + 64 * (j))
#define XB_TOP      3328
#define XB_TOPGEN   3392
#define XCD_BAR_WORDS 3456
#define XB_SPIN_CAP (1u << 24)
#define LAS __attribute__((address_space(3)))

__device__ __forceinline__ unsigned xb_ld(unsigned* p)              { return __hip_atomic_load(p, __ATOMIC_RELAXED, __HIP_MEMORY_SCOPE_AGENT); }
__device__ __forceinline__ unsigned xb_add(unsigned* p, unsigned v) { return __hip_atomic_fetch_add(p, v, __ATOMIC_RELAXED, __HIP_MEMORY_SCOPE_AGENT); }
__device__ __forceinline__ unsigned xb_xcc_id() { return (unsigned)__builtin_amdgcn_s_getreg((3 << 11) | 20) & 0xFu; }
#define XB_SPIN(cond, bar) do { unsigned _sp = 0; while (cond) { __builtin_amdgcn_s_sleep(1); \
    if ((++_sp & 255u) == 0u) { if (xb_ld(&(bar)[XB_TMO])) break; if (_sp > XB_SPIN_CAP) { atomicAdd(&(bar)[XB_TMO], 1u); break; } } } } while (0)

struct XcdBarrier { unsigned* bar; unsigned x; volatile LAS unsigned* st; };

__device__ __forceinline__ XcdBarrier xcd_barrier_post(unsigned* bar, volatile LAS unsigned* st) {
    XcdBarrier b; b.bar = bar; b.x = xb_xcc_id(); b.st = st;
    if (threadIdx.x == 0) (void)xb_add(&bar[XB_XCNT(b.x)], 1u);
    return b;
}
__device__ __forceinline__ void xcd_barrier_complete(unsigned* bar, unsigned x, unsigned& nloc, unsigned& nx) {
    const unsigned G = gridDim.x * gridDim.y * gridDim.z;
    unsigned sum, cnt, mine, sp = 0u;
    for (;;) {
        sum = 0u; cnt = 0u; mine = 0u;
#pragma unroll
        for (unsigned j = 0; j < 16; ++j) { const unsigned c = xb_ld(&bar[XB_XCNT(j)]); sum += c; cnt += (c > 0u) ? 1u : 0u; mine = (j == x) ? c : mine; }
        if (sum == G) break;
        __builtin_amdgcn_s_sleep(1);
        if ((++sp & 255u) == 0u) { if (xb_ld(&bar[XB_TMO])) break; if (sp > XB_SPIN_CAP) { atomicAdd(&bar[XB_TMO], 1u); break; } }
    }
    nloc = mine > 0u ? mine : 1u; nx = cnt > 0u ? cnt : 1u;
}
__device__ __forceinline__ void xcd_barrier(const XcdBarrier& b) {
    asm volatile("s_waitcnt vmcnt(0)" ::: "memory");
    __syncthreads();
    if (threadIdx.x == 0) {
        unsigned* bar = b.bar;
        __builtin_amdgcn_s_waitcnt(0);
        unsigned nloc = b.st[0], nx = b.st[1];
        if (nloc == 0u) { xcd_barrier_complete(bar, b.x, nloc, nx); b.st[0] = nloc; b.st[1] = nx; }
        const unsigned old = xb_add(&bar[XB_XSUB(b.x)], 1u);
        const unsigned gen = old / nloc;
        if (old + 1u == (gen + 1u) * nloc) {
            __builtin_amdgcn_fence(__ATOMIC_RELEASE, "agent");
            asm volatile("s_waitcnt vmcnt(0)" ::: "memory");
            const unsigned og = xb_add(&bar[XB_TOP], 1u);
            const unsigned tg = og / nx;
            if (og + 1u == (tg + 1u) * nx) xb_add(&bar[XB_TOPGEN], 1u);
            else XB_SPIN(xb_ld(&bar[XB_TOPGEN]) == tg, bar);
            __builtin_amdgcn_fence(__ATOMIC_ACQUIRE, "agent");
            xb_add(&bar[XB_XGEN(b.x)], 1u);
            asm volatile("s_waitcnt vmcnt(0)" ::: "memory");
        } else {
            XB_SPIN(xb_ld(&bar[XB_XGEN(b.x)]) == gen, bar);
            __builtin_amdgcn_fence(__ATOMIC_ACQUIRE, "agent");
            asm volatile("s_waitcnt vmcnt(0)" ::: "memory");
        }
    }
    __syncthreads();
}

struct Frame {
  const float* in[N_IN]; float* out; unsigned char* ws; unsigned char* lds;
  int tid, lane, wave, G, bid;
};
#define WSP(T, off) ((T*)(F.ws + (off)))

__device__ __forceinline__ const float* modp(const Frame& F, int l, int b) { return WSP(const float, WS_MOD) + ((size_t)l * 4 + b) * 6144; }

__device__ __forceinline__ unsigned pk4_fp8(float a, float b, float c, float d) { int r = __builtin_amdgcn_cvt_pk_fp8_f32(a, b, 0, false); r = __builtin_amdgcn_cvt_pk_fp8_f32(c, d, r, true); return (unsigned)r; }
constexpr float MOE_WUP_SC = 64.f, MOE_WDN_SC = 32.f, MOE_ACT_SC = 4.f;
constexpr float INPROJ_W_SC = 64.f;
struct CvtJob { const float* src; bf16_t* dst; int K, Nsrc, k0, n0, perm; float f8s; };
__device__ __forceinline__ void cvt_fetch(const CvtJob& J, int tid, f32x4& v0, f32x4& v1) {
  const int r = tid >> 4, c4 = (tid & 15) * 4;
  v0 = f32x4{0.f, 0.f, 0.f, 0.f}; v1 = v0;
  if (J.n0 + c4 < J.Nsrc) {
    v0 = *(const f32x4*)(J.src + (size_t)(J.k0 + r) * J.Nsrc + J.n0 + c4);
    v1 = *(const f32x4*)(J.src + (size_t)(J.k0 + r + 32) * J.Nsrc + J.n0 + c4);
  }
}
__device__ __forceinline__ void cvt_put(const Frame& F, const f32x4& v0, const f32x4& v1) {
  float* tile = (float*)(F.lds + 1024);
  const int r = F.tid >> 4, c4 = (F.tid & 15) * 4;
  tile[r * 65 + c4 + 0] = v0[0]; tile[r * 65 + c4 + 1] = v0[1]; tile[r * 65 + c4 + 2] = v0[2]; tile[r * 65 + c4 + 3] = v0[3];
  tile[(r + 32) * 65 + c4 + 0] = v1[0]; tile[(r + 32) * 65 + c4 + 1] = v1[1]; tile[(r + 32) * 65 + c4 + 2] = v1[2]; tile[(r + 32) * 65 + c4 + 3] = v1[3];
}
__device__ __forceinline__ void cvt_emit(const Frame& F, const CvtJob& J) {
  const float* tile = (const float*)(F.lds + 1024);
  const int tid = F.tid;
  const int n = tid >> 3, kc = (tid & 7) * 8;
  int nd = J.n0 + n;
  if (J.perm) nd = (nd < 512) ? 2 * nd : 2 * (nd - 512) + 1;
  const float f8scale = J.f8s;
  if (f8scale > 0.f) {
    u32x2 w8; w8[0] = pk4_fp8(tile[(kc + 0) * 65 + n] * f8scale, tile[(kc + 1) * 65 + n] * f8scale, tile[(kc + 2) * 65 + n] * f8scale, tile[(kc + 3) * 65 + n] * f8scale);
    w8[1] = pk4_fp8(tile[(kc + 4) * 65 + n] * f8scale, tile[(kc + 5) * 65 + n] * f8scale, tile[(kc + 6) * 65 + n] * f8scale, tile[(kc + 7) * 65 + n] * f8scale);
    *(u32x2*)((unsigned char*)J.dst + (size_t)nd * J.K + J.k0 + kc) = w8;
  } else {
    u32x4 w;
    w[0] = pack2(tile[(kc + 0) * 65 + n], tile[(kc + 1) * 65 + n]);
    w[1] = pack2(tile[(kc + 2) * 65 + n], tile[(kc + 3) * 65 + n]);
    w[2] = pack2(tile[(kc + 4) * 65 + n], tile[(kc + 5) * 65 + n]);
    w[3] = pack2(tile[(kc + 6) * 65 + n], tile[(kc + 7) * 65 + n]);
    *(u32x4*)(J.dst + (size_t)nd * J.K + J.k0 + kc) = w;
  }
}

__device__ __forceinline__ void phase0(const Frame& F) {
  constexpr int J0 = 16 * 28, J1 = 8 * 12, J2 = 4 * 16, J3 = 16 * 16, J4 = 16 * 48, J5 = 16 * 16, J6 = 64 * 256, J7 = 64 * 128;
  constexpr int E0 = J0, E1 = E0 + J1, E2 = E1 + J2, E3 = E2 + J3, E4 = E3 + J4, E5 = E4 + J5, E6 = E5 + J6, E7 = E6 + J7;
  auto decode = [&](int u) -> CvtJob {
    const float* src; bf16_t* dst; int K, Nsrc, ntn, perm = 0, v; float f8s = 0.f;
    if (u < E0)      { v = u;      src = F.in[I_ABWIN];  dst = WSP(bf16_t, WS_WIN0);  K = 1024; Nsrc = 1568; ntn = 28; f8s = INPROJ_W_SC; }
    else if (u < E1) { v = u - E0; src = F.in[I_ABWQB];  dst = WSP(bf16_t, WS_WQB);   K = 512;  Nsrc = 768;  ntn = 12; }
    else if (u < E2) { v = u - E1; src = F.in[I_ABWKVB]; dst = WSP(bf16_t, WS_WKVB);  K = 256;  Nsrc = 1024; ntn = 16; }
    else if (u < E3) { v = u - E2; src = F.in[I_ABWOUT]; dst = WSP(bf16_t, WS_WOUT0); K = 1024; Nsrc = 1024; ntn = 16; }
    else if (u < E4) { v = u - E3; src = F.in[I_CWIN];   dst = WSP(bf16_t, WS_WIN1);  K = 1024; Nsrc = 3072; ntn = 48; f8s = INPROJ_W_SC; }
    else if (u < E5) { v = u - E4; src = F.in[I_CWOUT];  dst = WSP(bf16_t, WS_WOUT1); K = 1024; Nsrc = 1024; ntn = 16; }
    else if (u < E6) { v = u - E5; const int m = v >> 8; v &= 255; src = F.in[I_WUP] + (size_t)m * 1024 * 1024; dst = (bf16_t*)(WSP(unsigned char, WS_WUP) + (size_t)m * 1024 * 1024); K = 1024; Nsrc = 1024; ntn = 16; perm = 1; f8s = MOE_WUP_SC; }
    else             { v = u - E6; const int m = v >> 7; v &= 127; src = F.in[I_WDN] + (size_t)m * 512 * 1024;  dst = (bf16_t*)(WSP(unsigned char, WS_WDN) + (size_t)m * 1024 * 512);  K = 512;  Nsrc = 1024; ntn = 16; f8s = MOE_WDN_SC; }
    const int kt = v / ntn, nt = v % ntn;
    return CvtJob{src, dst, K, Nsrc, kt * 64, nt * 64, perm, f8s};
  };
  {
    int u = F.bid;
    CvtJob J = decode(u < E7 ? u : 0);
    f32x4 a0, a1;
    if (u < E7) cvt_fetch(J, F.tid, a0, a1);
    while (u < E7) {
      cvt_put(F, a0, a1);
      asm volatile("s_waitcnt lgkmcnt(0)\n\ts_barrier" ::: "memory");
      const CvtJob Jc = J;
      const int un = u + F.G;
      if (un < E7) { J = decode(un); cvt_fetch(J, F.tid, a0, a1); }
      cvt_emit(F, Jc);
      asm volatile("s_waitcnt lgkmcnt(0)\n\ts_barrier" ::: "memory");
      u = un;
    }
  }
  for (int i = F.bid * NTHR + F.tid; i < 2 * 48 * 1024; i += F.G * NTHR) {
    const int l = i / (48 * 1024), j = (i >> 10) % 48, k = i & 1023;
    float v = 0.f;
    if (j < 4) v = F.in[I_WG][((size_t)l * 1024 + k) * 4 + j];
    else if (j < 36) v = F.in[I_WE][(((size_t)l * 4 + ((j - 4) >> 3)) * 1024 + k) * 8 + ((j - 4) & 7)];
    const unsigned short hi = f2bf(v);
    WSP(unsigned short, WS_WR)[(size_t)(l * 2 + 0) * 48 * 1024 + j * 1024 + k] = hi;
    WSP(unsigned short, WS_WR)[(size_t)(l * 2 + 1) * 48 * 1024 + j * 1024 + k] = f2bf(v - bf2f(hi));
  }
  {
    float* sc = (float*)(F.lds + 1024);
    for (int u = F.bid; u < 192; u += F.G) {
      const int kc = u & 7, cb = (u >> 3) % 12, l = u / 96;
      __syncthreads();
      { const int b = F.tid >> 7, k = F.tid & 127; sc[F.tid] = siluf(F.in[I_C][b * 1024 + kc * 128 + k]); }
      __syncthreads();
      const int j = cb * 512 + F.tid;
      const float* w = F.in[I_ADAW] + ((size_t)l * 1024 + kc * 128) * 6144 + j;
      float a0 = 0.f, a1 = 0.f, a2 = 0.f, a3 = 0.f;
#pragma unroll 8
      for (int k = 0; k < 128; ++k) { const float wv = w[(size_t)k * 6144]; a0 += sc[k] * wv; a1 += sc[128 + k] * wv; a2 += sc[256 + k] * wv; a3 += sc[384 + k] * wv; }
      float* mp = WSP(float, WS_MODP) + ((size_t)kc * 2 + l) * 4 * 6144 + j;
      mp[0] = a0; mp[6144] = a1; mp[2 * 6144] = a2; mp[3 * 6144] = a3;
    }
  }
  for (int i = F.bid * NTHR + F.tid; i < 8192 * 16; i += F.G * NTHR) {
    const int pos = i >> 4, j = i & 15;
    const float inv = (float)pow(10000.0, -(double)j / 16.0);
    const float ang = (float)pos * inv;
    const double rev = (double)ang * 0.15915494309189533577;
    const float fr = (float)(rev - rint(rev));
    WSP(float, WS_COS)[i] = __builtin_amdgcn_cosf(fr);
    WSP(float, WS_SIN)[i] = __builtin_amdgcn_sinf(fr);
  }
}

__device__ __forceinline__ float mod_sum(const Frame& F, int l, int b, int idx) {
  float s = F.in[I_ADAB][l * 6144 + idx];
#pragma unroll
  for (int kc = 0; kc < 8; ++kc) s += WSP(const float, WS_MODP)[(((size_t)kc * 2 + l) * 4 + b) * 6144 + idx];
  return s;
}

template <int MODE>
__device__ __forceinline__ void phase_xnorm(const Frame& F, int l) {
  float* gs = (float*)(F.lds + 1024);
  float* sh = gs + 1024;
  float* g2 = sh + 1024;
  if (MODE == 0) {
    for (int i = F.bid * NTHR + F.tid; i < 2 * 4 * 6144; i += F.G * NTHR) {
      const int idx = i % 6144, b = (i / 6144) & 3, ll = i / (4 * 6144);
      WSP(float, WS_MOD)[i] = mod_sum(F, ll, b, idx);
    }
  }
  const float* Xin = (MODE == 0) ? F.in[I_X] : F.out;
  const bf16_t* YB = WSP(const bf16_t, A_YB);
  bf16_t* HB = WSP(bf16_t, WS_HB);
  int curb = -1;
  for (int u = F.bid; u < T_ / 64; u += F.G) {
    const int b = u >> 7;
    if (b != curb) {
      __syncthreads();
      for (int c = F.tid; c < 1024; c += NTHR) {
        if (MODE == 0) { gs[c] = F.in[I_NMIX][l * 1024 + c] * (1.f + mod_sum(F, l, b, 1024 + c)); sh[c] = mod_sum(F, l, b, c); }
        if (MODE == 1) { gs[c] = F.in[I_NMIX][l * 1024 + c] * (1.f + modp(F, l, b)[1024 + c]); sh[c] = modp(F, l, b)[c]; }
        if (MODE >= 1) g2[c] = modp(F, l - (MODE == 1 ? 1 : 0), b)[5120 + c];
      }
      __syncthreads(); curb = b;
    }
    for (int i = 0; i < 8; ++i) {
      const size_t t = (size_t)u * 64 + F.wave * 8 + i;
      f32x4 v[4];
#pragma unroll
      for (int k = 0; k < 4; ++k) v[k] = *(const f32x4*)(Xin + t * 1024 + k * 256 + F.lane * 4);
      if (MODE >= 1) {
#pragma unroll
        for (int k = 0; k < 4; ++k) {
          const int c = k * 256 + F.lane * 4;
          const u32x2 y0 = *(const u32x2*)(YB + (t * 2) * 1024 + c), y1 = *(const u32x2*)(YB + (t * 2 + 1) * 1024 + c);
          v[k][0] += g2[c + 0] * (bflo(y0[0]) + bflo(y1[0]));
          v[k][1] += g2[c + 1] * (bfhi(y0[0]) + bfhi(y1[0]));
          v[k][2] += g2[c + 2] * (bflo(y0[1]) + bflo(y1[1]));
          v[k][3] += g2[c + 3] * (bfhi(y0[1]) + bfhi(y1[1]));
          *(f32x4*)(F.out + t * 1024 + c) = v[k];
        }
      }
      if (MODE <= 1) {
        float ss = 0.f;
#pragma unroll
        for (int k = 0; k < 4; ++k) ss += v[k][0] * v[k][0] + v[k][1] * v[k][1] + v[k][2] * v[k][2] + v[k][3] * v[k][3];
        ss = wave_sum(ss);
        const float r = rsqrtf(ss * (1.f / 1024.f) + EPS_);
#pragma unroll
        for (int k = 0; k < 4; ++k) {
          const int c = k * 256 + F.lane * 4;
          const float h0 = v[k][0] * r * gs[c] + sh[c], h1 = v[k][1] * r * gs[c + 1] + sh[c + 1], h2 = v[k][2] * r * gs[c + 2] + sh[c + 2], h3 = v[k][3] * r * gs[c + 3] + sh[c + 3];
          *(unsigned*)((unsigned char*)HB + t * 1024 + c) = pk4_fp8(h0, h1, h2, h3);
        }
      }
    }
  }
}

__device__ __forceinline__ float gain_absmax(const Frame& F, const float* g, int n) {
  float* red = (float*)(F.lds + LDS_CTL + 1024);
  float m = 0.f;
  for (int i = F.tid; i < n; i += NTHR) m = fmaxf(m, fabsf(g[i]));
#pragma unroll
  for (int o = 32; o >= 1; o >>= 1) m = fmaxf(m, __shfl_xor(m, o));
  __syncthreads();
  if (F.lane == 0) red[F.wave] = m;
  __syncthreads();
  float r = red[0];
#pragma unroll
  for (int w = 1; w < 8; ++w) r = fmaxf(r, red[w]);
  return r;
}
constexpr float LOG2E = 1.4426950408889634f;
constexpr float PP_BF8 = 20.f;
constexpr float PP_BOUND = 60.f;


__device__ __forceinline__ int vt_pos(int tau) { const int kq = tau & 31, i = kq >> 3, r = kq & 7; return (tau & 32) + ((r < 4) ? (4 * i + r) : (16 + 4 * i + (r - 4))); }
__device__ __forceinline__ int vt_pos0(int tau) { return 32 * ((tau >> 2) & 1) + 16 * (tau >> 5) + 4 * ((tau & 31) >> 3) + (tau & 3); }
__device__ __forceinline__ float pp_mla_bound(const Frame& F) { return 9.797959f * gain_absmax(F, F.in[I_MLAQN], 96) * gain_absmax(F, F.in[I_MLAKN], 96) * LOG2E * 1.04f; }
__device__ __forceinline__ bool pp_mla_ok(const Frame& F) { return pp_mla_bound(F) <= PP_BF8; }
__device__ __forceinline__ float pp_diff_bound(const Frame& F) { return (8.f * gain_absmax(F, F.in[I_CQN], 128) * gain_absmax(F, F.in[I_CKN], 128) * 1.04f + gain_absmax(F, F.in[I_RELB], 256)) * LOG2E; }
constexpr float PP_F16 = 15.9f;
__device__ __forceinline__ bool pp_diff_ok(const Frame& F) { return pp_diff_bound(F) <= PP_F16; }
__device__ __forceinline__ float pp_gqa_bound(const Frame& F) { return 8.f * gain_absmax(F, F.in[I_GQAQN], 64) * gain_absmax(F, F.in[I_GQAKN], 64) * LOG2E * 1.04f; }
__device__ __forceinline__ bool pp_gqa_ok(const Frame& F) { return pp_gqa_bound(F) <= PP_BF8; }

__device__ __forceinline__ void phase_split0(const Frame& F) {
  const bf16_t* PROJ = WSP(const bf16_t, A_PROJ0);
  bf16_t* CQN = WSP(bf16_t, A_CQN); bf16_t* CKVN = WSP(bf16_t, A_CKVN);
  bf16_t* QG = WSP(bf16_t, A_QG); bf16_t* KG = WSP(bf16_t, A_KG); bf16_t* VG = WSP(bf16_t, A_VG);
  unsigned char* QG8 = WSP(unsigned char, A_QG); unsigned char* KG8 = WSP(unsigned char, A_KG); unsigned char* VGT8 = WSP(unsigned char, A_VG);
  const float* COS = WSP(const float, WS_COS); const float* SIN = WSP(const float, WS_SIN);
  const int lane = F.lane;
  const bool pp = pp_gqa_ok(F);
  unsigned char* vt = F.lds + 1024;
  for (int u = F.bid; u < T_ / 64; u += F.G) {
   for (int tb = 0; tb < 8; tb += 4) {
    u32x4 Lcq[4], Lgq[4], Lgk[4], Lgv[4]; u32x2 Lckv[4]; float Lcs[4][8], Lsn[4][8];
#pragma unroll
    for (int k = 0; k < 4; ++k) {
      const int t = u * 64 + F.wave * 8 + tb + k, s = t & 8191;
      const bf16_t* row = PROJ + (size_t)t * P0LD;
      Lcq[k] = *(const u32x4*)(row + lane * 8);
      Lckv[k] = *(const u32x2*)(row + 512 + lane * 4);
      Lgq[k] = *(const u32x4*)(row + 800 + lane * 8);
      Lgk[k] = u32x4{0u, 0u, 0u, 0u}; Lgv[k] = u32x4{0u, 0u, 0u, 0u};
      if (lane < 16) { Lgk[k] = *(const u32x4*)(row + 1312 + lane * 8); Lgv[k] = *(const u32x4*)(row + 1440 + lane * 8); }
      const int pos = ((lane & 7) < 4) ? (s >> 6) : (s & 63), jb = (lane & 1) * 8;
#pragma unroll
      for (int i = 0; i < 8; ++i) { Lcs[k][i] = COS[pos * 16 + jb + i]; Lsn[k][i] = SIN[pos * 16 + jb + i]; }
    }
#pragma unroll
    for (int k = 0; k < 4; ++k) {
    const int ti = tb + k;
    const int tau = F.wave * 8 + ti, t = u * 64 + tau;
    const int b = t >> 13, s = t & 8191;
    {
      const u32x4 w = Lcq[k];
      float x[8] = {bflo(w[0]), bfhi(w[0]), bflo(w[1]), bfhi(w[1]), bflo(w[2]), bfhi(w[2]), bflo(w[3]), bfhi(w[3])};
      float ss = 0.f;
#pragma unroll
      for (int i = 0; i < 8; ++i) ss += x[i] * x[i];
      ss = wave_sum(ss);
      const float r = rsqrtf(ss * (1.f / 512.f) + EPS_);
      const float* g = F.in[I_ABQAN] + lane * 8;
      u32x4 o;
#pragma unroll
      for (int i = 0; i < 4; ++i) o[i] = pack2(x[2 * i] * r * g[2 * i], x[2 * i + 1] * r * g[2 * i + 1]);
      *(u32x4*)(CQN + (size_t)t * 512 + lane * 8) = o;
    }
    {
      const u32x2 w = Lckv[k];
      float x[4] = {bflo(w[0]), bfhi(w[0]), bflo(w[1]), bfhi(w[1])};
      float ss = x[0] * x[0] + x[1] * x[1] + x[2] * x[2] + x[3] * x[3];
      ss = wave_sum(ss);
      const float r = rsqrtf(ss * (1.f / 256.f) + EPS_);
      const float* g = F.in[I_ABKVAN] + lane * 4;
      u32x2 o; o[0] = pack2(x[0] * r * g[0], x[1] * r * g[1]); o[1] = pack2(x[2] * r * g[2], x[3] * r * g[3]);
      *(u32x2*)(CKVN + (size_t)t * 256 + lane * 4) = o;
    }
#pragma unroll
    for (int which = 0; which < 2; ++which) {
      const bool act = (which == 0) || (lane < 16);
      const u32x4 w = (which == 0) ? Lgq[k] : Lgk[k];
      float x[8] = {bflo(w[0]), bfhi(w[0]), bflo(w[1]), bfhi(w[1]), bflo(w[2]), bfhi(w[2]), bflo(w[3]), bfhi(w[3])};
      float ss = 0.f;
#pragma unroll
      for (int i = 0; i < 8; ++i) ss += x[i] * x[i];
      ss += __shfl_xor(ss, 1); ss += __shfl_xor(ss, 2); ss += __shfl_xor(ss, 4);
      const float r = rsqrtf(ss * (1.f / 64.f) + EPS_);
      const int ch = lane & 7;
      const float* g = F.in[which == 0 ? I_GQAQN : I_GQAKN] + ch * 8;
#pragma unroll
      for (int i = 0; i < 8; ++i) x[i] = x[i] * r * g[i];
      const bool second = (ch & 2) != 0;
      float y[8];
#pragma unroll
      for (int i = 0; i < 8; ++i) {
        const float p = __shfl_xor(x[i], 2);
        const float cs = Lcs[k][i], sn = Lsn[k][i];
        y[i] = second ? (x[i] * cs + p * sn) : (x[i] * cs - p * sn);
      }
      const float qs = (which == 0) ? (0.125f * 1.4426950408889634f * (pp ? 8.f : 1.f)) : 1.f;
      const int hd = lane >> 3;
      if (pp) {
        u32x2 o; o[0] = pk4_fp8(y[0] * qs, y[1] * qs, y[2] * qs, y[3] * qs); o[1] = pk4_fp8(y[4] * qs, y[5] * qs, y[6] * qs, y[7] * qs);
        if (act) {
          if (which == 0) *(u32x2*)(QG8 + (((size_t)b * 8 + hd) * S_ + s) * 64 + ch * 8) = o;
          else            *(u32x2*)(KG8 + (((size_t)b * 2 + hd) * S_ + s) * 64 + ch * 8) = o;
        }
      } else {
        u32x4 o;
#pragma unroll
        for (int i = 0; i < 4; ++i) o[i] = pack2(y[2 * i] * qs, y[2 * i + 1] * qs);
        if (act) {
          if (which == 0) *(u32x4*)(QG + (((size_t)b * 8 + hd) * S_ + s) * 64 + ch * 8) = o;
          else            *(u32x4*)(KG + (((size_t)b * 2 + hd) * S_ + s) * 64 + ch * 8) = o;
        }
      }
    }
    if (lane < 16) {
      const u32x4 w = Lgv[k];
      if (pp) {
        const unsigned a = pk4_fp8(bflo(w[0]), bfhi(w[0]), bflo(w[1]), bfhi(w[1])), c = pk4_fp8(bflo(w[2]), bfhi(w[2]), bflo(w[3]), bfhi(w[3]));
        unsigned char* dst = vt + ((lane >> 3) * 64 + (lane & 7) * 8) * 64 + vt_pos0(tau);
        dst[0 * 64] = (unsigned char)a; dst[1 * 64] = (unsigned char)(a >> 8); dst[2 * 64] = (unsigned char)(a >> 16); dst[3 * 64] = (unsigned char)(a >> 24);
        dst[4 * 64] = (unsigned char)c; dst[5 * 64] = (unsigned char)(c >> 8); dst[6 * 64] = (unsigned char)(c >> 16); dst[7 * 64] = (unsigned char)(c >> 24);
      } else {
        *(u32x4*)(VG + (((size_t)b * 2 + (lane >> 3)) * S_ + s) * 64 + (lane & 7) * 8) = w;
      }
    }
    }
   }
   if (pp) {
     __syncthreads();
     const int t0 = u * 64, b = t0 >> 13, s0 = t0 & 8191, rid = F.tid >> 2, chk = F.tid & 3;
     *(u32x4*)(VGT8 + ((size_t)(b * 2 * 64 + rid)) * S_ + s0 + chk * 16) = *(const u32x4*)(vt + rid * 64 + chk * 16);
     __syncthreads();
   }
  }
}

__device__ __forceinline__ void phase_mla(const Frame& F) {
  const bf16_t* PROJ = WSP(const bf16_t, A_PROJ0);
  const bf16_t* QRAW = WSP(const bf16_t, A_QRAW); const bf16_t* KVRAW = WSP(const bf16_t, A_KVRAW);
  bf16_t* QA = WSP(bf16_t, A_QA); bf16_t* KA = WSP(bf16_t, A_KA); bf16_t* VA = WSP(bf16_t, A_VA);
  unsigned char* QA8 = WSP(unsigned char, A_QA); unsigned char* KA8 = WSP(unsigned char, A_KA); unsigned char* VAT8 = WSP(unsigned char, A_VA);
  const float* COS = WSP(const float, WS_COS); const float* SIN = WSP(const float, WS_SIN);
  const int lane = F.lane, hd = lane >> 3, ch = lane & 7;
  const bool pp = pp_mla_ok(F);
  unsigned char* vt = F.lds + 1024;
  for (int u = F.bid; u < T_ / 64; u += F.G) {
   for (int tb = 0; tb < 8; tb += 4) {
    u32x4 Lq[4], Lkv[4], Lv[4]; u32x2 Lqr[4], Lkr[4]; float Lcs[4][4], Lsn[4][4];
#pragma unroll
    for (int k = 0; k < 4; ++k) {
      const int t = u * 64 + F.wave * 8 + tb + k, s = t & 8191;
      Lq[k] = *(const u32x4*)(QRAW + (size_t)t * 768 + hd * 96 + ch * 8);
      Lqr[k] = *(const u32x2*)(QRAW + (size_t)t * 768 + hd * 96 + 64 + ch * 4);
      Lkv[k] = *(const u32x4*)(KVRAW + (size_t)t * 1024 + hd * 128 + ch * 8);
      Lkr[k] = *(const u32x2*)(PROJ + (size_t)t * P0LD + 768 + ch * 4);
      Lv[k] = *(const u32x4*)(KVRAW + (size_t)t * 1024 + hd * 128 + 64 + ch * 8);
#pragma unroll
      for (int i = 0; i < 4; ++i) { Lcs[k][i] = COS[s * 16 + (ch & 3) * 4 + i]; Lsn[k][i] = SIN[s * 16 + (ch & 3) * 4 + i]; }
    }
#pragma unroll
    for (int k = 0; k < 4; ++k) {
    const int ti = tb + k;
    const int tau = F.wave * 8 + ti, t = u * 64 + tau;
    const int b = t >> 13, s = t & 8191;
#pragma unroll
    for (int which = 0; which < 2; ++which) {
      float xn[8], xr[4];
      if (which == 0) {
        const u32x4 w = Lq[k];
        const u32x2 v = Lqr[k];
        xn[0] = bflo(w[0]); xn[1] = bfhi(w[0]); xn[2] = bflo(w[1]); xn[3] = bfhi(w[1]); xn[4] = bflo(w[2]); xn[5] = bfhi(w[2]); xn[6] = bflo(w[3]); xn[7] = bfhi(w[3]);
        xr[0] = bflo(v[0]); xr[1] = bfhi(v[0]); xr[2] = bflo(v[1]); xr[3] = bfhi(v[1]);
      } else {
        const u32x4 w = Lkv[k];
        const u32x2 v = Lkr[k];
        xn[0] = bflo(w[0]); xn[1] = bfhi(w[0]); xn[2] = bflo(w[1]); xn[3] = bfhi(w[1]); xn[4] = bflo(w[2]); xn[5] = bfhi(w[2]); xn[6] = bflo(w[3]); xn[7] = bfhi(w[3]);
        xr[0] = bflo(v[0]); xr[1] = bfhi(v[0]); xr[2] = bflo(v[1]); xr[3] = bfhi(v[1]);
      }
      float ss = 0.f;
#pragma unroll
      for (int i = 0; i < 8; ++i) ss += xn[i] * xn[i];
#pragma unroll
      for (int i = 0; i < 4; ++i) ss += xr[i] * xr[i];
      ss += __shfl_xor(ss, 1); ss += __shfl_xor(ss, 2); ss += __shfl_xor(ss, 4);
      const float r = rsqrtf(ss * (1.f / 96.f) + EPS_);
      const float* g = F.in[which == 0 ? I_MLAQN : I_MLAKN];
#pragma unroll
      for (int i = 0; i < 8; ++i) xn[i] = xn[i] * r * g[ch * 8 + i];
#pragma unroll
      for (int i = 0; i < 4; ++i) xr[i] = xr[i] * r * g[64 + ch * 4 + i];
      const bool second = (ch & 4) != 0;
      float y[4];
#pragma unroll
      for (int i = 0; i < 4; ++i) {
        const float p = __shfl_xor(xr[i], 4);
        const float cs = Lcs[k][i], sn = Lsn[k][i];
        y[i] = second ? (xr[i] * cs + p * sn) : (xr[i] * cs - p * sn);
      }
      const float qs = (which == 0) ? (0.10206207261596575f * 1.4426950408889634f * (pp ? 8.f : 1.f)) : 1.f;
      if (pp) {
        unsigned char* dst = (which == 0 ? QA8 : KA8) + (((size_t)b * 8 + hd) * S_ + s) * 128;
        u32x2 o; o[0] = pk4_fp8(xn[0] * qs, xn[1] * qs, xn[2] * qs, xn[3] * qs); o[1] = pk4_fp8(xn[4] * qs, xn[5] * qs, xn[6] * qs, xn[7] * qs);
        *(u32x2*)(dst + ch * 8) = o;
        *(unsigned*)(dst + 64 + ch * 4) = pk4_fp8(y[0] * qs, y[1] * qs, y[2] * qs, y[3] * qs);
        *(unsigned*)(dst + 96 + ch * 4) = 0u;
      } else {
        bf16_t* dst = (which == 0 ? QA : KA) + (((size_t)b * 8 + hd) * S_ + s) * 128;
        u32x4 o;
#pragma unroll
        for (int i = 0; i < 4; ++i) o[i] = pack2(xn[2 * i] * qs, xn[2 * i + 1] * qs);
        *(u32x4*)(dst + ch * 8) = o;
        u32x2 o2; o2[0] = pack2(y[0] * qs, y[1] * qs); o2[1] = pack2(y[2] * qs, y[3] * qs);
        *(u32x2*)(dst + 64 + ch * 4) = o2;
        u32x2 z; z[0] = 0u; z[1] = 0u;
        *(u32x2*)(dst + 96 + ch * 4) = z;
      }
    }
    {
      const u32x4 w = Lv[k];
      if (pp) {
        const unsigned a = pk4_fp8(bflo(w[0]), bfhi(w[0]), bflo(w[1]), bfhi(w[1])), c = pk4_fp8(bflo(w[2]), bfhi(w[2]), bflo(w[3]), bfhi(w[3]));
        unsigned char* dst = vt + (hd * 64 + ch * 8) * 64 + vt_pos0(tau);
        dst[0 * 64] = (unsigned char)a; dst[1 * 64] = (unsigned char)(a >> 8); dst[2 * 64] = (unsigned char)(a >> 16); dst[3 * 64] = (unsigned char)(a >> 24);
        dst[4 * 64] = (unsigned char)c; dst[5 * 64] = (unsigned char)(c >> 8); dst[6 * 64] = (unsigned char)(c >> 16); dst[7 * 64] = (unsigned char)(c >> 24);
      } else {
        *(u32x4*)(VA + (((size_t)b * 8 + hd) * S_ + s) * 64 + ch * 8) = w;
      }
    }
    }
   }
   if (pp) {
     __syncthreads();
     const int t0 = u * 64, b = t0 >> 13, s0 = t0 & 8191;
#pragma unroll
     for (int q = 0; q < 4; ++q) { const int idx = F.tid + q * NTHR, rid = idx >> 2, chk = idx & 3;
       *(u32x4*)(VAT8 + ((size_t)(b * 8 * 64 + rid)) * S_ + s0 + chk * 16) = *(const u32x4*)(vt + rid * 64 + chk * 16); }
     __syncthreads();
   }
  }
}


__device__ __forceinline__ void phase_vt1(const Frame& F) {
  const bf16_t* VD = WSP(const bf16_t, A_VD);
  unsigned char* VT = WSP(unsigned char, A_VT8D);
  unsigned char* vt = F.lds + 1024;
  for (int u = F.bid; u < 32 * 128; u += F.G) {
    const int bh = u >> 7, s0 = (u & 127) * 64;
#pragma unroll
    for (int q = 0; q < 2; ++q) {
      const int idx = F.tid + q * NTHR, tau = idx >> 4, c8 = (idx & 15) * 8;
      const u32x4 w = *(const u32x4*)(VD + ((size_t)bh * S_ + s0 + tau) * 128 + c8);
      const unsigned a = pk4_fp8(bflo(w[0]), bfhi(w[0]), bflo(w[1]), bfhi(w[1])), c = pk4_fp8(bflo(w[2]), bfhi(w[2]), bflo(w[3]), bfhi(w[3]));
      unsigned char* dst = vt + c8 * 64 + vt_pos0(tau);
      dst[0 * 64] = (unsigned char)a; dst[1 * 64] = (unsigned char)(a >> 8); dst[2 * 64] = (unsigned char)(a >> 16); dst[3 * 64] = (unsigned char)(a >> 24);
      dst[4 * 64] = (unsigned char)c; dst[5 * 64] = (unsigned char)(c >> 8); dst[6 * 64] = (unsigned char)(c >> 16); dst[7 * 64] = (unsigned char)(c >> 24);
    }
    __syncthreads();
    { const int rid = F.tid >> 2, chk = F.tid & 3;
      *(u32x4*)(VT + ((size_t)bh * 128 + rid) * S_ + s0 + chk * 16) = *(const u32x4*)(vt + rid * 64 + chk * 16); }
    __syncthreads();
  }
}

__device__ __forceinline__ void phase_route(const Frame& F, int l) {
  typedef short bf16x8_t __attribute__((ext_vector_type(8)));
  constexpr int KC = 128, LDX = KC + 8;
  float* gs = (float*)(F.lds + 1024);
  float* sh = gs + 1024;
  float* rs = sh + 1024;
  bf16_t* XH = (bf16_t*)(rs + 64);
  bf16_t* XL = XH + 64 * LDX;
  bf16_t* WH = XL + 64 * LDX;
  bf16_t* WL = WH + 48 * LDX;
  float* lg = (float*)(WL + 48 * LDX);
  int* cnt = (int*)(lg + 64 * 49);
  int* base = cnt + 32;
  unsigned char* HB8 = WSP(unsigned char, WS_HB);
  const float* X = F.out;
  unsigned* COUNT = (unsigned*)(F.ws + WS_CTL + CW_CNT) + l * 32;
  int* LIST = WSP(int, WS_LIST); float* GATEW = WSP(float, WS_GATEW);
  const int lane = F.lane, mb = F.wave & 3, nb0 = (F.wave >> 2) ? 2 : 0, nnb = (F.wave >> 2) ? 1 : 2;
  int curb = -1;
  const bf16_t* WRg = WSP(const bf16_t, WS_WR) + (size_t)l * 2 * 48 * 1024;
  for (int u = F.bid; u < T_ / 64; u += F.G) {
    const int b = u >> 7;
    __syncthreads();
    if (b != curb) {
      for (int c = F.tid; c < 1024; c += NTHR) { gs[c] = F.in[I_NFFN][l * 1024 + c] * (1.f + modp(F, l, b)[4096 + c]); sh[c] = modp(F, l, b)[3072 + c]; }
      curb = b;
    }
    if (F.tid < 32) cnt[F.tid] = 0;
    if (F.tid < 64) {
      const float* sp = WSP(const float, WS_ROWSS) + ((size_t)u * 64 + F.tid) * 16;
      float ss = 0.f;
#pragma unroll
      for (int q = 0; q < 4; ++q) { const f32x4 v = *(const f32x4*)(sp + 4 * q); ss += v[0]; ss += v[1]; ss += v[2]; ss += v[3]; }
      rs[F.tid] = rsqrtf(ss * (1.f / 1024.f) + EPS_);
    }
    f32x4 acc[2] = {{0.f, 0.f, 0.f, 0.f}, {0.f, 0.f, 0.f, 0.f}};
    u32x4 wpre[3]; f32x4 xpre[4];
#define RT_FETCH(kc_) do { \
      _Pragma("unroll") for (int q = 0; q < 3; ++q) { const int idx = F.tid + NTHR * q, img = idx / 768, rem = idx % 768, row = rem >> 4, seg = rem & 15; \
        wpre[q] = *(const u32x4*)(WRg + ((size_t)img * 48 + row) * 1024 + (kc_) * KC + seg * 8); } \
      _Pragma("unroll") for (int i = 0; i < 4; ++i) { const int tl = F.wave * 8 + 2 * i + (lane >> 5); \
        xpre[i] = *(const f32x4*)(X + ((size_t)u * 64 + tl) * 1024 + (kc_) * KC + (lane & 31) * 4); } } while (0)
    RT_FETCH(0);
    for (int kc = 0; kc < 1024 / KC; ++kc) {
      __syncthreads();
#pragma unroll
      for (int q = 0; q < 3; ++q) { const int idx = F.tid + NTHR * q, img = idx / 768, rem = idx % 768, row = rem >> 4, seg = rem & 15;
        *(u32x4*)((img ? WL : WH) + row * LDX + seg * 8) = wpre[q]; }
#pragma unroll
      for (int i = 0; i < 4; ++i) {
        const int tl = F.wave * 8 + 2 * i + (lane >> 5); const size_t t = (size_t)u * 64 + tl;
        const int cl = (lane & 31) * 4, c = kc * KC + cl;
        const f32x4 v = xpre[i];
        const float r = rs[tl];
        const float h0 = v[0] * r * gs[c] + sh[c], h1 = v[1] * r * gs[c + 1] + sh[c + 1], h2 = v[2] * r * gs[c + 2] + sh[c + 2], h3 = v[3] * r * gs[c + 3] + sh[c + 3];
        u32x2 w; w[0] = pack2(h0, h1); w[1] = pack2(h2, h3);
        *(unsigned*)(HB8 + t * 1024 + c) = pk4_fp8(h0, h1, h2, h3);
        *(u32x2*)(XH + tl * LDX + cl) = w;
        u32x2 wl; wl[0] = pack2(h0 - bflo(w[0]), h1 - bfhi(w[0])); wl[1] = pack2(h2 - bflo(w[1]), h3 - bfhi(w[1]));
        *(u32x2*)(XL + tl * LDX + cl) = wl;
      }
      if (kc + 1 < 1024 / KC) RT_FETCH(kc + 1);
      __syncthreads();
#pragma unroll
      for (int ks = 0; ks < KC / 32; ++ks) {
        const int xo = (mb * 16 + (lane & 15)) * LDX + ks * 32 + 8 * (lane >> 4);
        const bf16x8_t ah = *(const bf16x8_t*)(XH + xo), al = *(const bf16x8_t*)(XL + xo);
#pragma unroll
        for (int q = 0; q < 2; ++q) if (q < nnb) {
          const int wo = ((nb0 + q) * 16 + (lane & 15)) * LDX + ks * 32 + 8 * (lane >> 4);
          const bf16x8_t bh = *(const bf16x8_t*)(WH + wo), bl = *(const bf16x8_t*)(WL + wo);
          acc[q] = __builtin_amdgcn_mfma_f32_16x16x32_bf16(ah, bh, acc[q], 0, 0, 0);
          acc[q] = __builtin_amdgcn_mfma_f32_16x16x32_bf16(ah, bl, acc[q], 0, 0, 0);
          acc[q] = __builtin_amdgcn_mfma_f32_16x16x32_bf16(al, bh, acc[q], 0, 0, 0);
        }
      }
    }
#undef RT_FETCH
#pragma unroll
    for (int q = 0; q < 2; ++q) if (q < nnb) {
#pragma unroll
      for (int r = 0; r < 4; ++r) lg[(mb * 16 + 4 * (lane >> 4) + r) * 49 + (nb0 + q) * 16 + (lane & 15)] = acc[q][r];
    }
    __syncthreads();
    int e0 = 0, e1 = 0, i0 = 0, i1 = 0; float w0 = 0.f, w1 = 0.f;
    if (F.tid < 64) {
      const float* L = lg + F.tid * 49;
      const float* bg = F.in[I_BG] + l * 4; const float* be = F.in[I_BE] + l * 32;
      float gl[4]; int g = 0; float gm;
#pragma unroll
      for (int j = 0; j < 4; ++j) gl[j] = L[j] + bg[j];
      gm = gl[0];
#pragma unroll
      for (int j = 1; j < 4; ++j) if (gl[j] > gm) { gm = gl[j]; g = j; }
      float gsum = 0.f;
#pragma unroll
      for (int j = 0; j < 4; ++j) gsum += __expf(gl[j] - gm);
      const float pg = 1.f / gsum;
      float el[8];
#pragma unroll
      for (int j = 0; j < 8; ++j) el[j] = L[4 + g * 8 + j] + be[g * 8 + j];
      int a0 = 0; float m0 = el[0];
#pragma unroll
      for (int j = 1; j < 8; ++j) if (el[j] > m0) { m0 = el[j]; a0 = j; }
      int a1 = -1; float m1 = -3.0e38f;
#pragma unroll
      for (int j = 0; j < 8; ++j) if (j != a0 && el[j] > m1) { m1 = el[j]; a1 = j; }
      const float ex = __expf(m1 - m0);
      w0 = pg / (1.f + ex); w1 = pg * ex / (1.f + ex);
      e0 = g * 8 + a0; e1 = g * 8 + a1;
      i0 = atomicAdd(&cnt[e0], 1); i1 = atomicAdd(&cnt[e1], 1);
    }
    __syncthreads();
    if (F.tid < 32) base[F.tid] = (int)__hip_atomic_fetch_add(COUNT + F.tid, (unsigned)cnt[F.tid], __ATOMIC_RELAXED, __HIP_MEMORY_SCOPE_AGENT);
    __syncthreads();
    if (F.tid < 64) {
      const int t = u * 64 + F.tid;
      LIST[(size_t)e0 * 65536 + base[e0] + i0] = t * 2;
      LIST[(size_t)e1 * 65536 + base[e1] + i1] = t * 2 + 1;
      GATEW[t * 2] = w0; GATEW[t * 2 + 1] = w1;
    }
  }
}


namespace pg {
typedef short bf16x8 __attribute__((ext_vector_type(8)));
typedef int i32x4_t __attribute__((ext_vector_type(4)));
typedef int i32x8_t __attribute__((ext_vector_type(8)));
constexpr int BM = 256, BK = 64, HALF = 128, HTB = HALF * BK * 2, STAGE_BYTES = 8 * HTB, NXCD = 8, WGM = 8;
__device__ __forceinline__ int lds_byte(int r, int c) { const int st = (r >> 4) * 2 + (c >> 5), rr = r & 15, cc = c & 31, ob = rr * 64 + cc * 2; return st * 1024 + (ob ^ (((ob >> 9) & 1) << 5)); }
__device__ __forceinline__ void stage_rc(int b, int& R, int& C) { const int st = b / 1024, sb = b % 1024, swz = sb ^ (((sb >> 9) & 1) << 5); R = (st >> 1) * 16 + swz / 64; C = (st & 1) * 32 + (swz % 64) / 2; }
__device__ __forceinline__ int perm32(int rho) { const int n = rho >> 4, i = rho & 15; return 8 * (i >> 2) + 4 * n + (i & 3); }
__device__ __forceinline__ unsigned cvt_pk_bf16(float lo, float hi) { unsigned r; asm volatile("v_cvt_pk_bf16_f32 %0, %1, %2" : "=v"(r) : "v"(lo), "v"(hi)); return r; }

struct GUnit { const char* A; const char* B; const int* lst; int row0, col0, nrow, e; };

struct DenseOrder {
  const char* A; const char* Bt; int K, nM, nN, nwg, G, c;
  __device__ void init(const bf16_t* A_, const bf16_t* Bt_, int M, int N, int K_, int G_, int c_) { A = (const char*)A_; Bt = (const char*)Bt_; K = K_; nM = M / BM; nN = N / BM; nwg = nM * nN; G = G_; c = c_; }
  __device__ __forceinline__ bool next(int i, GUnit& u) const {
    const long L = (long)i * G + c; if (L >= nwg) return false;
    int wgid = (int)L; { const int q = nwg / NXCD, r = nwg % NXCD, xcd = wgid % NXCD, off = wgid / NXCD; wgid = (xcd < r ? xcd * (q + 1) : r * (q + 1) + (xcd - r) * q) + off; }
    const int nig = WGM * nN, gid = wgid / nig, fm = gid * WGM, gsz = (nM - fm) < WGM ? (nM - fm) : WGM;
    const int pm = fm + ((wgid % nig) % gsz), pn = (wgid % nig) / gsz;
    u.A = A + (size_t)pm * BM * K * 2; u.B = Bt + (size_t)pn * BM * K * 2; u.lst = nullptr; u.row0 = pm * BM; u.col0 = pn * BM; u.nrow = BM; u.e = 0;
    return true;
  }
};
struct MoeOrder {
  const int* tstart; const int* sbase; const int* cntl; const char* Abase; const char* Wbase; const int* LIST; int K, G, c, up;
  __device__ __forceinline__ bool next(int i, GUnit& u) const {
    const int L = i * G + c; if (L >= tstart[32] * 4) return false;
    const int rtg = L >> 2, pn = L & 3;
    int e = 0; while (tstart[e + 1] <= rtg) ++e;
    const int rt = rtg - tstart[e];
    u.e = e; u.nrow = cntl[e] - rt * BM; if (u.nrow > BM) u.nrow = BM;
    u.lst = LIST + (size_t)e * 65536 + rt * BM; u.row0 = sbase[e] + rt * BM; u.col0 = pn * BM;
    u.A = up ? Abase : Abase + (size_t)u.row0 * K * 2;
    u.B = Wbase + ((size_t)e * 1024 + pn * BM) * K * 2;
    return true;
  }
};

struct EpiStoreBf16 {
  static constexpr bool PERM = true;
  bf16_t* O; int ldc;
  __device__ __forceinline__ void operator()(const f32x4 (&acc)[2][2][4][2], const GUnit& u, int wr, int wc, int fr, int fq) const {
#pragma unroll
    for (int ai = 0; ai < 2; ++ai)
#pragma unroll
      for (int m = 0; m < 4; ++m) { bf16_t* rowp = O + (size_t)(u.row0 + ai * HALF + wr * 64 + m * 16 + fr) * ldc + u.col0 + wc * 32 + 8 * fq;
#pragma unroll
        for (int bj = 0; bj < 2; ++bj) { const f32x4 v0 = acc[ai][bj][m][0], v1 = acc[ai][bj][m][1];
          u32x4 w; w[0] = cvt_pk_bf16(v0[0], v0[1]); w[1] = cvt_pk_bf16(v0[2], v0[3]); w[2] = cvt_pk_bf16(v1[0], v1[1]); w[3] = cvt_pk_bf16(v1[2], v1[3]);
          *(u32x4*)(rowp + bj * HALF) = w; } }
  }
};
struct EpiResid {
  static constexpr bool PERM = false;
  const float* R; float* O; const float* gate; float* SS;
  __device__ __forceinline__ void operator()(const f32x4 (&acc)[2][2][4][2], const GUnit& u, int wr, int wc, int fr, int fq) const {
    const int b = u.row0 >> 13; const float* gp = gate + (size_t)b * 6144 + u.col0 + wc * 32 + 4 * fq;
    f32x4 gv[2][2];
#pragma unroll
    for (int bj = 0; bj < 2; ++bj)
#pragma unroll
      for (int n = 0; n < 2; ++n) gv[bj][n] = *(const f32x4*)(gp + bj * HALF + n * 16);
#pragma unroll
    for (int ai = 0; ai < 2; ++ai)
#pragma unroll
      for (int m = 0; m < 4; ++m) { const int row = u.row0 + ai * HALF + wr * 64 + m * 16 + fr; const size_t off = (size_t)row * 1024 + u.col0 + wc * 32 + 4 * fq;
        float ss = 0.f;
#pragma unroll
        for (int bj = 0; bj < 2; ++bj)
#pragma unroll
          for (int n = 0; n < 2; ++n) { const f32x4 r = *(const f32x4*)(R + off + bj * HALF + n * 16); const f32x4 x = r + gv[bj][n] * acc[ai][bj][m][n]; *(f32x4*)(O + off + bj * HALF + n * 16) = x;
            ss += x[0] * x[0] + x[1] * x[1] + x[2] * x[2] + x[3] * x[3]; }
        ss += __shfl_xor(ss, 16); ss += __shfl_xor(ss, 32);
        if (fq == 0) SS[(size_t)row * 16 + (u.col0 >> 8) * 4 + wc] = ss; }
  }
};
struct EpiSplit1 {
  static constexpr bool PERM = true;
  bf16_t* QD; bf16_t* KD; bf16_t* VD; const float* qn; const float* kn; unsigned char* Q8; unsigned char* K8; int wbf;
  __device__ __forceinline__ void operator()(const f32x4 (&acc)[2][2][4][2], const GUnit& u, int wr, int wc, int fr, int fq) const {
    const int pn = u.col0 >> 8;
    if (pn < 8) {
      const int which = pn >> 2, head16 = (pn & 3) * 4 + wc, comp = head16 & 1;
      const float* gp = (which ? kn : qn) + comp * 64 + 8 * fq;
      const float qs = which ? 1.f : (0.125f * 1.4426950408889634f);
      f32x4 g[2][2];
#pragma unroll
      for (int bj = 0; bj < 2; ++bj)
#pragma unroll
        for (int n = 0; n < 2; ++n) g[bj][n] = *(const f32x4*)(gp + 32 * bj + 4 * n) * qs;
      bf16_t* base = (which ? KD : QD);
#pragma unroll
      for (int ai = 0; ai < 2; ++ai)
#pragma unroll
        for (int m = 0; m < 4; ++m) {
          const int t = u.row0 + ai * HALF + wr * 64 + m * 16 + fr, b = t >> 13, s = t & 8191;
          float ss = 0.f;
#pragma unroll
          for (int bj = 0; bj < 2; ++bj)
#pragma unroll
            for (int n = 0; n < 2; ++n) { const f32x4 v = acc[ai][bj][m][n]; ss += v[0] * v[0] + v[1] * v[1] + v[2] * v[2] + v[3] * v[3]; }
          ss += __shfl_xor(ss, 16); ss += __shfl_xor(ss, 32);
          const float r = rsqrtf(ss * (1.f / 64.f) + EPS_);
          bf16_t* dst = base + (((size_t)b * 16 + head16) * S_ + s) * 64 + 8 * fq;
          unsigned char* dst8 = (which ? K8 : Q8) + (((size_t)b * 16 + head16) * S_ + s) * 64 + 8 * fq;
          const float f8 = which ? 1.f : 8.f;
#pragma unroll
          for (int bj = 0; bj < 2; ++bj) { const f32x4 v0 = acc[ai][bj][m][0] * r * g[bj][0], v1 = acc[ai][bj][m][1] * r * g[bj][1];
            u32x4 w; w[0] = cvt_pk_bf16(v0[0], v0[1]); w[1] = cvt_pk_bf16(v0[2], v0[3]); w[2] = cvt_pk_bf16(v1[0], v1[1]); w[3] = cvt_pk_bf16(v1[2], v1[3]);
            if (wbf) *(u32x4*)(dst + 32 * bj) = w;
            { u32x2 w8; w8[0] = pk4_fp8(v0[0] * f8, v0[1] * f8, v0[2] * f8, v0[3] * f8); w8[1] = pk4_fp8(v1[0] * f8, v1[1] * f8, v1[2] * f8, v1[3] * f8); *(u32x2*)(dst8 + 32 * bj) = w8; } }
        }
    } else {
      const int h = (pn - 8) * 2 + (wc >> 1), e0 = (wc & 1) * 64 + 8 * fq;
#pragma unroll
      for (int ai = 0; ai < 2; ++ai)
#pragma unroll
        for (int m = 0; m < 4; ++m) {
          const int t = u.row0 + ai * HALF + wr * 64 + m * 16 + fr, b = t >> 13, s = t & 8191;
          bf16_t* dst = VD + (((size_t)b * 8 + h) * S_ + s) * 128 + e0;
#pragma unroll
          for (int bj = 0; bj < 2; ++bj) { const f32x4 v0 = acc[ai][bj][m][0], v1 = acc[ai][bj][m][1];
            u32x4 w; w[0] = cvt_pk_bf16(v0[0], v0[1]); w[1] = cvt_pk_bf16(v0[2], v0[3]); w[2] = cvt_pk_bf16(v1[0], v1[1]); w[3] = cvt_pk_bf16(v1[2], v1[3]);
            *(u32x4*)(dst + 32 * bj) = w; }
        }
    }
  }
};
struct EpiSwiglu {
  static constexpr bool PERM = true;
  unsigned char* ACT;
  __device__ __forceinline__ void operator()(const f32x4 (&acc)[2][2][4][2], const GUnit& u, int wr, int wc, int fr, int fq) const {
#pragma unroll
    for (int ai = 0; ai < 2; ++ai)
#pragma unroll
      for (int m = 0; m < 4; ++m) { const int r = ai * HALF + wr * 64 + m * 16 + fr;
        if (r < u.nrow) { unsigned char* rowp = ACT + (size_t)(u.row0 + r) * 512 + ((u.col0 + wc * 32 + 8 * fq) >> 1);
#pragma unroll
          for (int bj = 0; bj < 2; ++bj) { const f32x4 v0 = acc[ai][bj][m][0], v1 = acc[ai][bj][m][1];
            *(unsigned*)(rowp + bj * (HALF / 2)) = pk4_fp8(MOE_ACT_SC * siluf(v0[0]) * v0[1], MOE_ACT_SC * siluf(v0[2]) * v0[3], MOE_ACT_SC * siluf(v1[0]) * v1[1], MOE_ACT_SC * siluf(v1[2]) * v1[3]); } } }
  }
};
struct EpiDown {
  static constexpr bool PERM = true;
  bf16_t* YB; const float* GATEW;
  __device__ __forceinline__ void operator()(const f32x4 (&acc)[2][2][4][2], const GUnit& u, int wr, int wc, int fr, int fq) const {
#pragma unroll
    for (int ai = 0; ai < 2; ++ai)
#pragma unroll
      for (int m = 0; m < 4; ++m) { const int r = ai * HALF + wr * 64 + m * 16 + fr;
        if (r < u.nrow) { const int ent = u.lst[r]; const float gw = GATEW[ent];
          bf16_t* rowp = YB + (size_t)ent * 1024 + u.col0 + wc * 32 + 8 * fq;
#pragma unroll
          for (int bj = 0; bj < 2; ++bj) { const f32x4 v0 = acc[ai][bj][m][0] * gw, v1 = acc[ai][bj][m][1] * gw;
            u32x4 w; w[0] = cvt_pk_bf16(v0[0], v0[1]); w[1] = cvt_pk_bf16(v0[2], v0[3]); w[2] = cvt_pk_bf16(v1[0], v1[1]); w[3] = cvt_pk_bf16(v1[2], v1[3]);
            *(u32x4*)(rowp + bj * HALF) = w; } } }
  }
};

template <class Epi, class Sched, bool GATHER, bool FP8 = false, int BLAY = 0>
__device__ __forceinline__ void gemm_phase(LAS unsigned char* lds, const int K, const Sched& S, const Epi& E, const int sa = 127, const int sb = 127) {
  const int tid = threadIdx.x, wid = __builtin_amdgcn_readfirstlane(tid >> 6), lane = tid & 63, wr = wid >> 2, wc = wid & 3, fr = lane & 15, fq = lane >> 4;
  const int nt = K / BK;
  unsigned voffA[2], voffB[2]; int gR[2], gC[2];
#pragma unroll
  for (int i = 0; i < 2; ++i) { int R, C; stage_rc(tid * 16 + i * 8192, R, C); const int Rb = Epi::PERM ? ((R & ~31) + perm32(R & 31)) : R;
    const int Rg = BLAY ? (64 * (R >> 5) + (Epi::PERM ? perm32(R & 31) : (R & 31))) : Rb;
    voffA[i] = (unsigned)(R * K + C) * 2u; voffB[i] = (unsigned)(Rg * K + C) * 2u; gR[i] = R; gC[i] = C; }
  const size_t kstep = (size_t)(BK * 2);
  const size_t hstep = (size_t)HALF * K * 2;
  const size_t bstep = BLAY ? (size_t)32 * K * 2 : hstep;
  const unsigned ldsw = (unsigned)wid * 1024u;
  const int aoff = lds_byte(wr * 64 + fr, fq * 8), boff = lds_byte(wc * 32 + fr, fq * 8);
  unsigned gcur[2][2], gnxt[2][2];
#define PG_GOFF(dst, u) do { _Pragma("unroll") for (int _h = 0; _h < 2; ++_h) _Pragma("unroll") for (int _i = 0; _i < 2; ++_i) { int _r = _h * HALF + gR[_i]; _r = _r < (u).nrow ? _r : (u).nrow - 1; \
      dst[_h][_i] = (unsigned)(((u).lst[_r] >> 1) * K + gC[_i]) * 2u; } } while (0)
#define PG_SA(b, h) (((b) * 2 + (h)) * HTB)
#define PG_SB(b, h) ((4 + (b) * 2 + (h)) * HTB)
#define PG_STAGE(bufoff, gbase, voff) do { _Pragma("unroll") for (int _i = 0; _i < 2; ++_i) \
      __builtin_amdgcn_global_load_lds((const unsigned*)((const char*)(gbase) + (voff)[_i]), (LAS unsigned*)(lds + (bufoff) + ldsw + _i * 8192), 16, 0, 0); } while (0)
#define PG_STAGE_A(bufoff, base, h, nx) do { if constexpr (GATHER) { unsigned _vo[2]; _vo[0] = (nx) ? gnxt[h][0] : gcur[h][0]; _vo[1] = (nx) ? gnxt[h][1] : gcur[h][1]; PG_STAGE(bufoff, base, _vo); } \
      else { PG_STAGE(bufoff, (base) + (h) * hstep, voffA); } } while (0)
#define PG_LD8(p) ({ const i32x4_t lo_ = *(const LAS i32x4_t*)(p), hi_ = *(const LAS i32x4_t*)((p) + 1024); __builtin_shufflevector(lo_, hi_, 0, 1, 2, 3, 4, 5, 6, 7); })
#define PG_LDA(dst, b, h) do { _Pragma("unroll") for (int m = 0; m < 4; ++m) { if constexpr (FP8) dst##8[m] = PG_LD8(lds + PG_SA(b, h) + aoff + m * 2048); else { _Pragma("unroll") for (int k = 0; k < 2; ++k) dst[m][k] = *(const LAS bf16x8*)(lds + PG_SA(b, h) + aoff + m * 2048 + k * 1024); } } } while (0)
#define PG_LDB(dst, b, h) do { _Pragma("unroll") for (int n = 0; n < 2; ++n) { if constexpr (FP8) dst##8[n] = PG_LD8(lds + PG_SB(b, h) + boff + n * 2048); else { _Pragma("unroll") for (int k = 0; k < 2; ++k) dst[n][k] = *(const LAS bf16x8*)(lds + PG_SB(b, h) + boff + n * 2048 + k * 1024); } } } while (0)
#define PG_MMA(ai, bj, At, Bt) do { __builtin_amdgcn_s_setprio(1); _Pragma("unroll") for (int m = 0; m < 4; ++m) _Pragma("unroll") for (int n = 0; n < 2; ++n) { \
      if constexpr (FP8) asm volatile("s_nop 1\n\tv_mfma_scale_f32_16x16x128_f8f6f4 %0, %1, %2, %0, %3, %4 op_sel_hi:[0,0,0]" : "+v"(acc[ai][bj][m][n]) : "v"(Bt##8[n]), "v"(At##8[m]), "v"(sa), "v"(sb));   \
      else { _Pragma("unroll") for (int k = 0; k < 2; ++k) acc[ai][bj][m][n] = __builtin_amdgcn_mfma_f32_16x16x32_bf16(Bt[n][k], At[m][k], acc[ai][bj][m][n], 0, 0, 0); } } __builtin_amdgcn_s_setprio(0); } while (0)
#define PG_WAIT_V(n) asm volatile("s_waitcnt vmcnt(" #n ")" ::: "memory")
#define PG_WAIT_L(n) asm volatile("s_waitcnt lgkmcnt(" #n ")" ::: "memory")
#define PG_BAR __builtin_amdgcn_s_barrier()
#define PG_SCHED __builtin_amdgcn_sched_barrier(0)
  GUnit cur, nxt; int ui = 0;
  if (!S.next(0, cur)) return;
  if constexpr (GATHER) { PG_GOFF(gcur, cur); PG_GOFF(gnxt, cur); }
  f32x4 acc[2][2][4][2];
#pragma unroll
  for (int a = 0; a < 2; ++a)
#pragma unroll
    for (int b = 0; b < 2; ++b)
#pragma unroll
      for (int m = 0; m < 4; ++m)
#pragma unroll
        for (int n = 0; n < 2; ++n) acc[a][b][m][n] = (f32x4){0.f, 0.f, 0.f, 0.f};
  bf16x8 At[4][2], B0[2][2], B1[2][2]; i32x8_t At8[4], B08[2], B18[2];
  const char* cA = cur.A; const char* cB = cur.B;
  PG_STAGE(PG_SB(0, 0), cB, voffB); PG_STAGE(PG_SB(0, 1), cB + bstep, voffB); PG_STAGE_A(PG_SA(0, 0), cA, 0, false); PG_STAGE_A(PG_SA(0, 1), cA, 1, false);
  if (wr == 1) PG_BAR;
  PG_WAIT_V(2); PG_BAR;
  PG_STAGE(PG_SB(1, 0), cB + kstep, voffB); PG_STAGE_A(PG_SA(1, 0), cA + kstep, 0, false); PG_STAGE(PG_SB(1, 1), cB + bstep + kstep, voffB);
  PG_WAIT_V(6); PG_BAR;
  for (;;) {
    const bool has_next = S.next(ui + 1, nxt);
    if constexpr (GATHER) { if (has_next) PG_GOFF(gnxt, nxt); }
    const char* nA = has_next ? nxt.A : cA; const char* nB = has_next ? nxt.B : cB;
    const bool nxg = has_next;
    for (int t = 0; t < nt; t += 2) {
      const bool last = (t == nt - 2);
      const char* a1 = cA + (size_t)(t + 1) * kstep;
      const char* a2 = last ? nA : cA + (size_t)(t + 2) * kstep; const char* b2 = last ? nB : cB + (size_t)(t + 2) * kstep;
      const char* a3 = a2 + kstep; const char* b3 = b2 + kstep;
      const bool nx = last && nxg;
      PG_LDB(B0, 0, 0); PG_LDB(B1, 0, 1); PG_SCHED; PG_LDA(At, 0, 0); PG_STAGE_A(PG_SA(1, 1), a1, 1, false);
      PG_WAIT_V(8); PG_WAIT_L(0); PG_BAR; PG_MMA(0, 0, At, B0); PG_MMA(0, 1, At, B1); PG_BAR; PG_SCHED;
      PG_LDA(At, 0, 1); PG_STAGE(PG_SB(0, 0), b2, voffB); PG_STAGE(PG_SB(0, 1), b2 + bstep, voffB); PG_STAGE_A(PG_SA(0, 0), a2, 0, nx);
      PG_WAIT_V(8); PG_WAIT_L(0); PG_BAR; PG_MMA(1, 0, At, B0); PG_MMA(1, 1, At, B1); PG_BAR; PG_SCHED;
      PG_LDB(B0, 1, 0); PG_LDB(B1, 1, 1); PG_SCHED; PG_LDA(At, 1, 0); PG_STAGE_A(PG_SA(0, 1), a2, 1, nx);
      PG_WAIT_V(8); PG_WAIT_L(0); PG_BAR; PG_MMA(0, 0, At, B0); PG_MMA(0, 1, At, B1); PG_BAR; PG_SCHED;
      PG_LDA(At, 1, 1); PG_STAGE(PG_SB(1, 0), b3, voffB); PG_STAGE(PG_SB(1, 1), b3 + bstep, voffB); PG_STAGE_A(PG_SA(1, 0), a3, 0, nx);
      PG_WAIT_V(8); PG_WAIT_L(0); PG_BAR; PG_MMA(1, 0, At, B0); PG_MMA(1, 1, At, B1); PG_BAR; PG_SCHED;
    }
    if (wr == 0) PG_BAR;
    if constexpr (FP8) asm volatile("s_nop 15\n\ts_nop 15\n\ts_nop 15\n\ts_nop 15" ::: "memory");
    E(acc, cur, wr, wc, fr, fq);
    if (!has_next) break;
#pragma unroll
    for (int a = 0; a < 2; ++a)
#pragma unroll
      for (int b = 0; b < 2; ++b)
#pragma unroll
        for (int m = 0; m < 4; ++m)
#pragma unroll
          for (int n = 0; n < 2; ++n) acc[a][b][m][n] = (f32x4){0.f, 0.f, 0.f, 0.f};
    cur = nxt; cA = nA; cB = nB; ++ui;
    if constexpr (GATHER) {
#pragma unroll
      for (int h = 0; h < 2; ++h) { gcur[h][0] = gnxt[h][0]; gcur[h][1] = gnxt[h][1]; }
    }
    if (wr == 1) PG_BAR;
  }
  PG_WAIT_V(0);
  PG_BAR;
#undef PG_GOFF
#undef PG_SA
#undef PG_SB
#undef PG_STAGE
#undef PG_STAGE_A
#undef PG_LDA
#undef PG_LDB
#undef PG_MMA
#undef PG_LD8
#undef PG_WAIT_V
#undef PG_WAIT_L
#undef PG_BAR
#undef PG_SCHED
}
}

__device__ __forceinline__ void moe_tables(const Frame& F, int l, int tile) {
  int* tstart = (int*)(F.lds + LDS_CTL + 64); int* sbase = tstart + 40; int* cntl = sbase + 40;
  const unsigned* COUNT = (const unsigned*)(F.ws + WS_CTL + CW_CNT) + l * 32;
  __syncthreads();
  if (F.tid == 0) { int ts = 0, sb = 0; for (int e = 0; e < 32; ++e) { const int c = (int)COUNT[e]; cntl[e] = c; tstart[e] = ts; sbase[e] = sb; ts += (c + tile - 1) / tile; sb += c; } tstart[32] = ts; sbase[32] = sb; }
  __syncthreads();
}


__device__ __forceinline__ void moe_up_fast(const Frame& F, int l) {
  moe_tables(F, l, 256);
  const int* tstart = (const int*)(F.lds + LDS_CTL + 64); const int* sbase = tstart + 40; const int* cntl = sbase + 40;
  pg::MoeOrder S{tstart, sbase, cntl, (const char*)WSP(const unsigned char, WS_HB), (const char*)(WSP(const unsigned char, WS_WUP) + (size_t)l * 32 * 1024 * 1024), WSP(const int, WS_LIST), 512, F.G, F.bid, 1};
  pg::EpiSwiglu E{WSP(unsigned char, A_ACT)};
  pg::gemm_phase<pg::EpiSwiglu, pg::MoeOrder, true, true>((LAS unsigned char*)F.lds, 512, S, E, 121  , 127);
}
__device__ __forceinline__ void moe_down_fast(const Frame& F, int l) {
  moe_tables(F, l, 256);
  const int* tstart = (const int*)(F.lds + LDS_CTL + 64); const int* sbase = tstart + 40; const int* cntl = sbase + 40;
  pg::MoeOrder S{tstart, sbase, cntl, (const char*)WSP(const unsigned char, A_ACT), (const char*)(WSP(const unsigned char, WS_WDN) + (size_t)l * 32 * 1024 * 512), WSP(const int, WS_LIST), 256, F.G, F.bid, 0};
  pg::EpiDown E{WSP(bf16_t, A_YB), WSP(const float, WS_GATEW)};
  pg::gemm_phase<pg::EpiDown, pg::MoeOrder, false, true>((LAS unsigned char*)F.lds, 256, S, E, 122  , 125  );
}

__device__ __forceinline__ int t5_bucket(int rel) {
  const int n = rel < 0 ? -rel : rel;
  int bkt;
  if (n < 8) bkt = n; else if (n < 12) bkt = 8; else if (n < 16) bkt = 9; else if (n < 23) bkt = 10; else if (n < 32) bkt = 11;
  else if (n < 46) bkt = 12; else if (n < 64) bkt = 13; else if (n < 91) bkt = 14; else bkt = 15;
  return bkt + (rel > 0 ? 16 : 0);
}


namespace fa {
using bf16x8 = __attribute__((ext_vector_type(8))) short;
using s16x4  = __attribute__((ext_vector_type(4))) short;
using f32x16 = __attribute__((ext_vector_type(16))) float;
constexpr int NW = 8, QBLK = 32, KVBLK = 64;
constexpr float THR2 = 8.f * 1.4426950408889634f;
#define FA_SBAR() __builtin_amdgcn_sched_barrier(0)
__device__ __forceinline__ int crow(int r, int hi) { return (r & 3) + 8 * (r >> 2) + 4 * hi; }
__device__ __forceinline__ unsigned cvtpk(float lo, float hi) { unsigned r; asm volatile("v_cvt_pk_bf16_f32 %0, %1, %2" : "=v"(r) : "v"(lo), "v"(hi)); return r; }

__device__ __forceinline__ void partialSM(f32x16& p0, f32x16& p1, float& m_reg, float& alpha, float Cmul, float tb) {
  float pmax = p0[0];
#pragma unroll
  for (int r = 1; r < 16; ++r) pmax = fmaxf(pmax, p0[r]);
#pragma unroll
  for (int r = 0; r < 16; ++r) pmax = fmaxf(pmax, p1[r]);
  { auto rr = __builtin_amdgcn_permlane32_swap(__float_as_uint(pmax), __float_as_uint(pmax), false, false);
    pmax = fmaxf(__uint_as_float(rr[0]), __uint_as_float(rr[1])); }
  const float tmax = fmaf(pmax, Cmul, tb);
  float mn;
  if (__builtin_expect(__all(tmax - m_reg <= THR2), 1)) { mn = m_reg; alpha = 1.f; }
  else { mn = fmaxf(m_reg, tmax); alpha = __builtin_amdgcn_exp2f(m_reg - mn); m_reg = mn; }
  const float off = tb - mn;
#pragma unroll
  for (int r = 0; r < 16; ++r) p0[r] = fmaf(p0[r], Cmul, off);
#pragma unroll
  for (int r = 0; r < 16; ++r) p1[r] = fmaf(p1[r], Cmul, off);
#pragma unroll
  for (int r = 0; r < 16; ++r) p0[r] = __builtin_amdgcn_exp2f(p0[r]);
}
__device__ __forceinline__ void partialSM_nomax(f32x16& p0) {
#pragma unroll
  for (int r = 0; r < 16; ++r) p0[r] = __builtin_amdgcn_exp2f(p0[r]);
}
__device__ __forceinline__ void finishSM(f32x16& p0, f32x16& p1, float alpha, float& l_reg, bf16x8& pa0, bf16x8& pa1, bf16x8& pa2, bf16x8& pa3) {
#pragma unroll
  for (int r = 0; r < 16; ++r) p1[r] = __builtin_amdgcn_exp2f(p1[r]);
  float ps = 0;
#pragma unroll
  for (int r = 0; r < 16; ++r) ps += p0[r];
#pragma unroll
  for (int r = 0; r < 16; ++r) ps += p1[r];
  { auto rr = __builtin_amdgcn_permlane32_swap(__float_as_uint(ps), __float_as_uint(ps), false, false);
    ps = __uint_as_float(rr[0]) + __uint_as_float(rr[1]); }
  l_reg = l_reg * alpha + ps;
#define FA_PK4(P, BASE, OUT) do { unsigned a0 = cvtpk(P[BASE + 0], P[BASE + 1]), a1 = cvtpk(P[BASE + 2], P[BASE + 3]);   \
    unsigned b0 = cvtpk(P[BASE + 4], P[BASE + 5]), b1 = cvtpk(P[BASE + 6], P[BASE + 7]);                              \
    auto r0 = __builtin_amdgcn_permlane32_swap(a0, b0, false, false); auto r1 = __builtin_amdgcn_permlane32_swap(a1, b1, false, false); \
    u32x4 w = {r0[0], r1[0], r0[1], r1[1]}; OUT = *reinterpret_cast<bf16x8*>(&w); } while (0)
  FA_PK4(p0, 0, pa0); FA_PK4(p0, 8, pa1); FA_PK4(p1, 0, pa2); FA_PK4(p1, 8, pa3);
#undef FA_PK4
}
template <int OFF> __device__ __forceinline__ s16x4 tr_read(int vb) {
  s16x4 r; asm volatile("ds_read_b64_tr_b16 %0, %1 offset:%2" : "=&v"(r) : "v"(vb), "i"(OFF) : "memory"); return r;
}
__device__ __forceinline__ int v_rd_base(int lane) { return ((lane & 3) << 3) | (((lane >> 2) & 3) << 6) | (((lane >> 4) & 1) << 5) | (((lane >> 5) & 1) << 8); }

template <int LDK, int NKS, int DV, bool BIAS, bool NOMAX = false>
struct Body {
  static constexpr int RB = LDK * 2;
  static constexpr int SHM_K = KVBLK * RB, SHM_V = KVBLK * DV * 2;
  static constexpr int NC = DV / 32;
  static constexpr int NKL = LDK / 64, NVL = DV / 64;
  static constexpr int OFF_V = 0, OFF_K = 2 * SHM_V, OFF_WS = 2 * SHM_V + 2 * SHM_K, OFF_TAB = OFF_WS + NW * 64 * 4, LDS_NEED = OFF_TAB + 392 * 4;
  static __device__ __forceinline__ int kswz(int row, int colB) { return row * RB + (colB ^ ((((RB == 128) ? (row ^ (row >> 3)) : row) & 7) << 4)); }
  static __device__ __forceinline__ int v_st(int k, int c) { const int kk = (k & ~0xC) | ((k & 4) << 1) | ((k & 8) >> 1); return ((kk >> 3) * NC + (c >> 5)) * 512 + ((kk & 7) * 32 + (c & 31)) * 2; }
  static constexpr int v_rd_off(int d0, int ks, int half) { return d0 * 512 + ks * (NC * 1024) + half * (NC * 512); }

  static __device__ __forceinline__ void qkt(f32x16& p0, f32x16& p1, const char* Ks, const bf16x8* qr, int r32, int hi) {
    p0 = f32x16{}; p1 = f32x16{};
#pragma unroll
    for (int d0 = 0; d0 < NKS; ++d0) { const int cb = (d0 * 16 + hi * 8) * 2;
      const bf16x8 b0 = *reinterpret_cast<const bf16x8*>(Ks + kswz(r32, cb));
      const bf16x8 b1 = *reinterpret_cast<const bf16x8*>(Ks + kswz(32 + r32, cb));
      p0 = __builtin_amdgcn_mfma_f32_32x32x16_bf16(b0, qr[d0], p0, 0, 0, 0);
      p1 = __builtin_amdgcn_mfma_f32_32x32x16_bf16(b1, qr[d0], p1, 0, 0, 0); }
  }
  template <int D0> static __device__ __forceinline__ void pv_one(f32x16& od, int vb, bf16x8 pa0, bf16x8 pa1, bf16x8 pa2, bf16x8 pa3) {
    const s16x4 l0 = tr_read<v_rd_off(D0, 0, 0)>(vb), h0 = tr_read<v_rd_off(D0, 0, 1)>(vb), l1 = tr_read<v_rd_off(D0, 1, 0)>(vb), h1 = tr_read<v_rd_off(D0, 1, 1)>(vb);
    const s16x4 l2 = tr_read<v_rd_off(D0, 2, 0)>(vb), h2 = tr_read<v_rd_off(D0, 2, 1)>(vb), l3 = tr_read<v_rd_off(D0, 3, 0)>(vb), h3 = tr_read<v_rd_off(D0, 3, 1)>(vb);
    asm volatile("s_waitcnt lgkmcnt(0)" ::: "memory"); FA_SBAR();
#define FA_PK(L, H) (bf16x8){L[0], L[1], L[2], L[3], H[0], H[1], H[2], H[3]}
    od = __builtin_amdgcn_mfma_f32_32x32x16_bf16(pa0, FA_PK(l0, h0), od, 0, 0, 0);
    od = __builtin_amdgcn_mfma_f32_32x32x16_bf16(pa1, FA_PK(l1, h1), od, 0, 0, 0);
    od = __builtin_amdgcn_mfma_f32_32x32x16_bf16(pa2, FA_PK(l2, h2), od, 0, 0, 0);
    od = __builtin_amdgcn_mfma_f32_32x32x16_bf16(pa3, FA_PK(l3, h3), od, 0, 0, 0);
#undef FA_PK
  }
  static __device__ __forceinline__ void pv_all(f32x16* o, int vb, bf16x8 pa0, bf16x8 pa1, bf16x8 pa2, bf16x8 pa3) {
    pv_one<0>(o[0], vb, pa0, pa1, pa2, pa3); pv_one<1>(o[1], vb, pa0, pa1, pa2, pa3);
    if constexpr (NC == 4) { pv_one<2>(o[2], vb, pa0, pa1, pa2, pa3); pv_one<3>(o[3], vb, pa0, pa1, pa2, pa3); }
  }
  static __device__ __forceinline__ void add_bias(f32x16& p0, f32x16& p1, float C, const float* tabl) {
#pragma unroll
    for (int r = 0; r < 16; ++r) { p0[r] = fmaf(p0[r], C, tabl[(r & 3) + 8 * (r >> 2)]); p1[r] = fmaf(p1[r], C, tabl[32 + (r & 3) + 8 * (r >> 2)]); }
  }

  template <class Store>
  static __device__ __forceinline__ void run(const bf16_t* __restrict__ Qb, const bf16_t* __restrict__ Kh, const bf16_t* __restrict__ Vh, int seq, char* lds, float C, int q0, Store store) {
    int tid_ = threadIdx.x; asm volatile("" : "+v"(tid_));
    const int tid = tid_, wid = tid >> 6, lane = tid & 63, r32 = lane & 31, hi = lane >> 5;
    char* V_lds = lds + OFF_V; char* K_lds = lds + OFF_K;
    float* ws = (float*)(lds + OFF_WS) + wid * 64; float* li_l = ws; float* al_l = ws + 32;
    const float* tab = (const float*)(lds + OFF_TAB);
    float m_reg = -1e30f, l_reg = 0; f32x16 o[NC] = {}; bf16x8 qr[NKS];
    const bf16_t* Qw = Qb + (size_t)(wid * QBLK + r32) * LDK + hi * 8;
#pragma unroll
    for (int d0 = 0; d0 < NKS; ++d0) qr[d0] = *reinterpret_cast<const bf16x8*>(Qw + d0 * 16);
    const int ksr = (LDK == 128) ? (tid >> 4) : (tid >> 3), ksc = (LDK == 128) ? (tid & 15) * 8 : (tid & 7) * 8;
    const int vsr = (DV == 128) ? (tid >> 4) : (tid >> 3), vsc = (DV == 128) ? (tid & 15) * 8 : (tid & 7) * 8;
    const int vst0 = v_st(vsr, vsc), vst1 = v_st(32 + vsr, vsc);
    const int vb0 = (int)(uintptr_t)V_lds + v_rd_base(lane);
    struct { bf16x8 v[NVL], k[NKL]; } sr_[2];
#define FA_SLOAD(i, k0) do { _Pragma("unroll") for (int _q = 0; _q < NVL; ++_q) sr_[i].v[_q] = *reinterpret_cast<const bf16x8*>(&Vh[(size_t)((k0) + vsr + 32 * _q) * DV + vsc]); \
    _Pragma("unroll") for (int _q = 0; _q < NKL; ++_q) sr_[i].k[_q] = *reinterpret_cast<const bf16x8*>(&Kh[(size_t)((k0) + ksr + 32 * _q) * LDK + ksc]); } while (0)
#define FA_SWRITE(b, i) do { *(bf16x8*)(V_lds + (b) * SHM_V + vst0) = sr_[i].v[0]; if constexpr (NVL == 2) *(bf16x8*)(V_lds + (b) * SHM_V + vst1) = sr_[i].v[NVL - 1]; \
    *(bf16x8*)(K_lds + (b) * SHM_K + kswz(ksr, ksc * 2)) = sr_[i].k[0]; if constexpr (NKL == 2) *(bf16x8*)(K_lds + (b) * SHM_K + kswz(32 + ksr, ksc * 2)) = sr_[i].k[NKL - 1]; } while (0)
#define FA_SWAIT() do { if constexpr (NVL + NKL == 2) asm volatile("s_waitcnt vmcnt(2)" ::: "memory"); else if constexpr (NVL + NKL == 3) asm volatile("s_waitcnt vmcnt(3)" ::: "memory"); else asm volatile("s_waitcnt vmcnt(4)" ::: "memory"); } while (0)
#define FA_RESC(a) do { if constexpr (NOMAX) { if ((a) != 1.f) { _Pragma("unroll") for (int d = 0; d < NC; ++d) _Pragma("unroll") for (int r = 0; r < 16; ++r) o[d][r] *= (a); } } \
    else if (__any((a) < 1.f)) { if (hi == 0) al_l[r32] = (a); asm volatile("s_waitcnt lgkmcnt(0)" ::: "memory"); \
    _Pragma("unroll") for (int d = 0; d < NC; ++d) _Pragma("unroll") for (int r = 0; r < 16; ++r) o[d][r] *= al_l[crow(r, hi)]; } } while (0)
    const int qw = q0 + wid * QBLK;
#define FA_CLS(jt) (((jt) * KVBLK + 63 - qw <= -91) ? 0 : (((jt) * KVBLK - qw - 31 >= 91) ? 2 : 1))
#define FA_PSM(P0, P1, AL, jt) do { if constexpr (NOMAX) { AL = 1.f; \
      if constexpr (BIAS) { const int c1_ = FA_CLS(jt); if ((jt) > 0) { const int c0_ = FA_CLS((jt) - 1); if (c1_ != c0_) AL = (c1_ == 1) ? __builtin_amdgcn_exp2f(tab[0]) : __builtin_amdgcn_exp2f(-tab[384]); } \
        if (c1_ == 1) add_bias(P0, P1, 1.f, tab + ((jt) * KVBLK - (qw + r32) + 192 + 4 * hi)); }     \
      partialSM_nomax(P0); } \
    else if constexpr (BIAS) { const int kt_ = (jt) * KVBLK; \
      if (kt_ + 63 - qw <= -91) partialSM(P0, P1, m_reg, AL, C, tab[0]); \
      else if (kt_ - qw - 31 >= 91) partialSM(P0, P1, m_reg, AL, C, tab[384]); \
      else { add_bias(P0, P1, C, tab + (kt_ - (qw + r32) + 192 + 4 * hi)); partialSM(P0, P1, m_reg, AL, 1.f, 0.f); } } \
    else partialSM(P0, P1, m_reg, AL, C, 0.f); } while (0)
    f32x16 pA0, pA1, pB0, pB1; float alA, alB; bf16x8 pa0, pa1, pa2, pa3; const int NT = seq / KVBLK;
    constexpr int SE = 0, SO = 1;
    FA_SLOAD(SE, 0); asm volatile("s_waitcnt vmcnt(0)" ::: "memory"); FA_SWRITE(0, SE); __syncthreads();
    qkt(pA0, pA1, K_lds, qr, r32, hi); FA_PSM(pA0, pA1, alA, 0);
    FA_SLOAD(SO, KVBLK); if (2 < NT) FA_SLOAD(SE, 2 * KVBLK);
    FA_SWAIT(); FA_SWRITE(1, SO); __syncthreads();
    for (int j = 1; j + 1 < NT; j += 2) {
      FA_SBAR(); qkt(pB0, pB1, K_lds + SHM_K, qr, r32, hi);
      finishSM(pA0, pA1, alA, l_reg, pa0, pa1, pa2, pa3); FA_SBAR();
      FA_SLOAD(SO, (j + 2) * KVBLK); FA_SBAR();
      pv_all(o, vb0, pa0, pa1, pa2, pa3); FA_PSM(pB0, pB1, alB, j);
      __syncthreads(); FA_SWAIT(); FA_SWRITE(0, SE);
      FA_RESC(alB); __syncthreads();
      FA_SBAR(); qkt(pA0, pA1, K_lds, qr, r32, hi);
      finishSM(pB0, pB1, alB, l_reg, pa0, pa1, pa2, pa3); FA_SBAR();
      if (j + 3 < NT) FA_SLOAD(SE, (j + 3) * KVBLK); FA_SBAR();
      pv_all(o, vb0 + SHM_V, pa0, pa1, pa2, pa3); FA_PSM(pA0, pA1, alA, j + 1);
      __syncthreads(); FA_SWAIT(); FA_SWRITE(1, SO);
      FA_RESC(alA); __syncthreads();
    }
    FA_SBAR(); qkt(pB0, pB1, K_lds + SHM_K, qr, r32, hi);
    finishSM(pA0, pA1, alA, l_reg, pa0, pa1, pa2, pa3); FA_SBAR();
    pv_all(o, vb0, pa0, pa1, pa2, pa3); FA_PSM(pB0, pB1, alB, NT - 1);
    __syncthreads(); FA_RESC(alB);
    finishSM(pB0, pB1, alB, l_reg, pa0, pa1, pa2, pa3); FA_SBAR();
    pv_all(o, vb0 + SHM_V, pa0, pa1, pa2, pa3);
    if (hi == 0) li_l[r32] = l_reg; asm volatile("s_waitcnt lgkmcnt(0)" ::: "memory");
    float rli[16];
#pragma unroll
    for (int r = 0; r < 16; ++r) rli[r] = __builtin_amdgcn_rcpf(li_l[crow(r, hi)]);
    store(o, rli, wid, r32, hi);
    __syncthreads();
#undef FA_SLOAD
#undef FA_SWRITE
#undef FA_SWAIT
#undef FA_RESC
#undef FA_PSM
#undef FA_CLS
  }
};
}


namespace fa8 {
using fa::f32x16; using fa::crow;
typedef int v8i __attribute__((ext_vector_type(8)));
typedef short v2s __attribute__((ext_vector_type(2)));
template <int NKB>
struct Body {
  static constexpr int RBK = 64 * NKB, SHM_K = 64 * RBK, SHM_V = 64 * 64, NP = (NKB == 1) ? 1 : 2;
  static constexpr int OFF_V = 0, OFF_K = 4 * SHM_V, OFF_WS = OFF_K + 4 * SHM_K, LDS_NEED = OFF_WS + 8 * 32 * 4;
  static __device__ __forceinline__ int swzk(int row) { return NKB == 1 ? ((row >> 2) & 3) : ((row >> 1) & 7); }
  static __device__ __forceinline__ int koffs(int row, int chunk) { return row * RBK + ((chunk ^ swzk(row)) << 4); }
  static __device__ __forceinline__ int voffs(int row, int chunk) { return row * 64 + ((chunk ^ ((row >> 2) & 3)) << 4); }

  template <class Store>
  static __device__ __forceinline__ void run(const unsigned char* __restrict__ Qb, const unsigned char* __restrict__ Kh, const unsigned char* __restrict__ VTh, int seq, LAS unsigned char* lds, int cexp, Store store) {
    int tid_ = threadIdx.x; asm volatile("" : "+v"(tid_));
    const int tid = tid_, wid = __builtin_amdgcn_readfirstlane(tid >> 6), lane = tid & 63, r32 = lane & 31, hi = lane >> 5;
    unsigned kgo, vgo;
    { const int pc = (NKB == 1) ? (wid & 3) : wid, pos = pc * 1024 + lane * 16, row = pos / RBK, ch = ((pos % RBK) >> 4) ^ swzk(row); kgo = (unsigned)(row * RBK + ch * 16); }
    { const int pc = wid & 3, pos = pc * 1024 + lane * 16, row = pos >> 6, ch = ((pos & 63) >> 4) ^ ((row >> 2) & 3); vgo = (unsigned)(row * seq + ch * 16); }
    const int NT = seq / 64;
#define F8_TCL(t) ((t) < NT ? (t) : NT - 1)
#define F8_DMA_K(t, b) __builtin_amdgcn_global_load_lds((const unsigned*)(Kh + (size_t)F8_TCL(t) * 64 * RBK + kgo), (LAS unsigned*)(lds + OFF_K + (b) * SHM_K + ((NKB == 1) ? (wid & 3) : wid) * 1024), 16, 0, 0)
#define F8_DMA_V(t, b) __builtin_amdgcn_global_load_lds((const unsigned*)(VTh + (size_t)F8_TCL(t) * 64 + vgo), (LAS unsigned*)(lds + OFF_V + (b) * SHM_V + (wid & 3) * 1024), 16, 0, 0)
#define F8_DMA2(a_) do { \
      if constexpr (NKB == 1) { const int kt_ = (a_) + 4 + (wid >> 2); F8_DMA_K(kt_, kt_ & 3); } \
      else { F8_DMA_K((a_) + 4, ((a_) + 4) & 3); F8_DMA_K((a_) + 5, ((a_) + 5) & 3); } \
      { const int vt_ = (a_) + 1 + (wid >> 2); F8_DMA_V(vt_, vt_ & 3); } } while (0)
#define F8_BAR() do { __builtin_amdgcn_sched_barrier(0); __builtin_amdgcn_s_barrier(); __builtin_amdgcn_sched_barrier(0); } while (0)
#define F8_VM0() asm volatile("s_waitcnt vmcnt(0)" ::: "memory")
#define F8_VMNP() do { if constexpr (NP == 1) asm volatile("s_waitcnt vmcnt(1)" ::: "memory"); else asm volatile("s_waitcnt vmcnt(2)" ::: "memory"); } while (0)
    f32x16 o[2] = {}, ol = {}; f32x16 sA0, sA1, sB0, sB1; v8i pA, pB; int saA = 127, saB = 127;
    const float csc = __builtin_bit_cast(float, (unsigned)(127 + cexp) << 23); const int sap = 127 + cexp;
    const v8i ones = {0x38383838, 0x38383838, 0x38383838, 0x38383838, 0x38383838, 0x38383838, 0x38383838, 0x38383838};
    int c127 = 127, c124 = 124; asm volatile("" : "+v"(c127), "+v"(c124));
    v8i qf[NKB], kf[2][NKB], vf[2];
    { const unsigned char* Qw = Qb + (size_t)(wid * 32 + r32) * RBK + hi * 32;
#pragma unroll
      for (int c = 0; c < NKB; ++c) { const u32x4 a = *(const u32x4*)(Qw + c * 64), b = *(const u32x4*)(Qw + c * 64 + 16); qf[c] = (v8i){(int)a[0], (int)a[1], (int)a[2], (int)a[3], (int)b[0], (int)b[1], (int)b[2], (int)b[3]}; } }
#define F8_LD32(p0_, p1_) ({ const u32x4 a_ = *(const LAS u32x4*)(p0_), b_ = *(const LAS u32x4*)(p1_); (v8i){(int)a_[0], (int)a_[1], (int)a_[2], (int)a_[3], (int)b_[0], (int)b_[1], (int)b_[2], (int)b_[3]}; })
#define F8_KLOAD(kb) do { const LAS unsigned char* Ks_ = lds + OFF_K + (kb) * SHM_K; \
      _Pragma("unroll") for (int h2 = 0; h2 < 2; ++h2) _Pragma("unroll") for (int c = 0; c < NKB; ++c) { const int row = h2 * 32 + r32, ch = c * 4 + 2 * hi; \
        kf[h2][c] = F8_LD32(Ks_ + koffs(row, ch), Ks_ + koffs(row, ch + 1)); } } while (0)
#define F8_VLOAD(vb) do { const LAS unsigned char* Vs_ = lds + OFF_V + (vb) * SHM_V; \
      _Pragma("unroll") for (int d = 0; d < 2; ++d) { const int row = d * 32 + r32; vf[d] = F8_LD32(Vs_ + voffs(row, 2 * hi), Vs_ + voffs(row, 2 * hi + 1)); } } while (0)
#define F8_QKN(S, KF, QF) asm volatile("s_nop 1\n\tv_mfma_scale_f32_32x32x64_f8f6f4 %0, %1, %2, 0, %3, %4 op_sel_hi:[0,0,0]" : "=&v"(S) : "v"(KF), "v"(QF), "v"(c127), "v"(c124))
#define F8_QKA(S, KF, QF) asm volatile("s_nop 1\n\tv_mfma_scale_f32_32x32x64_f8f6f4 %0, %1, %2, %0, %3, %4 op_sel_hi:[0,0,0]" : "+v"(S) : "v"(KF), "v"(QF), "v"(c127), "v"(c124))
#define F8_QK(S0, S1) do { __builtin_amdgcn_sched_barrier(0); F8_QKN(S0, kf[0][0], qf[0]); F8_QKN(S1, kf[1][0], qf[0]); \
      if constexpr (NKB == 2) { F8_QKA(S0, kf[0][1], qf[1]); F8_QKA(S1, kf[1][1], qf[1]); } __builtin_amdgcn_sched_barrier(0); } while (0)
#define F8_PVX(ACC, P, B, SA) do { __builtin_amdgcn_sched_barrier(0); asm volatile("s_nop 1\n\tv_mfma_scale_f32_32x32x64_f8f6f4 %0, %1, %2, %0, %3, %4 op_sel_hi:[0,0,0] cbsz:1" : "+v"(ACC) : "v"(P), "v"(B), "v"(SA), "v"(c127)); __builtin_amdgcn_sched_barrier(0); } while (0)
#define F8_PV(P, SA) do { F8_PVX(o[0], P, vf[0], SA); F8_PVX(o[1], P, vf[1], SA); F8_PVX(ol, P, ones, SA); } while (0)
#define F8_ONOP() asm volatile("s_nop 15\n\ts_nop 15\n\ts_nop 15\n\ts_nop 15" ::: "memory")
#define F8_CV4(S, B4, SC) ({ v2s z_; asm volatile("" : "=v"(z_)); z_ = __builtin_amdgcn_cvt_scalef32_pk_bf8_f32(z_, S[B4], S[B4 + 1], SC, false); z_ = __builtin_amdgcn_cvt_scalef32_pk_bf8_f32(z_, S[B4 + 2], S[B4 + 3], SC, true); (unsigned)__builtin_bit_cast(int, z_); })
#define F8_SM(S0, S1, P, SA) F8_SMX(S0, S1, P, SA, P, SA, false, -1)
#define F8_SMX(S0, S1, P, SA, PP_, SAP_, DOPV_, KB_) do { \
      _Pragma("unroll") for (int r = 0; r < 16; ++r) S0[r] = __builtin_amdgcn_exp2f(S0[r]); \
      if (DOPV_) F8_PVX(o[0], PP_, vf[0], SAP_); \
      _Pragma("unroll") for (int r = 0; r < 16; ++r) S1[r] = __builtin_amdgcn_exp2f(S1[r]); \
      if (DOPV_) F8_PVX(o[1], PP_, vf[1], SAP_); \
      if ((KB_) >= 0) { __builtin_amdgcn_sched_barrier(0); F8_KLOAD(KB_); __builtin_amdgcn_sched_barrier(0); }        \
      unsigned x_[4], y_[4]; \
      _Pragma("unroll") for (int i = 0; i < 4; ++i) x_[i] = F8_CV4(S0, 4 * i, csc); \
      if (DOPV_) F8_PVX(ol, PP_, ones, SAP_); \
      _Pragma("unroll") for (int i = 0; i < 4; ++i) y_[i] = F8_CV4(S1, 4 * i, csc); \
      P = (v8i){(int)x_[0], (int)x_[1], (int)x_[2], (int)x_[3], (int)y_[0], (int)y_[1], (int)y_[2], (int)y_[3]}; \
      SA = sap; } while (0)
#define F8_STEP(j_, SI0, SI1, SO0, SO1, PP, SAP, PN, SAN, dopv) do { \
      F8_QK(SO0, SO1); \
      if (dopv) F8_VLOAD(((j_) - 1) & 3); \
      F8_SMX(SI0, SI1, PN, SAN, PP, SAP, dopv, ((j_) + 2) & 3); \
      __builtin_amdgcn_sched_barrier(0); } while (0)
#define F8_PAIR_END() do { asm volatile("s_waitcnt lgkmcnt(0)" ::: "memory"); F8_VM0(); F8_BAR(); } while (0)

    if constexpr (NKB == 1) { if (wid < 4) { F8_DMA_K(0, 0); F8_DMA_K(1, 1); F8_DMA_K(2, 2); F8_DMA_K(3, 3); } else F8_DMA_V(0, 0); }
    else { F8_DMA_K(0, 0); F8_DMA_K(1, 1); F8_DMA_K(2, 2); F8_DMA_K(3, 3); F8_DMA_V(0, 0); }
    F8_VM0(); F8_BAR();
    F8_KLOAD(0); F8_QK(sA0, sA1); F8_ONOP(); F8_ONOP(); F8_ONOP(); F8_ONOP(); __builtin_amdgcn_sched_barrier(0); F8_KLOAD(1);
    asm volatile("s_waitcnt lgkmcnt(0)" ::: "memory"); F8_BAR();
    F8_DMA2(0); __builtin_amdgcn_sched_barrier(0);
    F8_STEP(0, sA0, sA1, sB0, sB1, pB, saB, pA, saA, false);
    F8_STEP(1, sB0, sB1, sA0, sA1, pA, saA, pB, saB, true);
    F8_PAIR_END();
    for (int j = 2; j + 1 < NT; j += 2) {
      F8_DMA2(j); __builtin_amdgcn_sched_barrier(0);
      F8_STEP(j, sA0, sA1, sB0, sB1, pB, saB, pA, saA, true);
      F8_STEP(j + 1, sB0, sB1, sA0, sA1, pA, saA, pB, saB, true);
      F8_PAIR_END();
    }
    F8_VLOAD((NT - 1) & 3); F8_PV(pB, saB);
    F8_ONOP();
    float rli[16];
#pragma unroll
    for (int r = 0; r < 16; ++r) rli[r] = __builtin_amdgcn_rcpf(ol[r]);
    store(o, rli, wid, r32, hi);
    __syncthreads();
#undef F8_TCL
#undef F8_DMA_K
#undef F8_DMA_V
#undef F8_BAR
#undef F8_VM0
#undef F8_VMNP
#undef F8_LD32
#undef F8_KLOAD
#undef F8_VLOAD
#undef F8_QK
#undef F8_QKN
#undef F8_QKA
#undef F8_PVX
#undef F8_ONOP
#undef F8_SMX
#undef F8_PV
#undef F8_CV4
#undef F8_SM
#undef F8_STEP
#undef F8_PAIR_END
#undef F8_DMA2
  }
};
}


namespace fa8v {
using fa::f32x16; using fa::crow;
typedef int v8i __attribute__((ext_vector_type(8)));
typedef short v2s __attribute__((ext_vector_type(2)));
struct Body {
  static constexpr int SHM_K = 64 * 64, SHM_V = 128 * 64;
  static constexpr int OFF_V = 0, OFF_K = 4 * SHM_V, OFF_TAB = fa::Body<64, 4, 128, true>::OFF_TAB, OFF_WS = OFF_TAB + 392 * 4, LDS_NEED = OFF_WS + 8 * 32 * 4;
  static_assert(OFF_K + 4 * SHM_K <= OFF_TAB && LDS_NEED <= LDS_CTL, "fa8v LDS map");
  static __device__ __forceinline__ int offs(int row, int chunk) { return row * 64 + ((chunk ^ ((row >> 2) & 3)) << 4); }

  template <class Store>
  static __device__ __forceinline__ void run(const unsigned char* __restrict__ Qb, const unsigned char* __restrict__ Kh, const unsigned char* __restrict__ VTh, int seq, LAS unsigned char* lds, int q0, int cexp, Store store) {
    int tid_ = threadIdx.x; asm volatile("" : "+v"(tid_));
    const int tid = tid_, wid = __builtin_amdgcn_readfirstlane(tid >> 6), lane = tid & 63, r32 = lane & 31, hi = lane >> 5;
    const float* tab = (const float*)(lds + OFF_TAB);
    float* li_l = (float*)(lds + OFF_WS) + wid * 32;
    unsigned kgo, vgo;
    { const int pos = (wid & 3) * 1024 + lane * 16, row = pos >> 6, ch = ((pos & 63) >> 4) ^ ((row >> 2) & 3); kgo = (unsigned)(row * 64 + ch * 16); }
    { const int pos = wid * 1024 + lane * 16, row = pos >> 6, ch = ((pos & 63) >> 4) ^ ((row >> 2) & 3); vgo = (unsigned)(row * seq + ch * 16); }
    const int NT = seq / 64;
#define FV_TCL(t) ((t) < NT ? (t) : NT - 1)
#define FV_DMA_K(t, b) do { if (wid < 4) __builtin_amdgcn_global_load_lds((const unsigned*)(Kh + (size_t)FV_TCL(t) * 4096 + kgo), (LAS unsigned*)(lds + OFF_K + (b) * SHM_K + wid * 1024), 16, 0, 0); } while (0)
#define FV_DMA_V(t, b) __builtin_amdgcn_global_load_lds((const unsigned*)(VTh + (size_t)FV_TCL(t) * 64 + vgo), (LAS unsigned*)(lds + OFF_V + (b) * SHM_V + wid * 1024), 16, 0, 0)
#define FV_DMA2(a_) do { const int kt_ = (a_) + 4 + (wid >> 2); \
      __builtin_amdgcn_global_load_lds((const unsigned*)(Kh + (size_t)FV_TCL(kt_) * 4096 + kgo), (LAS unsigned*)(lds + OFF_K + (kt_ & 3) * SHM_K + (wid & 3) * 1024), 16, 0, 0); \
      __builtin_amdgcn_global_load_lds((const unsigned*)(VTh + (size_t)FV_TCL((a_) + 2) * 64 + vgo), (LAS unsigned*)(lds + OFF_V + (((a_) + 2) & 3) * SHM_V + wid * 1024), 16, 0, 0); \
      __builtin_amdgcn_global_load_lds((const unsigned*)(VTh + (size_t)FV_TCL((a_) + 3) * 64 + vgo), (LAS unsigned*)(lds + OFF_V + (((a_) + 3) & 3) * SHM_V + wid * 1024), 16, 0, 0); } while (0)
#define FV_BAR() do { __builtin_amdgcn_sched_barrier(0); __builtin_amdgcn_s_barrier(); __builtin_amdgcn_sched_barrier(0); } while (0)
#define FV_VM0() asm volatile("s_waitcnt vmcnt(0)" ::: "memory")
#define FV_VMNP() do { if (wid < 4) asm volatile("s_waitcnt vmcnt(2)" ::: "memory"); else asm volatile("s_waitcnt vmcnt(1)" ::: "memory"); } while (0)
    f32x16 o[4] = {}; f32x16 sA0, sA1, sB0, sB1; v8i pA, pB; int saA = 127, saB = 127;
    typedef float f32x4_t __attribute__((ext_vector_type(4)));
    f32x4_t ol4 = {0.f, 0.f, 0.f, 0.f};
    int c127 = 127, c124 = 124; asm volatile("" : "+v"(c127), "+v"(c124));
    v8i onesB; { const int on = ((((lane & 15) < 8) ? 0 : 1) == ((lane >> 4) & 1)) ? 0x38383838 : 0; onesB = (v8i){on, on, on, on, on, on, on, on}; }
    const float csc = __builtin_bit_cast(float, (unsigned)(127 + cexp) << 23); const int sap = 127 + cexp;
    v8i qf, kf[2], vf[4];
    { const unsigned char* Qw = Qb + (size_t)(wid * 32 + r32) * 64 + hi * 32;
      const u32x4 a = *(const u32x4*)Qw, b = *(const u32x4*)(Qw + 16); qf = (v8i){(int)a[0], (int)a[1], (int)a[2], (int)a[3], (int)b[0], (int)b[1], (int)b[2], (int)b[3]}; }
    const int qw = q0 + wid * 32;
    const int Lf = (qw - 154) >> 6, Rf = (qw + 122 + 63) >> 6, jn0 = (Lf >= 0) ? Lf + 1 : -1;
#define FV_CLS1(jt) ((jt) > Lf && (jt) < Rf)
#define FV_LD32(p0_, p1_) ({ const u32x4 a_ = *(const LAS u32x4*)(p0_), b_ = *(const LAS u32x4*)(p1_); (v8i){(int)a_[0], (int)a_[1], (int)a_[2], (int)a_[3], (int)b_[0], (int)b_[1], (int)b_[2], (int)b_[3]}; })
#define FV_KLOAD(kb) do { const LAS unsigned char* Ks_ = lds + OFF_K + (kb) * SHM_K; \
      _Pragma("unroll") for (int h2 = 0; h2 < 2; ++h2) { const int row = h2 * 32 + r32; kf[h2] = FV_LD32(Ks_ + offs(row, 2 * hi), Ks_ + offs(row, 2 * hi + 1)); } } while (0)
#define FV_VLOAD(vb) do { const LAS unsigned char* Vs_ = lds + OFF_V + (vb) * SHM_V; \
      _Pragma("unroll") for (int d = 0; d < 4; ++d) { const int row = d * 32 + r32; vf[d] = FV_LD32(Vs_ + offs(row, 2 * hi), Vs_ + offs(row, 2 * hi + 1)); } } while (0)
#define FV_QK1(S, KF) asm volatile("s_nop 1\n\tv_mfma_scale_f32_32x32x64_f8f6f4 %0, %1, %2, 0, %3, %4 op_sel_hi:[0,0,0]" : "=&v"(S) : "v"(KF), "v"(qf), "v"(c127), "v"(c124))
#define FV_QK(S0, S1) do { __builtin_amdgcn_sched_barrier(0); FV_QK1(S0, kf[0]); FV_QK1(S1, kf[1]); __builtin_amdgcn_sched_barrier(0); } while (0)
#define FV_PV1(P, SA, d) do { __builtin_amdgcn_sched_barrier(0); asm volatile("s_nop 1\n\tv_mfma_scale_f32_32x32x64_f8f6f4 %0, %1, %2, %0, %3, %4 op_sel_hi:[0,0,0] cbsz:1" : "+v"(o[d]) : "v"(P), "v"(vf[d]), "v"(SA), "v"(c127)); __builtin_amdgcn_sched_barrier(0); } while (0)
#define FV_PVS(P, SA) do { ol4 = __builtin_amdgcn_mfma_scale_f32_16x16x128_f8f6f4(P, onesB, ol4, 1, 0, 0, SA, 0, 127); } while (0)
#define FV_PV(P, SA) do { FV_PV1(P, SA, 0); FV_PV1(P, SA, 1); FV_PV1(P, SA, 2); FV_PV1(P, SA, 3); FV_PVS(P, SA); } while (0)
#define FV_ONOP() asm volatile("s_nop 15\n\ts_nop 15\n\ts_nop 15\n\ts_nop 15" ::: "memory")
#define FV_CV4(S, B4, SC) ({ const unsigned w0_ = __builtin_bit_cast(unsigned, __builtin_amdgcn_cvt_pkrtz(S[B4], S[B4 + 1])), w1_ = __builtin_bit_cast(unsigned, __builtin_amdgcn_cvt_pkrtz(S[B4 + 2], S[B4 + 3])); __builtin_amdgcn_perm(w1_, w0_, 0x07050301u); })
#define FV_FAC(jt, f, chg) do { chg = false; f = 1.f; if ((jt) == jn0 || (jt) == Rf) { chg = true; f = ((jt) == jn0) ? __builtin_amdgcn_exp2f(tab[0]) : __builtin_amdgcn_exp2f(-tab[384]); } } while (0)
#define FV_SM(jt, S0, S1, P, SA) FV_SMX(jt, S0, S1, P, SA, P, SA, false, -1, -1)
#define FV_SMX(jt, S0, S1, P, SA, PP_, SAP_, DOPV_, KB_, VB_) do { \
      if (FV_CLS1(jt)) { const float* tl_ = tab + ((jt) * 64 - (qw + r32) + 192 + 4 * hi); \
        _Pragma("unroll") for (int r = 0; r < 16; ++r) { S0[r] += tl_[(r & 3) + 8 * (r >> 2)]; S1[r] += tl_[32 + (r & 3) + 8 * (r >> 2)]; } } \
      _Pragma("unroll") for (int r = 0; r < 8; ++r) S0[r] = __builtin_amdgcn_exp2f(S0[r]); \
      if (DOPV_) FV_PV1(PP_, SAP_, 0); \
      _Pragma("unroll") for (int r = 8; r < 16; ++r) S0[r] = __builtin_amdgcn_exp2f(S0[r]); \
      if (DOPV_) FV_PV1(PP_, SAP_, 1); \
      _Pragma("unroll") for (int r = 0; r < 8; ++r) S1[r] = __builtin_amdgcn_exp2f(S1[r]); \
      if (DOPV_) FV_PV1(PP_, SAP_, 2); \
      _Pragma("unroll") for (int r = 8; r < 16; ++r) S1[r] = __builtin_amdgcn_exp2f(S1[r]); \
      if (DOPV_) { FV_PV1(PP_, SAP_, 3); FV_PVS(PP_, SAP_); } \
      __builtin_amdgcn_sched_barrier(0); \
      if ((KB_) >= 0) FV_KLOAD(KB_); \
      if ((VB_) >= 0) FV_VLOAD(VB_); \
      __builtin_amdgcn_sched_barrier(0); \
      unsigned x_[4], y_[4]; \
      _Pragma("unroll") for (int i = 0; i < 4; ++i) x_[i] = FV_CV4(S0, 4 * i, csc); \
      _Pragma("unroll") for (int i = 0; i < 4; ++i) y_[i] = FV_CV4(S1, 4 * i, csc); \
      _Pragma("unroll") for (int i = 0; i < 4; ++i) asm volatile("" : "+v"(x_[i]), "+v"(y_[i])); \
      P = (v8i){(int)x_[0], (int)x_[1], (int)x_[2], (int)x_[3], (int)y_[0], (int)y_[1], (int)y_[2], (int)y_[3]}; SA = sap; } while (0)
#define FV_ORESC(jt) do { bool chg_; float f_; FV_FAC(jt, f_, chg_); if (chg_) { FV_ONOP(); _Pragma("unroll") for (int d = 0; d < 4; ++d) _Pragma("unroll") for (int r = 0; r < 16; ++r) o[d][r] *= f_; ol4 *= f_; } } while (0)
#define FV_STEP(j_, SI0, SI1, SO0, SO1, PP, SAP, PN, SAN, dopv) do { \
      FV_QK(SO0, SO1); \
      __builtin_amdgcn_sched_barrier(0); \
      if (dopv) { FV_ORESC((j_) - 1); } \
      FV_SMX(j_, SI0, SI1, PN, SAN, PP, SAP, dopv, ((j_) + 2) & 3, (j_) & 3); \
      __builtin_amdgcn_sched_barrier(0); } while (0)
#define FV_PAIR_END() do { asm volatile("s_waitcnt lgkmcnt(0)" ::: "memory"); FV_VM0(); FV_BAR(); } while (0)

    FV_DMA_K(0, 0); FV_DMA_K(1, 1); FV_DMA_K(2, 2); FV_DMA_K(3, 3); FV_DMA_V(0, 0); FV_DMA_V(1, 1);
    FV_VM0(); FV_BAR();
    FV_KLOAD(0); FV_QK(sA0, sA1); FV_ONOP(); FV_ONOP(); __builtin_amdgcn_sched_barrier(0); FV_KLOAD(1);
    asm volatile("s_waitcnt lgkmcnt(0)" ::: "memory"); FV_BAR();
    FV_DMA2(0); __builtin_amdgcn_sched_barrier(0);
    FV_STEP(0, sA0, sA1, sB0, sB1, pB, saB, pA, saA, false);
    FV_STEP(1, sB0, sB1, sA0, sA1, pA, saA, pB, saB, true);
    FV_PAIR_END();
    for (int j = 2; j + 1 < NT; j += 2) {
      FV_DMA2(j); __builtin_amdgcn_sched_barrier(0);
      FV_STEP(j, sA0, sA1, sB0, sB1, pB, saB, pA, saA, true);
      FV_STEP(j + 1, sB0, sB1, sA0, sA1, pA, saA, pB, saB, true);
      FV_PAIR_END();
    }
    FV_ORESC(NT - 1); FV_PV(pB, saB);
    FV_ONOP();
    if ((lane & 7) == 0) { const int qb_ = ((lane & 15) ? 16 : 0) + 4 * (lane >> 4);
      li_l[qb_ + 0] = ol4[0]; li_l[qb_ + 1] = ol4[1]; li_l[qb_ + 2] = ol4[2]; li_l[qb_ + 3] = ol4[3]; }
    asm volatile("s_waitcnt lgkmcnt(0)" ::: "memory");
    float rli[16];
#pragma unroll
    for (int r = 0; r < 16; ++r) rli[r] = __builtin_amdgcn_rcpf(li_l[crow(r, hi)]);
    store(o, rli, wid, r32, hi);
    __syncthreads();
#undef FV_TCL
#undef FV_DMA_K
#undef FV_DMA_V
#undef FV_BAR
#undef FV_VM0
#undef FV_VMNP
#undef FV_CLS1
#undef FV_LD32
#undef FV_KLOAD
#undef FV_VLOAD
#undef FV_QK
#undef FV_QK1
#undef FV_PV
#undef FV_PV1
#undef FV_PVS
#undef FV_ONOP
#undef FV_SMX
#undef FV_CV4
#undef FV_FAC
#undef FV_SM
#undef FV_ORESC
#undef FV_STEP
#undef FV_PAIR_END
#undef FV_DMA2
  }
};
}

__device__ __forceinline__ void attn0_fast(const Frame& F) {
  bf16_t* OB = WSP(bf16_t, A_OB);
  const float bnd_mla = pp_mla_bound(F), bnd_gqa = pp_gqa_bound(F);
  const bool pp_mla = bnd_mla <= PP_BF8, pp_gqa = bnd_gqa <= PP_BF8;
  const int cexp_mla = max(-8, (int)ceilf(bnd_mla - 15.5f)), cexp_gqa = max(-8, (int)ceilf(bnd_gqa - 15.5f));
  const int vcu = (F.G % 8 == 0) ? (F.bid % 8) * (F.G / 8) + F.bid / 8 : F.bid;
  for (int u = vcu; u < 64 * 32; u += F.G) {
    const int item = u >> 5, qb = u & 31, q0 = qb * 256;
    if (item < 32) {
      const int b = item >> 3, h = item & 7;
      bf16_t* Ow = OB + ((size_t)b * S_ + q0) * 1024 + h * 64;
      auto st = [&](const fa::f32x16* o, const float* rli, int wid, int r32, int hi) {
#pragma unroll
        for (int r = 0; r < 16; ++r) { const int orow = wid * 32 + fa::crow(r, hi);
#pragma unroll
          for (int d0 = 0; d0 < 2; ++d0) Ow[(size_t)orow * 1024 + d0 * 32 + r32] = f2bf(o[d0][r] * rli[r]); } };
      if (pp_mla) {
        const unsigned char* Qp = WSP(const unsigned char, A_QA) + (((size_t)b * 8 + h) * S_ + q0) * 128;
        const unsigned char* Kp = WSP(const unsigned char, A_KA) + (((size_t)b * 8 + h) * S_) * 128;
        const unsigned char* Vp = WSP(const unsigned char, A_VA) + ((size_t)b * 8 + h) * 64 * S_;
        fa8::Body<2>::run(Qp, Kp, Vp, S_, (LAS unsigned char*)F.lds, cexp_mla, st);
      } else {
        const bf16_t* Qp = WSP(const bf16_t, A_QA) + (((size_t)b * 8 + h) * S_ + q0) * 128;
        const bf16_t* Kp = WSP(const bf16_t, A_KA) + (((size_t)b * 8 + h) * S_) * 128;
        const bf16_t* Vp = WSP(const bf16_t, A_VA) + (((size_t)b * 8 + h) * S_) * 64;
        fa::Body<128, 6, 64, false>::run(Qp, Kp, Vp, S_, (char*)F.lds, 1.f, q0, st);
      }
    } else {
      const int it = item - 32, b = it >> 3, hq = it & 7, hk = hq >> 2;
      bf16_t* Ow = OB + ((size_t)b * S_ + q0) * 1024 + 512 + hq * 64;
      auto st = [&](const fa::f32x16* o, const float* rli, int wid, int r32, int hi) {
#pragma unroll
        for (int r = 0; r < 16; ++r) { const int orow = wid * 32 + fa::crow(r, hi);
#pragma unroll
          for (int d0 = 0; d0 < 2; ++d0) Ow[(size_t)orow * 1024 + d0 * 32 + r32] = f2bf(o[d0][r] * rli[r]); } };
      if (pp_gqa) {
        const unsigned char* Qp = WSP(const unsigned char, A_QG) + (((size_t)b * 8 + hq) * S_ + q0) * 64;
        const unsigned char* Kp = WSP(const unsigned char, A_KG) + (((size_t)b * 2 + hk) * S_) * 64;
        const unsigned char* Vp = WSP(const unsigned char, A_VG) + ((size_t)b * 2 + hk) * 64 * S_;
        fa8::Body<1>::run(Qp, Kp, Vp, S_, (LAS unsigned char*)F.lds, cexp_gqa, st);
      } else {
        const bf16_t* Qp = WSP(const bf16_t, A_QG) + (((size_t)b * 8 + hq) * S_ + q0) * 64;
        const bf16_t* Kp = WSP(const bf16_t, A_KG) + (((size_t)b * 2 + hk) * S_) * 64;
        const bf16_t* Vp = WSP(const bf16_t, A_VG) + (((size_t)b * 2 + hk) * S_) * 64;
        fa::Body<64, 4, 64, false>::run(Qp, Kp, Vp, S_, (char*)F.lds, 1.f, q0, st);
      }
    }
  }
}
#ifndef FP8_FROM_COMP
#define FP8_FROM_COMP 0
#endif
__device__ __forceinline__ void attn1_fast(const Frame& F) {
  float* OD = WSP(float, A_OD);
  bf16_t* OB = WSP(bf16_t, A_OB1);
  using B1 = fa::Body<64, 4, 128, true>;
  const float bnd = pp_diff_bound(F);
  const bool pp = bnd <= PP_F16;
  const int cexp = 0;
  const float lambda_init = 0.8f - 0.6f * 0.7408182206817179f;
  float lam;
  { const float a = F.in[I_LQ1][F.lane] * F.in[I_LK1][F.lane], c = F.in[I_LQ2][F.lane] * F.in[I_LK2][F.lane];
    lam = __expf(wave_sum(a)) - __expf(wave_sum(c)) + lambda_init; }
  float* tab = (float*)(F.lds + B1::OFF_TAB);
  const int vcu = (F.G % 8 == 0) ? (F.bid % 8) * (F.G / 8) + F.bid / 8 : F.bid;
  const int nround = (64 * 32 + F.G - 1) / F.G;
  int curh = -1;
  for (int v = vcu; v < 32 * 32; v += F.G)
  for (int comp = 0; comp < 2; ++comp) {
    const int pair = v >> 5, qb = v & 31, q0 = qb * 256;
    const int b = pair >> 3, h = pair & 7, h16 = h * 2 + comp;
    if (h != curh) {
      for (int i = F.tid; i < 385; i += NTHR) tab[i] = F.in[I_RELB][t5_bucket(i - 192) * 8 + h] * LOG2E;
      curh = h; __syncthreads();
    }
    const bf16_t* Qp = WSP(const bf16_t, A_QD) + (((size_t)b * 16 + h16) * S_ + q0) * 64;
    const bf16_t* Kp = WSP(const bf16_t, A_KD) + (((size_t)b * 16 + h16) * S_) * 64;
    const bf16_t* Vp = WSP(const bf16_t, A_VD) + (((size_t)b * 8 + h) * S_) * 128;
    float* Od = OD + (((size_t)b * S_ + q0) * 8 + h) * 128;
    bf16_t* Ob = OB + ((size_t)b * S_ + q0) * 1024 + h * 128;
    const float* sub = F.in[I_SUBLN];
    auto st = [&](const fa::f32x16* o, const float* rli, int wid, int r32, int hi) {
      if (comp == 0) {
#pragma unroll
        for (int r = 0; r < 16; ++r) { const int orow = wid * 32 + fa::crow(r, hi);
#pragma unroll
          for (int d0 = 0; d0 < 4; ++d0) Od[(size_t)orow * 1024 + d0 * 32 + r32] = o[d0][r] * rli[r]; }
        asm volatile("s_waitcnt vmcnt(0)" ::: "memory");
      } else {
        float g[4];
#pragma unroll
        for (int d0 = 0; d0 < 4; ++d0) g[d0] = sub[d0 * 32 + r32] * (1.f - lambda_init);
#pragma unroll
        for (int r = 0; r < 16; ++r) { const int orow = wid * 32 + fa::crow(r, hi);
          float x[4]; float ss = 0.f;
#pragma unroll
          for (int d0 = 0; d0 < 4; ++d0) { x[d0] = Od[(size_t)orow * 1024 + d0 * 32 + r32] - lam * (o[d0][r] * rli[r]); ss += x[d0] * x[d0]; }
          ss += __shfl_xor(ss, 1); ss += __shfl_xor(ss, 2); ss += __shfl_xor(ss, 4); ss += __shfl_xor(ss, 8); ss += __shfl_xor(ss, 16);
          const float rn = rsqrtf(ss * (1.f / 128.f) + EPS_);
#pragma unroll
          for (int d0 = 0; d0 < 4; ++d0) Ob[(size_t)orow * 1024 + d0 * 32 + r32] = f2bf(x[d0] * rn * g[d0]); }
      } };
    if (pp && comp >= FP8_FROM_COMP) {
      const unsigned char* Q8 = WSP(const unsigned char, A_Q8D) + (((size_t)b * 16 + h16) * S_ + q0) * 64;
      const unsigned char* K8 = WSP(const unsigned char, A_K8D) + (((size_t)b * 16 + h16) * S_) * 64;
      const unsigned char* V8 = WSP(const unsigned char, A_VT8D) + ((size_t)b * 8 + h) * 128 * S_;
      fa8v::Body::run(Q8, K8, V8, S_, (LAS unsigned char*)F.lds, q0, cexp, st);
    }
    else if (pp) fa::Body<64, 4, 128, true, true>::run(Qp, Kp, Vp, S_, (char*)F.lds, 1.f, q0, st);
    else         B1::run(Qp, Kp, Vp, S_, (char*)F.lds, 1.f, q0, st);
  }
  (void)nround;
}


constexpr int NPH = 21;
__global__ void __launch_bounds__(NTHR, 2) mega(Args a) {
  extern __shared__ __attribute__((aligned(16))) unsigned char lds[];
  Frame F;
#pragma unroll
  for (int i = 0; i < N_IN; ++i) F.in[i] = a.in[i];
  F.out = a.out; F.ws = a.ws; F.lds = lds;
  F.tid = threadIdx.x; F.lane = F.tid & 63; F.wave = __builtin_amdgcn_readfirstlane(F.tid >> 6); F.G = gridDim.x; F.bid = blockIdx.x;
  if (F.tid < 4) ((unsigned*)(lds + LDS_CTL))[F.tid] = 0u;
  __syncthreads();
  XcdBarrier bar; bar.bar = (unsigned*)(F.ws + WS_CTL); bar.x = 0; bar.st = nullptr;
#if MK_ONE_LAUNCH
  bar = xcd_barrier_post((unsigned*)(F.ws + WS_CTL), (volatile LAS unsigned*)(lds + LDS_CTL));
#define GRID_BAR() xcd_barrier(bar)
#else
#define GRID_BAR() do {} while (0)
#endif
  const int lo = a.ph_lo, hi = a.ph_hi;
#define IN(k) (lo <= (k) && (k) < hi)
#define SEAM(k) do { if (IN((k) + 1)) GRID_BAR(); } while (0)

  if (IN(0)) { phase0(F); SEAM(0); }
  if (IN(1)) { phase_xnorm<0>(F, 0); SEAM(1); }
  if (IN(2)) {
    {
    pg::DenseOrder S; S.init(WSP(const bf16_t, WS_HB), WSP(const bf16_t, WS_WIN0), T_, P0LD, 512, F.G, F.bid);
    pg::EpiStoreBf16 E{WSP(bf16_t, A_PROJ0), P0LD};
    pg::gemm_phase<pg::EpiStoreBf16, pg::DenseOrder, false, true>((LAS unsigned char*)lds, 512, S, E, 121  , 127);
    }
    SEAM(2);
  }
  if (IN(3)) { phase_split0(F); SEAM(3); }
  if (IN(4)) {
    {
    { pg::DenseOrder S; S.init(WSP(const bf16_t, A_CQN), WSP(const bf16_t, WS_WQB), T_, 768, 512, F.G, F.bid);
      pg::EpiStoreBf16 E{WSP(bf16_t, A_QRAW), 768};
      pg::gemm_phase<pg::EpiStoreBf16, pg::DenseOrder, false>((LAS unsigned char*)lds, 512, S, E); }
    { pg::DenseOrder S; S.init(WSP(const bf16_t, A_CKVN), WSP(const bf16_t, WS_WKVB), T_, 1024, 256, F.G, F.bid);
      pg::EpiStoreBf16 E{WSP(bf16_t, A_KVRAW), 1024};
      pg::gemm_phase<pg::EpiStoreBf16, pg::DenseOrder, false>((LAS unsigned char*)lds, 256, S, E); }
    }
    SEAM(4);
  }
  if (IN(5)) { phase_mla(F); SEAM(5); }
  if (IN(6)) { attn0_fast(F); SEAM(6); }
  if (IN(7)) {
    {
    pg::DenseOrder S; S.init(WSP(const bf16_t, A_OB), WSP(const bf16_t, WS_WOUT0), T_, 1024, 1024, F.G, F.bid);
    pg::EpiResid E{F.in[I_X], F.out, WSP(const float, WS_MOD) + 2048, WSP(float, WS_ROWSS)};
    pg::gemm_phase<pg::EpiResid, pg::DenseOrder, false>((LAS unsigned char*)lds, 1024, S, E);
    }
    SEAM(7);
  }
  if (IN(8)) { phase_route(F, 0); SEAM(8); }
  if (IN(9)) { moe_up_fast(F, 0); SEAM(9); }
  if (IN(10)) { moe_down_fast(F, 0); SEAM(10); }
  if (IN(11)) { phase_xnorm<1>(F, 1); SEAM(11); }
  if (IN(12)) {
    const bool pp1 = pp_diff_ok(F);
    {
    pg::DenseOrder S; S.init(WSP(const bf16_t, WS_HB), WSP(const bf16_t, WS_WIN1), T_, 3072, 512, F.G, F.bid);
    pg::EpiSplit1 E{WSP(bf16_t, A_QD), WSP(bf16_t, A_KD), WSP(bf16_t, A_VD), F.in[I_CQN], F.in[I_CKN], WSP(unsigned char, A_Q8D), WSP(unsigned char, A_K8D), pp1 ? 0 : 1};
    pg::gemm_phase<pg::EpiSplit1, pg::DenseOrder, false, true, 1>((LAS unsigned char*)lds, 512, S, E, 121  , 127);
    }
    SEAM(12);
  }
  if (IN(13)) { phase_vt1(F); SEAM(13); }
  if (IN(14)) { attn1_fast(F); SEAM(14); }
  if (IN(16)) {
    pg::DenseOrder S; S.init(WSP(const bf16_t, A_OB1), WSP(const bf16_t, WS_WOUT1), T_, 1024, 1024, F.G, F.bid);
    pg::EpiResid E{F.out, F.out, WSP(const float, WS_MOD) + (size_t)4 * 6144 + 2048, WSP(float, WS_ROWSS)};
    pg::gemm_phase<pg::EpiResid, pg::DenseOrder, false>((LAS unsigned char*)lds, 1024, S, E);
    SEAM(16);
  }
  if (IN(17)) { phase_route(F, 1); SEAM(17); }
  if (IN(18)) { moe_up_fast(F, 1); SEAM(18); }
  if (IN(19)) { moe_down_fast(F, 1); SEAM(19); }
  if (IN(20)) { phase_xnorm<2>(F, 1); }
}
}

extern "C" void kernel_launch(void* const* d_in, const int* in_sizes, int n_in, void* d_out, int out_size, void* d_ws, size_t ws_size, hipStream_t stream) {
  static int grid = 0;
  if (grid == 0) {
    if (n_in != N_IN || out_size != T_ * D_ || ws_size < WS_END) { fprintf(stderr, "kernel_launch: bad shapes n_in %d out %d ws %zu (need %zu)\n", n_in, out_size, ws_size, (size_t)WS_END); grid = -1; return; }
    int dev = 0, cus = 0, per_cu = 0;
    if (hipGetDevice(&dev) != hipSuccess || hipDeviceGetAttribute(&cus, hipDeviceAttributeMultiprocessorCount, dev) != hipSuccess) { grid = -1; return; }
    if (hipFuncSetAttribute((const void*)mega, hipFuncAttributeMaxDynamicSharedMemorySize, LDS_BYTES) != hipSuccess) { fprintf(stderr, "kernel_launch: hipFuncSetAttribute failed\n"); grid = -1; return; }
    if (hipOccupancyMaxActiveBlocksPerMultiprocessor(&per_cu, (const void*)mega, NTHR, LDS_BYTES) != hipSuccess || per_cu < 1) { fprintf(stderr, "kernel_launch: occupancy query says %d\n", per_cu); }
    (void)hipGetLastError();
    grid = cus;
  }
  if (grid < 0) return;
  (void)in_sizes;
  (void)hipMemsetAsync((char*)d_ws + WS_CTL, 0, CTL_BYTES, stream);
  Args a{};
  for (int i = 0; i < N_IN; ++i) a.in[i] = (const float*)d_in[i];
  a.out = (float*)d_out; a.ws = (unsigned char*)d_ws;
#if MK_ONE_LAUNCH
  a.ph_lo = 0; a.ph_hi = NPH;
  hipLaunchKernelGGL(mega, dim3(grid), dim3(NTHR), LDS_BYTES, stream, a);
#else
  for (int p = 0; p < NPH; ++p) { a.ph_lo = p; a.ph_hi = p + 1; hipLaunchKernelGGL(mega, dim3(grid), dim3(NTHR), LDS_BYTES, stream, a); }
#endif
}
```
